# Optimizing an MI355X kernel written in HIP

```python
import jax
import jax.numpy as jnp
from jax import lax
import numpy as np

D_MODEL = 1024
BATCH = 4
SEQ = 8192
DEPTH = 2

GRID_W = 64
CTX_LEN = 256
NA_HEADS = 8
NA_HEAD_DIM = 64
NA_WIN_ROWS = 8
NA_WIN_COLS = 16
RET_HEADS = 4
RET_DK = 64
RET_DV = 128
RET_CHUNK = 128
RET_MIN_EXP = 5.0
RET_MAX_EXP = 12.0
ROPE_BASE = 10000.0
FOURIER_GROUPS = 8
FFN_DIM = 2816
N_EXPERTS = 8
TOP_K = 2
EXPERT_DIM = 3584
MOE_BLOCK = 256
NORM_EPS = 1e-6
NA_WIDTH = NA_HEADS * NA_HEAD_DIM
RET_QK_WIDTH = RET_HEADS * RET_DK
RET_V_WIDTH = RET_HEADS * RET_DV
Q_SIDE_WIDTH = NA_WIDTH + RET_QK_WIDTH + RET_V_WIDTH
KV_SIDE_WIDTH = 2 * NA_WIDTH + RET_QK_WIDTH + RET_V_WIDTH
IN_WIDTH = Q_SIDE_WIDTH + KV_SIDE_WIDTH
MIX_WIDTH = NA_WIDTH + RET_V_WIDTH

kernel_name = 'hybrid_natten_retention_fnet_moe_dit'


def _split(t, sizes):
    return jnp.split(t, [int(s) for s in np.cumsum(sizes)[:-1]], axis=-1)


def rms_normalize(x):
    xf = x.astype(jnp.float32)
    return xf * lax.rsqrt(jnp.mean(xf * xf, axis=-1, keepdims=True) + NORM_EPS)


def rmsnorm(x, gain):
    return (rms_normalize(x) * gain.astype(jnp.float32)).astype(x.dtype)


def ada_chunks(cond, w_ada, b_ada, n_chunks):
    d = w_ada.shape[0]
    m = jax.nn.silu(cond) @ w_ada[:, :n_chunks * d] + b_ada[:n_chunks * d]
    if m.ndim == 2:
        m = m[:, None, :]
    return jnp.split(m, n_chunks, axis=-1)


def modulate(x, shift, scale):
    return x * (1.0 + scale) + shift


def heads(t, n_heads, dim):
    return t.reshape(t.shape[0], t.shape[1], n_heads, dim)


def axial_rope(n, dim):
    pos = jnp.arange(n)
    row = (pos // GRID_W).astype(jnp.float32)
    col = (pos % GRID_W).astype(jnp.float32)
    n_freq = dim // 4
    inv_freq = ROPE_BASE ** (-jnp.arange(n_freq, dtype=jnp.float32) / n_freq)
    ang = jnp.concatenate([row[:, None] * inv_freq, col[:, None] * inv_freq], axis=-1)
    return jnp.cos(ang), jnp.sin(ang)


def apply_rope(x, cos, sin):
    b, n, h, d = x.shape
    xp = x.astype(jnp.float32).reshape(b, n, h, d // 2, 2)
    x1, x2 = xp[..., 0], xp[..., 1]
    cs, sn = cos[None, :, None, :], sin[None, :, None, :]
    return jnp.stack([x1 * cs - x2 * sn, x1 * sn + x2 * cs], axis=-1).reshape(b, n, h, d).astype(x.dtype)


def neighbourhood_attention(q, k, v, k_ctx, v_ctx, rpb):
    b, n, h, hd = q.shape
    rows = n // GRID_W
    kr = min(NA_WIN_ROWS, rows)
    kc = NA_WIN_COLS
    col = np.arange(GRID_W)
    col_start = np.clip(col - kc // 2, 0, GRID_W - kc)
    col_idx = col_start[:, None] + np.arange(kc)[None, :]
    col_off = col_idx - col[:, None] + (kc - 1)

    def to_grid(t):
        return t.reshape(b, rows, GRID_W, h, hd).transpose(0, 3, 1, 2, 4)

    qg, kg, vg = to_grid(q), to_grid(k), to_grid(v)
    kx = k_ctx.transpose(0, 2, 1, 3)
    vx = v_ctx.transpose(0, 2, 1, 3)
    scale = hd ** -0.5
    n_nb = kr * kc

    def row_block(r):
        r0 = jnp.clip(r - kr // 2, 0, rows - kr)
        q_r = lax.dynamic_index_in_dim(qg, r, axis=2, keepdims=False)
        k_strip = lax.dynamic_slice_in_dim(kg, r0, kr, axis=2)
        v_strip = lax.dynamic_slice_in_dim(vg, r0, kr, axis=2)
        k_nb = k_strip[:, :, :, col_idx]
        v_nb = v_strip[:, :, :, col_idx]
        row_off = r0 - r + jnp.arange(kr) + (NA_WIN_ROWS - 1)
        bias = rpb[:, row_off[:, None, None], col_off[None, :, :]].transpose(0, 2, 1, 3)
        s_nb = jnp.einsum('bhqd,bhiqjd->bhqij', q_r, k_nb) * scale + bias[None]
        s_cx = jnp.einsum('bhqd,bhcd->bhqc', q_r, kx) * scale
        s = jnp.concatenate([s_nb.reshape(b, h, GRID_W, n_nb), s_cx], axis=-1).astype(jnp.float32)
        p = jax.nn.softmax(s, axis=-1).astype(v.dtype)
        p_nb = p[..., :n_nb].reshape(b, h, GRID_W, kr, kc)
        p_cx = p[..., n_nb:]
        return (jnp.einsum('bhqij,bhiqjd->bhqd', p_nb, v_nb)
                + jnp.einsum('bhqc,bhcd->bhqd', p_cx, vx))

    out = lax.map(row_block, jnp.arange(rows))
    return out.transpose(1, 0, 3, 2, 4).reshape(b, n, h * hd)


def retention_chunkwise(q, k, v, log_g, s0):
    b, n, h, dk = q.shape
    dv = v.shape[-1]
    nc = n // RET_CHUNK

    def chunks(t):
        return t.reshape(b, nc, RET_CHUNK, h, t.shape[-1]).transpose(1, 0, 3, 2, 4)

    idx = jnp.arange(RET_CHUNK, dtype=jnp.float32)
    diff = idx[:, None] - idx[None, :]
    decay_mask = jnp.where(diff >= 0, jnp.exp(jnp.maximum(diff, 0.0)[None] * log_g[:, None, None]), 0.0)
    xi = jnp.exp((idx + 1.0)[None, :] * log_g[:, None])[..., None]
    zeta = jnp.exp((RET_CHUNK - 1.0 - idx)[None, :] * log_g[:, None])[..., None]
    g_chunk = jnp.exp(RET_CHUNK * log_g)[:, None, None]

    def step(state, inp):
        qi, ki, vi = inp
        inner = jnp.einsum('bhid,bhjd->bhij', qi, ki) * decay_mask
        o = jnp.einsum('bhij,bhjv->bhiv', inner, vi) + jnp.einsum('bhid,bhdv->bhiv', qi, state) * xi
        state = state * g_chunk + jnp.einsum('bhjd,bhjv->bhdv', ki * zeta, vi)
        return state, o

    _, o = lax.scan(step, s0, (chunks(q), chunks(k), chunks(v)))
    return o.transpose(1, 0, 3, 2, 4).reshape(b, n, h, dv)


def bidirectional_retention(q, k, v, k_ctx, v_ctx, a_fwd, a_bwd):
    f32 = jnp.float32
    q, k, v = q.astype(f32), k.astype(f32), v.astype(f32)
    k_ctx, v_ctx = k_ctx.astype(f32), v_ctx.astype(f32)
    lg_f = jax.nn.log_sigmoid(a_fwd.astype(f32))
    lg_b = jax.nn.log_sigmoid(a_bwd.astype(f32))
    n_ctx = k_ctx.shape[1]
    pos = jnp.arange(n_ctx, dtype=f32)
    w_f = jnp.exp((n_ctx - 1.0 - pos)[None, :] * lg_f[:, None])
    w_b = jnp.exp(pos[None, :] * lg_b[:, None])
    s_f = jnp.einsum('blhd,hl,blhv->bhdv', k_ctx, w_f, v_ctx)
    s_b = jnp.einsum('blhd,hl,blhv->bhdv', k_ctx, w_b, v_ctx)
    o_f = retention_chunkwise(q, k, v, lg_f, s_f)
    o_b = retention_chunkwise(q[:, ::-1], k[:, ::-1], v[:, ::-1], lg_b, s_b)[:, ::-1]
    return o_f + o_b


def swiglu(h, w_gate_up, w_down):
    g, u = jnp.split(h @ w_gate_up, 2, axis=-1)
    return (jax.nn.silu(g) * u) @ w_down


def fourier_mix(h):
    b, n, d = h.shape
    hg = h.astype(jnp.float32).reshape(b, n, FOURIER_GROUPS, d // FOURIER_GROUPS)
    f = jnp.fft.fft2(hg, axes=(1, 3), norm='ortho').real
    return f.reshape(b, n, d).astype(h.dtype)


def moe_swiglu(h, w_router, w_gate_up, w_down):
    t, d = h.shape
    logits = (h @ w_router).astype(jnp.float32)
    top_logit, top_idx = lax.top_k(logits, TOP_K)
    gates = jax.nn.softmax(top_logit, axis=-1)
    n_assign = t * TOP_K
    expert = top_idx.reshape(n_assign)
    token = jnp.arange(n_assign, dtype=jnp.int32) // TOP_K
    gate = gates.reshape(n_assign)
    order = jnp.argsort(expert)
    e_sorted = expert[order]
    counts = jnp.bincount(expert, length=N_EXPERTS)
    padded = (counts + MOE_BLOCK - 1) // MOE_BLOCK * MOE_BLOCK
    pad_end = jnp.cumsum(padded)
    pad_start = pad_end - padded
    start = jnp.cumsum(counts) - counts
    slot = pad_start[e_sorted] + jnp.arange(n_assign) - start[e_sorted]
    n_blocks = (n_assign + N_EXPERTS * (MOE_BLOCK - 1) + MOE_BLOCK - 1) // MOE_BLOCK
    n_slots = n_blocks * MOE_BLOCK
    slot_token = jnp.full((n_slots,), t, jnp.int32).at[slot].set(token[order])
    slot_gate = jnp.zeros((n_slots,), jnp.float32).at[slot].set(gate[order])
    block_expert = jnp.minimum(
        jnp.searchsorted(pad_end, jnp.arange(n_blocks) * MOE_BLOCK, side='right'), N_EXPERTS - 1)
    h_pad = jnp.concatenate([h, jnp.zeros((1, d), h.dtype)], axis=0)
    xb = h_pad[slot_token].reshape(n_blocks, MOE_BLOCK, d)

    def expert_block(args):
        xblk, e = args
        return swiglu(xblk, w_gate_up[e], w_down[e])

    yb = lax.map(expert_block, (xb, block_expert)).reshape(n_slots, d)
    y = yb * slot_gate[:, None].astype(yb.dtype)
    return jax.ops.segment_sum(y, slot_token, num_segments=t + 1)[:t]


def even_layer(x, c, ctx, c_ctx, norm_mix, norm_ffn, w_ada, b_ada, w_in, q_gain, k_gain, rpb,
               ret_decay_fwd, ret_decay_bwd, w_out, w_gate_up, w_down):
    b, n, d = x.shape
    sh_m, sc_m, g_m, sh_f, sc_f, g_f = ada_chunks(c, w_ada, b_ada, 6)
    cx_sh, cx_sc = ada_chunks(c_ctx, w_ada, b_ada, 2)
    h = modulate(rmsnorm(x, norm_mix), sh_m, sc_m)
    hx = modulate(rmsnorm(ctx, norm_mix), cx_sh, cx_sc)
    proj = h @ w_in
    proj_x = hx @ w_in[:, Q_SIDE_WIDTH:]
    na_q, ret_q, ret_g, na_k, na_v, ret_k, ret_v = _split(
        proj, (NA_WIDTH, RET_QK_WIDTH, RET_V_WIDTH, NA_WIDTH, NA_WIDTH, RET_QK_WIDTH, RET_V_WIDTH))
    cx_na_k, cx_na_v, cx_ret_k, cx_ret_v = _split(
        proj_x, (NA_WIDTH, NA_WIDTH, RET_QK_WIDTH, RET_V_WIDTH))

    qa = rmsnorm(heads(na_q, NA_HEADS, NA_HEAD_DIM), q_gain)
    ka = rmsnorm(heads(na_k, NA_HEADS, NA_HEAD_DIM), k_gain)
    kxa = rmsnorm(heads(cx_na_k, NA_HEADS, NA_HEAD_DIM), k_gain)
    o_na = neighbourhood_attention(qa, ka, heads(na_v, NA_HEADS, NA_HEAD_DIM),
                                   kxa, heads(cx_na_v, NA_HEADS, NA_HEAD_DIM), rpb)

    cos, sin = axial_rope(n, RET_DK)
    qr = apply_rope(heads(ret_q, RET_HEADS, RET_DK), cos, sin)
    kr = apply_rope(heads(ret_k, RET_HEADS, RET_DK), cos, sin) * (RET_DK ** -0.5)
    kxr = heads(cx_ret_k, RET_HEADS, RET_DK) * (RET_DK ** -0.5)
    o_ret = bidirectional_retention(qr, kr, heads(ret_v, RET_HEADS, RET_DV),
                                    kxr, heads(cx_ret_v, RET_HEADS, RET_DV), ret_decay_fwd, ret_decay_bwd)
    o_ret = rms_normalize(o_ret).reshape(b, n, RET_V_WIDTH).astype(x.dtype) * jax.nn.silu(ret_g)

    mix = jnp.concatenate([o_na.astype(x.dtype), o_ret], axis=-1) @ w_out
    x = x + g_m * mix
    h2 = modulate(rmsnorm(x, norm_ffn), sh_f, sc_f)
    return x + g_f * swiglu(h2, w_gate_up, w_down)


def odd_layer(x, c, norm_mix, norm_ffn, w_ada, b_ada, w_fourier, w_router, w_exp_gate_up, w_exp_down):
    b, n, d = x.shape
    sh_m, sc_m, g_m, sh_f, sc_f, g_f = ada_chunks(c, w_ada, b_ada, 6)
    h = modulate(rmsnorm(x, norm_mix), sh_m, sc_m)
    x = x + g_m * (fourier_mix(h) @ w_fourier)
    h2 = modulate(rmsnorm(x, norm_ffn), sh_f, sc_f)
    y = moe_swiglu(h2.reshape(b * n, d), w_router, w_exp_gate_up, w_exp_down).reshape(b, n, d)
    return x + g_f * y


def setup_inputs(seed: int = 0) -> dict:
    key = jax.random.key(seed)
    keys = jax.random.split(key, 32)
    d = D_MODEL

    def nrm(i, shape, scale):
        return scale * jax.random.normal(keys[i], shape, jnp.float32)

    ret_init = jnp.asarray(np.log(2.0 ** np.linspace(RET_MIN_EXP, RET_MAX_EXP, RET_HEADS) - 1.0), jnp.float32)
    return {
        'x': nrm(0, (BATCH, SEQ, d), 1.0),
        'c': nrm(1, (BATCH, d), 1.0),
        'ctx': nrm(2, (BATCH, CTX_LEN, d), 1.0),
        'c_ctx': nrm(3, (d,), 1.0),
        'l0_norm_mix': 1.0 + nrm(4, (d,), 0.05),
        'l0_norm_ffn': 1.0 + nrm(5, (d,), 0.05),
        'l0_w_ada': nrm(6, (d, 6 * d), 0.5 * d ** -0.5),
        'l0_b_ada': nrm(7, (6 * d,), 0.02),
        'l0_w_in': nrm(8, (d, IN_WIDTH), d ** -0.5),
        'l0_q_gain': 1.0 + nrm(9, (NA_HEAD_DIM,), 0.05),
        'l0_k_gain': 1.0 + nrm(10, (NA_HEAD_DIM,), 0.05),
        'l0_rpb': nrm(11, (NA_HEADS, 2 * NA_WIN_ROWS - 1, 2 * NA_WIN_COLS - 1), 0.2),
        'l0_ret_decay_fwd': ret_init + nrm(12, (RET_HEADS,), 0.1),
        'l0_ret_decay_bwd': ret_init + nrm(13, (RET_HEADS,), 0.1),
        'l0_w_out': nrm(14, (MIX_WIDTH, d), MIX_WIDTH ** -0.5),
        'l0_w_gate_up': nrm(15, (d, 2 * FFN_DIM), d ** -0.5),
        'l0_w_down': nrm(16, (FFN_DIM, d), FFN_DIM ** -0.5),
        'l1_norm_mix': 1.0 + nrm(17, (d,), 0.05),
        'l1_norm_ffn': 1.0 + nrm(18, (d,), 0.05),
        'l1_w_ada': nrm(19, (d, 6 * d), 0.5 * d ** -0.5),
        'l1_b_ada': nrm(20, (6 * d,), 0.02),
        'l1_w_fourier': nrm(21, (d, d), d ** -0.5),
        'l1_w_router': nrm(22, (d, N_EXPERTS), d ** -0.5),
        'l1_w_exp_gate_up': nrm(23, (N_EXPERTS, d, 2 * EXPERT_DIM), d ** -0.5),
        'l1_w_exp_down': nrm(24, (N_EXPERTS, EXPERT_DIM, d), EXPERT_DIM ** -0.5),
    }


def reference(x, c, ctx, c_ctx,
              l0_norm_mix, l0_norm_ffn, l0_w_ada, l0_b_ada, l0_w_in, l0_q_gain, l0_k_gain, l0_rpb,
              l0_ret_decay_fwd, l0_ret_decay_bwd, l0_w_out, l0_w_gate_up, l0_w_down,
              l1_norm_mix, l1_norm_ffn, l1_w_ada, l1_b_ada, l1_w_fourier, l1_w_router,
              l1_w_exp_gate_up, l1_w_exp_down):
    layers = (
        (l0_norm_mix, l0_norm_ffn, l0_w_ada, l0_b_ada, l0_w_in, l0_q_gain, l0_k_gain, l0_rpb,
         l0_ret_decay_fwd, l0_ret_decay_bwd, l0_w_out, l0_w_gate_up, l0_w_down),
        (l1_norm_mix, l1_norm_ffn, l1_w_ada, l1_b_ada, l1_w_fourier, l1_w_router,
         l1_w_exp_gate_up, l1_w_exp_down),
    )
    for layer in range(DEPTH):
        if layer % 2 == 0:
            x = even_layer(x, c, ctx, c_ctx, *layers[layer])
        else:
            x = odd_layer(x, c, *layers[layer])
    return x
```

```cpp
#include <hip/hip_runtime.h>
#include <hip/hip_cooperative_groups.h>
#include <cstdio>
#include <cstdint>
namespace cg = cooperative_groups;

#ifndef MK_SPLIT
#define MK_SPLIT 0
#endif
#ifndef DBG_MASK
#define DBG_MASK 0
#endif

#define FP8_DIAG 0
#define USE_FP8 1
#define USE_FP8_FFN2 0
#define USE_FP8_FFN 0
#define LAS __attribute__((address_space(3)))
typedef unsigned short bf16_t;
typedef short bf16x8 __attribute__((ext_vector_type(8)));
typedef float f32x4 __attribute__((ext_vector_type(4)));
typedef float f32x2 __attribute__((ext_vector_type(2)));
typedef unsigned u32x4 __attribute__((ext_vector_type(4)));
typedef unsigned u32x2 __attribute__((ext_vector_type(2)));

constexpr int D = 1024, NBATCH = 4, SEQ = 8192, T = NBATCH * SEQ, CTXL = 256, TX = NBATCH * CTXL;
constexpr int INW = 3072, KVW = 1792;
constexpr int C_NAQ = 0, C_RQ = 512, C_RG = 768, C_NAK = 1280, C_NAV = 1792, C_RK = 2304, C_RV = 2560;
constexpr int X_NAK = 0, X_NAV = 512, X_RK = 1024, X_RV = 1280;
constexpr int FFN = 2816, NE = 8, EDIM = 3584;
constexpr int MOE_TILES = 264, NSLOTS = MOE_TILES * 256;
constexpr int NCHUNK = 64, NCC = 66;
constexpr float EPS = 1e-6f;

constexpr size_t AL(size_t x) { return (x + 255) & ~(size_t)255; }
constexpr size_t WS_WT_IN = 0;
constexpr size_t WS_WT_OUT = WS_WT_IN + (size_t)INW * D * 2;
constexpr size_t WS_WT_GU = WS_WT_OUT + (size_t)D * D * 2;
constexpr size_t WS_WT_DOWN = WS_WT_GU + (size_t)2 * FFN * D * 2;
constexpr size_t WS_WT_FOUR = WS_WT_DOWN + (size_t)D * FFN * 2;
constexpr size_t WS_WT_EGU = WS_WT_FOUR + (size_t)D * D * 2;
constexpr size_t WS_WT_EDOWN = WS_WT_EGU + (size_t)NE * 2 * EDIM * D * 2;
constexpr size_t WS_WC = WS_WT_EDOWN + (size_t)NE * D * EDIM * 2;
constexpr size_t WS_WC2 = WS_WC + (size_t)2048 * 1024 * 2;
constexpr size_t WS_M1 = WS_WC2 + (size_t)256 * 128 * 2;
constexpr size_t WS_M3 = WS_M1 + (size_t)256 * 256 * 2;
constexpr size_t WS_TW = WS_M3 + (size_t)256 * 512 * 2;
constexpr size_t WS_BAR = WS_TW + (size_t)128 * 64 * 8;
constexpr size_t WS_ADA0 = WS_BAR + 16384;
constexpr size_t WS_ADA1 = WS_ADA0 + AL(5 * 6144 * 4);
constexpr size_t WS_HIST = WS_ADA1 + AL(4 * 6144 * 4);
constexpr size_t WS_TOKE = WS_HIST + AL(256 * 8 * 4);
constexpr size_t WS_TOKG = WS_TOKE + AL((size_t)T * 4);
constexpr size_t WS_TOKS = WS_TOKG + AL((size_t)T * 8);
constexpr size_t WS_SLTOK = WS_TOKS + AL((size_t)T * 8);
constexpr size_t WS_SLGATE = WS_SLTOK + AL((size_t)NSLOTS * 4);
constexpr size_t WS_H = WS_SLGATE + AL((size_t)NSLOTS * 4);
constexpr size_t WS_HX = WS_H + (size_t)T * D * 2;
constexpr size_t WS_B = WS_HX + (size_t)TX * D * 2;
constexpr size_t B_PROJ = 0;
constexpr size_t B_ACT = 0;
constexpr size_t B_PROJX = B_PROJ + (size_t)T * INW * 2;
constexpr size_t B_MIXIN = B_PROJX + (size_t)TX * KVW * 2;
constexpr size_t B_U = B_MIXIN + (size_t)T * D * 2;
constexpr size_t B_S = B_U + (size_t)2 * 16 * NCC * 8192 * 4;
constexpr size_t B_NAVT = B_S + (size_t)2 * 16 * NCHUNK * 8192 * 2;
constexpr size_t B_RETVT = B_NAVT + (size_t)NBATCH * 512 * SEQ * 2;
constexpr size_t B_RETKT = B_RETVT + (size_t)NBATCH * 512 * SEQ * 2;
constexpr size_t B_RKR = B_RETKT + (size_t)NBATCH * 256 * SEQ * 2;
constexpr size_t B_NAVXT = B_RKR + (size_t)T * 256 * 2;
constexpr size_t B_RETVXT = B_NAVXT + (size_t)NBATCH * 512 * CTXL * 2;
constexpr size_t B_RETKXT = B_RETVXT + (size_t)NBATCH * 512 * CTXL * 2;
constexpr size_t B_L0_END = B_RETKXT + (size_t)NBATCH * 256 * CTXL * 2;
constexpr size_t B_ZT = 0;
constexpr size_t B_T2 = B_ZT + (size_t)NBATCH * 2048 * SEQ * 2;
constexpr size_t B_FOUR = B_T2 + (size_t)NBATCH * 2048 * SEQ * 2;
constexpr size_t B_F_END = B_FOUR + (size_t)T * D * 2;
constexpr size_t B_ACTE = 0;
constexpr size_t B_H8S = (size_t)256 << 20;
constexpr size_t B_Y = B_ACTE + (size_t)NSLOTS * EDIM * 2;
constexpr size_t B_M_END = B_Y + (size_t)NSLOTS * D * 2;
constexpr size_t BMAX1 = B_L0_END > B_F_END ? B_L0_END : B_F_END;
constexpr size_t WS_END = WS_B + (BMAX1 > B_M_END ? BMAX1 : B_M_END);

constexpr int LDS_GEMM = 131072, LDS_TOTAL = LDS_GEMM + 512;

struct Params {
    const float* in[25];
    float* out;
    unsigned char* ws;
    int ph_lo, ph_hi;
};

typedef __bf16 bf16x2_t __attribute__((ext_vector_type(2)));
__device__ __forceinline__ unsigned pk2(float lo, float hi) { const f32x2 v = {lo, hi}; const bf16x2_t r = __builtin_convertvector(v, bf16x2_t); return __builtin_bit_cast(unsigned, r); }
__device__ __forceinline__ float bflo(unsigned w) { return __uint_as_float(w << 16); }
__device__ __forceinline__ float bfhi(unsigned w) { return __uint_as_float(w & 0xffff0000u); }
__device__ __forceinline__ bf16_t f2bf(float f) { return (bf16_t)(pk2(f, 0.f) & 0xffffu); }
__device__ __forceinline__ float wave_sum(float v) {
#pragma unroll
    for (int o = 1; o < 64; o <<= 1) v += __shfl_xor(v, o);
    return v;
}
__device__ __forceinline__ float silu_f(float g) { return g * __builtin_amdgcn_rcpf(1.0f + __expf(-g)); }
__device__ __forceinline__ f32x4 mfma16(u32x4 a, u32x4 b, f32x4 c) {
    return __builtin_amdgcn_mfma_f32_16x16x32_bf16(__builtin_bit_cast(bf16x8, a), __builtin_bit_cast(bf16x8, b), c, 0, 0, 0);
}
__device__ __forceinline__ void lds_add(LAS int* p, int v) { __hip_atomic_fetch_add((int*)p, v, __ATOMIC_RELAXED, __HIP_MEMORY_SCOPE_WORKGROUP); }
__device__ __forceinline__ void unpack8(const u32x4 w, float (&x)[8]) {
    x[0] = bflo(w.x); x[1] = bfhi(w.x); x[2] = bflo(w.y); x[3] = bfhi(w.y); x[4] = bflo(w.z); x[5] = bfhi(w.z); x[6] = bflo(w.w); x[7] = bfhi(w.w);
}
__device__ __forceinline__ u32x4 pack8(const float (&x)[8]) { return (u32x4){pk2(x[0], x[1]), pk2(x[2], x[3]), pk2(x[4], x[5]), pk2(x[6], x[7])}; }
__device__ __forceinline__ int otid() { int t = threadIdx.x; asm volatile("" : "+v"(t)); return t; }
typedef int i32x8 __attribute__((ext_vector_type(8)));
typedef int u32x4i __attribute__((ext_vector_type(4)));
__device__ __forceinline__ float clamp448(float x) { return __builtin_amdgcn_fmed3f(x, -448.0f, 448.0f); }
__device__ __forceinline__ unsigned pk4_fp8(float a, float b, float c, float d) {
    int w = 0; w = __builtin_amdgcn_cvt_pk_fp8_f32(clamp448(a), clamp448(b), w, false); w = __builtin_amdgcn_cvt_pk_fp8_f32(clamp448(c), clamp448(d), w, true); return (unsigned)w; }
constexpr float S_W8 = 64.0f, S_A8 = 4.0f, DESCALE8 = 1.0f / (S_W8 * S_A8);
#define LDS_WAIT() asm volatile("s_waitcnt lgkmcnt(0)" ::: "memory")

namespace g8 {
constexpr int BM = 256, BK = 64, HALF = 128, HTB = HALF * BK * 2, NXCD = 8, WGM = 8;
__device__ __forceinline__ int lds_byte(int r, int c) { const int st = (r >> 4) * 2 + (c >> 5), rr = r & 15, cc = c & 31, ob = rr * 64 + cc * 2; return st * 1024 + (ob ^ (((ob >> 9) & 1) << 5)); }
__device__ __forceinline__ void stage_rc(int b, int& R, int& C) { const int st = b / 1024, sb = b % 1024, swz = sb ^ (((sb >> 9) & 1) << 5); R = (st >> 1) * 16 + swz / 64; C = (st & 1) * 32 + (swz % 64) / 2; }
__device__ __forceinline__ int perm32(int rho) { const int n = rho >> 4, i = rho & 15; return 8 * (i >> 2) + 4 * n + (i & 3); }

struct Unit { const char* A; const char* B; int pm, pn, z; };

__device__ __forceinline__ void remap(int w, int nM, int nN, int& pm, int& pn) {
    const int nwg = nM * nN; int wgid = w;
    { const int q = nwg / NXCD, r = nwg % NXCD, xcd = wgid % NXCD, off = wgid / NXCD; wgid = (xcd < r ? xcd * (q + 1) : r * (q + 1) + (xcd - r) * q) + off; }
    const int nig = WGM * nN, gid = wgid / nig, fm = gid * WGM, gsz = (nM - fm) < WGM ? (nM - fm) : WGM;
    pm = fm + ((wgid % nig) % gsz); pn = (wgid % nig) / gsz;
}

struct DenseSched {
    const char* A; const char* B; size_t azs, bzs, aps, bps; int nM, nN, nz, G, c;
    __device__ __forceinline__ bool next(int i, Unit& u) const {
        const long L = (long)i * G + c; const int per = nM * nN; if (L >= (long)per * nz) return false;
        const int z = (int)(L / per), w = (int)(L % per); int pm, pn; remap(w, nM, nN, pm, pn);
        u.pm = pm; u.pn = pn; u.z = z; u.A = A + z * azs + (size_t)pm * aps; u.B = B + z * bzs + (size_t)pn * bps; return true;
    }
};
struct InProjSched {
    const char* H; const char* HX; const char* W; int G, c;
    __device__ __forceinline__ bool next(int i, Unit& u) const {
        const long L = (long)i * G + c; const int n0 = 128 * 12;
        if (L < n0) { int pm, pn; remap((int)L, 128, 12, pm, pn); u.pm = pm; u.pn = pn; u.z = 0; u.A = H + (size_t)pm * 256 * D * 2; u.B = W + (size_t)pn * 256 * D * 2; return true; }
        const int w = (int)(L - n0); if (w >= 28) return false;
        u.pm = w / 7; u.pn = w % 7; u.z = 1; u.A = HX + (size_t)u.pm * 256 * D * 2; u.B = W + (size_t)(1280 + u.pn * 256) * D * 2; return true;
    }
};
struct FourASched {
    const char* A; const char* H; int G, c;
    __device__ __forceinline__ bool next(int i, Unit& u) const {
        const long L = (long)i * G + c; if (L >= 1024) return false;
        const int pn = (int)(L & 31), g = (int)((L >> 5) & 7), b = (int)(L >> 8);
        u.pm = 0; u.pn = pn; u.z = b * 8 + g; u.A = A; u.B = H + (size_t)b * SEQ * D * 2 + (size_t)pn * 2 * D * 2 + g * 256; return true;
    }
};
struct MoeSched {
    const char* A; const char* W; size_t wes; int lda, ldb, nM, nN, G, c; int pe0, pe1, pe2, pe3, pe4, pe5, pe6, pe7; bool gather;
    __device__ __forceinline__ bool next(int i, Unit& u) const {
        const long L = (long)i * G + c; if (L >= (long)nM * nN) return false;
        int pm, pn; remap((int)L, nM, nN, pm, pn);
        const int e = (pm >= pe0) + (pm >= pe1) + (pm >= pe2) + (pm >= pe3) + (pm >= pe4) + (pm >= pe5) + (pm >= pe6);
        u.pm = pm; u.pn = pn; u.z = e; u.A = gather ? A : A + (size_t)pm * 256 * lda; u.B = W + e * wes + (size_t)pn * 256 * ldb; return true;
    }
};

template <class Epi, class Sched, bool GATHER, bool FP8 = false>
__device__ __forceinline__ void gemm_phase(LAS unsigned char* lds, const int K_, const int lda, const int ldb, const Sched& S, const Epi& E, const int* __restrict__ rowidx, const size_t hstepB_) {
    int tid = threadIdx.x; asm volatile("" : "+v"(tid));
    const int wid = __builtin_amdgcn_readfirstlane(tid >> 6), lane = tid & 63, wr = wid >> 2, wc = wid & 3, fr = lane & 15, fq = lane >> 4;
    int K = K_; asm volatile("" : "+s"(K));
    const int nt = K / (BK * 2);
    int Rr[2], Cc[2]; unsigned voffB[2];
#pragma unroll
    for (int i = 0; i < 2; ++i) { int R, C; stage_rc(tid * 16 + i * 8192, R, C); const int Rb = Epi::PERM ? ((R & ~31) + perm32(R & 31)) : R;
        Rr[i] = R; Cc[i] = C; voffB[i] = (unsigned)(Rb * ldb + C * 2); }
    const size_t kstep = (size_t)(BK * 2);
    const size_t hstepB = hstepB_ ? hstepB_ : (size_t)HALF * ldb;
    const unsigned ldsw = (unsigned)wid * 1024u;
    const int aoff = lds_byte(wr * 64 + fr, fq * 8), boff = lds_byte(wc * 32 + fr, fq * 8);
#define G8_SA(b, h) (((b) * 2 + (h)) * HTB)
#define G8_SB(b, h) ((4 + (b) * 2 + (h)) * HTB)
#define G8_STAGE(bufoff, gbase, voff) do { _Pragma("unroll") for (int _i = 0; _i < 2; ++_i) \
        __builtin_amdgcn_global_load_lds((const unsigned*)((const char*)(gbase) + (voff)[_i]), (LAS unsigned*)(lds + (bufoff) + ldsw + _i * 8192), 16, 0, 0); } while (0)
#define G8_LDA(dst, b, h) do { _Pragma("unroll") for (int m = 0; m < 4; ++m) { const u32x4i l_ = *(const LAS u32x4i*)(lds + G8_SA(b, h) + aoff + m * 2048), h_ = *(const LAS u32x4i*)(lds + G8_SA(b, h) + aoff + m * 2048 + 1024); \
        dst[m] = __builtin_shufflevector(l_, h_, 0, 1, 2, 3, 4, 5, 6, 7); } } while (0)
#define G8_LDB(dst, b, h) do { _Pragma("unroll") for (int n = 0; n < 2; ++n) { const u32x4i l_ = *(const LAS u32x4i*)(lds + G8_SB(b, h) + boff + n * 2048), h_ = *(const LAS u32x4i*)(lds + G8_SB(b, h) + boff + n * 2048 + 1024); \
        dst[n] = __builtin_shufflevector(l_, h_, 0, 1, 2, 3, 4, 5, 6, 7); } } while (0)
#define G8_LO(v) __builtin_bit_cast(bf16x8, __builtin_shufflevector(v, v, 0, 1, 2, 3))
#define G8_HI(v) __builtin_bit_cast(bf16x8, __builtin_shufflevector(v, v, 4, 5, 6, 7))
#define G8_MMA(ai, bj, At, Bt) do { __builtin_amdgcn_s_setprio(1); _Pragma("unroll") for (int m = 0; m < 4; ++m) _Pragma("unroll") for (int n = 0; n < 2; ++n) { \
        if constexpr (FP8) { if (FP8_DIAG) { typedef long l4 __attribute__((ext_vector_type(4))); const l4 bb = __builtin_bit_cast(l4, Bt[n]), aa = __builtin_bit_cast(l4, At[m]); \
            _Pragma("unroll") for (int q = 0; q < 4; ++q) acc[ai][bj][m][n] = __builtin_amdgcn_mfma_f32_16x16x32_fp8_fp8(bb[q], aa[q], acc[ai][bj][m][n], 0, 0, 0); } \
          else asm volatile("v_mfma_f32_16x16x128_f8f6f4 %0, %1, %2, %0" : "+v"(acc[ai][bj][m][n]) : "v"(Bt[n]), "v"(At[m])); } \
        else { acc[ai][bj][m][n] = __builtin_amdgcn_mfma_f32_16x16x32_bf16(G8_LO(Bt[n]), G8_LO(At[m]), acc[ai][bj][m][n], 0, 0, 0); \
               acc[ai][bj][m][n] = __builtin_amdgcn_mfma_f32_16x16x32_bf16(G8_HI(Bt[n]), G8_HI(At[m]), acc[ai][bj][m][n], 0, 0, 0); } } \
        __builtin_amdgcn_s_setprio(0); } while (0)
#define G8_WAIT_V(n) asm volatile("s_waitcnt vmcnt(" #n ")" ::: "memory")
#define G8_WAIT_L(n) asm volatile("s_waitcnt lgkmcnt(" #n ")" ::: "memory")
#define G8_BAR __builtin_amdgcn_s_barrier()
#define G8_SCHED __builtin_amdgcn_sched_barrier(0)
    Unit cur, nxt; int ui = 0;
    if (!S.next(0, cur)) return;
    unsigned ca[2][2], na[2][2];
#pragma unroll
    for (int h = 0; h < 2; ++h)
#pragma unroll
        for (int i = 0; i < 2; ++i) {
            if constexpr (GATHER) ca[h][i] = (unsigned)rowidx[cur.pm * 256 + h * 128 + Rr[i]] * (unsigned)lda + (unsigned)(Cc[i] * 2);
            else ca[h][i] = (unsigned)((h * 128 + Rr[i]) * lda + Cc[i] * 2);
            na[h][i] = ca[h][i];
        }
    f32x4 acc[2][2][4][2];
#pragma unroll
    for (int a = 0; a < 2; ++a)
#pragma unroll
        for (int b = 0; b < 2; ++b)
#pragma unroll
            for (int m = 0; m < 4; ++m)
#pragma unroll
                for (int n = 0; n < 2; ++n) acc[a][b][m][n] = (f32x4){0.f, 0.f, 0.f, 0.f};
    i32x8 At[4], B0[2], B1[2];
    const char* cA = cur.A; const char* cB = cur.B;
    G8_STAGE(G8_SB(0, 0), cB, voffB); G8_STAGE(G8_SB(0, 1), cB + hstepB, voffB); G8_STAGE(G8_SA(0, 0), cA, ca[0]); G8_STAGE(G8_SA(0, 1), cA, ca[1]);
    if (wr == 1) G8_BAR;
    G8_WAIT_V(2); G8_BAR;
    G8_STAGE(G8_SB(1, 0), cB + kstep, voffB); G8_STAGE(G8_SA(1, 0), cA + kstep, ca[0]); G8_STAGE(G8_SB(1, 1), cB + hstepB + kstep, voffB);
    G8_WAIT_V(6); G8_BAR;
    for (;;) {
        const bool has_next = S.next(ui + 1, nxt);
        const char* nA = has_next ? nxt.A : cA; const char* nB = has_next ? nxt.B : cB;
        if constexpr (GATHER) {
            if (has_next) {
#pragma unroll
                for (int h = 0; h < 2; ++h)
#pragma unroll
                    for (int i = 0; i < 2; ++i) na[h][i] = (unsigned)rowidx[nxt.pm * 256 + h * 128 + Rr[i]] * (unsigned)lda + (unsigned)(Cc[i] * 2);
            }
        }
        for (int t = 0; t < nt; t += 2) {
            const bool last = (t == nt - 2);
            const char* a1 = cA + (size_t)(t + 1) * kstep;
            const char* a2 = last ? nA : cA + (size_t)(t + 2) * kstep; const char* b2 = last ? nB : cB + (size_t)(t + 2) * kstep;
            const char* a3 = a2 + kstep; const char* b3 = b2 + kstep;
            unsigned o2[2][2];
#pragma unroll
            for (int h = 0; h < 2; ++h)
#pragma unroll
                for (int i = 0; i < 2; ++i) { if constexpr (GATHER) o2[h][i] = last ? na[h][i] : ca[h][i]; else o2[h][i] = ca[h][i]; }
            G8_LDB(B0, 0, 0); G8_LDB(B1, 0, 1); G8_SCHED; G8_LDA(At, 0, 0); G8_STAGE(G8_SA(1, 1), a1, ca[1]);
            G8_WAIT_V(8); G8_WAIT_L(0); G8_BAR; G8_MMA(0, 0, At, B0); G8_MMA(0, 1, At, B1); G8_BAR; G8_SCHED;
            G8_LDA(At, 0, 1); G8_STAGE(G8_SB(0, 0), b2, voffB); G8_STAGE(G8_SB(0, 1), b2 + hstepB, voffB); G8_STAGE(G8_SA(0, 0), a2, o2[0]);
            G8_WAIT_V(8); G8_WAIT_L(0); G8_BAR; G8_MMA(1, 0, At, B0); G8_MMA(1, 1, At, B1); G8_BAR; G8_SCHED;
            G8_LDB(B0, 1, 0); G8_LDB(B1, 1, 1); G8_SCHED; G8_LDA(At, 1, 0); G8_STAGE(G8_SA(0, 1), a2, o2[1]);
            G8_WAIT_V(8); G8_WAIT_L(0); G8_BAR; G8_MMA(0, 0, At, B0); G8_MMA(0, 1, At, B1); G8_BAR; G8_SCHED;
            G8_LDA(At, 1, 1); G8_STAGE(G8_SB(1, 0), b3, voffB); G8_STAGE(G8_SB(1, 1), b3 + hstepB, voffB); G8_STAGE(G8_SA(1, 0), a3, o2[0]);
            G8_WAIT_V(8); G8_WAIT_L(0); G8_BAR; G8_MMA(1, 0, At, B0); G8_MMA(1, 1, At, B1); G8_BAR; G8_SCHED;
        }
        if (wr == 0) G8_BAR;
        E(acc, cur, wr, wc, fr, fq);
        if (!has_next) break;
#pragma unroll
        for (int a = 0; a < 2; ++a)
#pragma unroll
            for (int b = 0; b < 2; ++b)
#pragma unroll
                for (int m = 0; m < 4; ++m)
#pragma unroll
                    for (int n = 0; n < 2; ++n) acc[a][b][m][n] = (f32x4){0.f, 0.f, 0.f, 0.f};
        cur = nxt; cA = nA; cB = nB; ++ui;
        if (wr == 1) G8_BAR;
        if constexpr (GATHER) {
#pragma unroll
            for (int h = 0; h < 2; ++h)
#pragma unroll
                for (int i = 0; i < 2; ++i) ca[h][i] = na[h][i];
        }
    }
    G8_WAIT_V(0);
    G8_BAR;
#undef G8_SA
#undef G8_SB
#undef G8_STAGE
#undef G8_LDA
#undef G8_LDB
#undef G8_LO
#undef G8_HI
#undef G8_MMA
#undef G8_WAIT_V
#undef G8_WAIT_L
#undef G8_BAR
#undef G8_SCHED
}

struct EpiStoreBf16 {
    static constexpr bool PERM = true;
    bf16_t* O0; bf16_t* O1; int ldc0, ldc1; size_t zs; float scale; bool inproj;
    __device__ __forceinline__ void operator()(const f32x4 (&acc)[2][2][4][2], const Unit& u, int wr, int wc, int fr, int fq) const {
        bf16_t* base; int ldc;
        if (inproj) { base = u.z ? O1 : O0; ldc = u.z ? ldc1 : ldc0; } else { base = O0 + u.z * zs; ldc = ldc0; }
        const int row0 = u.pm * BM + wr * 64 + fr, col0 = u.pn * BM + wc * 32 + 8 * fq;
#pragma unroll
        for (int ai = 0; ai < 2; ++ai)
#pragma unroll
            for (int m = 0; m < 4; ++m) { bf16_t* rowp = base + (size_t)(row0 + ai * HALF + m * 16) * ldc + col0;
#pragma unroll
                for (int bj = 0; bj < 2; ++bj) { const f32x4 v0 = acc[ai][bj][m][0] * scale, v1 = acc[ai][bj][m][1] * scale;
                    u32x4 w; w.x = pk2(v0[0], v0[1]); w.y = pk2(v0[2], v0[3]); w.z = pk2(v1[0], v1[1]); w.w = pk2(v1[2], v1[3]);
                    *(u32x4*)(rowp + bj * HALF) = w; } }
    }
};
struct EpiResid {
    static constexpr bool PERM = false;
    float* out; const float* resid; const float* gate; bool zero; float ascale;
    __device__ __forceinline__ void operator()(const f32x4 (&acc)[2][2][4][2], const Unit& u, int wr, int wc, int fr, int fq) const {
        const int row0 = u.pm * BM + wr * 64 + fr, col0 = u.pn * BM + wc * 32 + 4 * fq;
        const float* gp = gate + (size_t)(row0 >> 13) * 6144 + col0;
        f32x4 gv[2][2];
#pragma unroll
        for (int bj = 0; bj < 2; ++bj)
#pragma unroll
            for (int n = 0; n < 2; ++n) { gv[bj][n] = *(const f32x4*)(gp + bj * HALF + n * 16) * ascale; if (zero) gv[bj][n] = (f32x4){0.f, 0.f, 0.f, 0.f}; }
#pragma unroll
        for (int ai = 0; ai < 2; ++ai)
#pragma unroll
            for (int m = 0; m < 4; ++m) { const size_t ro = (size_t)(row0 + ai * HALF + m * 16) * D + col0;
#pragma unroll
                for (int bj = 0; bj < 2; ++bj)
#pragma unroll
                    for (int n = 0; n < 2; ++n) { const f32x4 r = *(const f32x4*)(resid + ro + bj * HALF + n * 16);
                        *(f32x4*)(out + ro + bj * HALF + n * 16) = r + gv[bj][n] * acc[ai][bj][m][n]; } }
    }
};
struct EpiSwiglu {
    static constexpr bool PERM = true;
    bf16_t* O; int ldc;
    __device__ __forceinline__ void operator()(const f32x4 (&acc)[2][2][4][2], const Unit& u, int wr, int wc, int fr, int fq) const {
        const int row0 = u.pm * BM + wr * 64 + fr, col0 = u.pn * HALF + wc * 32 + 8 * fq;
#pragma unroll
        for (int ai = 0; ai < 2; ++ai)
#pragma unroll
            for (int m = 0; m < 4; ++m) { bf16_t* rowp = O + (size_t)(row0 + ai * HALF + m * 16) * ldc + col0;
                float v[8];
#pragma unroll
                for (int n = 0; n < 2; ++n)
#pragma unroll
                    for (int j = 0; j < 4; ++j) v[n * 4 + j] = silu_f(acc[ai][0][m][n][j]) * acc[ai][1][m][n][j];
                u32x4 w; w.x = pk2(v[0], v[1]); w.y = pk2(v[2], v[3]); w.z = pk2(v[4], v[5]); w.w = pk2(v[6], v[7]);
                *(u32x4*)rowp = w; }
    }
};
struct EpiSwiglu8 {
    static constexpr bool PERM = true;
    unsigned char* O; int ldc; float dsc;
    __device__ __forceinline__ void operator()(const f32x4 (&acc)[2][2][4][2], const Unit& u, int wr, int wc, int fr, int fq) const {
        const int row0 = u.pm * BM + wr * 64 + fr, col0 = u.pn * HALF + wc * 32 + 8 * fq;
#pragma unroll
        for (int ai = 0; ai < 2; ++ai)
#pragma unroll
            for (int m = 0; m < 4; ++m) { unsigned char* rowp = O + (size_t)(row0 + ai * HALF + m * 16) * ldc + col0;
                float v[8];
#pragma unroll
                for (int n = 0; n < 2; ++n)
#pragma unroll
                    for (int j = 0; j < 4; ++j) v[n * 4 + j] = silu_f(acc[ai][0][m][n][j] * dsc) * (acc[ai][1][m][n][j] * (dsc * S_A8));
                *(u32x2*)rowp = (u32x2){pk4_fp8(v[0], v[1], v[2], v[3]), pk4_fp8(v[4], v[5], v[6], v[7])}; }
    }
};
struct EpiMoeDown {
    static constexpr bool PERM = true;
    bf16_t* Y; const float* sg;
    __device__ __forceinline__ void operator()(const f32x4 (&acc)[2][2][4][2], const Unit& u, int wr, int wc, int fr, int fq) const {
        const int row0 = u.pm * BM + wr * 64 + fr, col0 = u.pn * BM + wc * 32 + 8 * fq;
#pragma unroll
        for (int ai = 0; ai < 2; ++ai)
#pragma unroll
            for (int m = 0; m < 4; ++m) { const int row = row0 + ai * HALF + m * 16; const float g = sg[row] * (USE_FP8 ? DESCALE8 : 1.0f); bf16_t* rowp = Y + (size_t)row * D + col0;
#pragma unroll
                for (int bj = 0; bj < 2; ++bj) { const f32x4 v0 = acc[ai][bj][m][0] * g, v1 = acc[ai][bj][m][1] * g;
                    u32x4 w; w.x = pk2(v0[0], v0[1]); w.y = pk2(v0[2], v0[3]); w.z = pk2(v1[0], v1[1]); w.w = pk2(v1[2], v1[3]);
                    *(u32x4*)(rowp + bj * HALF) = w; } }
    }
};
struct EpiFA {
    static constexpr bool PERM = true;
    bf16_t* O;
    __device__ __forceinline__ void operator()(const f32x4 (&acc)[2][2][4][2], const Unit& u, int wr, int wc, int fr, int fq) const {
        const int row0 = u.pm * BM + wr * 64 + fr, n1 = wc * 32 + 8 * fq;
#pragma unroll
        for (int ai = 0; ai < 2; ++ai)
#pragma unroll
            for (int m = 0; m < 4; ++m) { const int r = row0 + ai * HALF + m * 16, ch = r >> 1, part = r & 1;
#pragma unroll
                for (int bj = 0; bj < 2; ++bj) { const int n2 = 2 * u.pn + bj; const f32x4 v0 = acc[ai][bj][m][0], v1 = acc[ai][bj][m][1];
                    u32x4 w; w.x = pk2(v0[0], v0[1]); w.y = pk2(v0[2], v0[3]); w.z = pk2(v1[0], v1[1]); w.w = pk2(v1[2], v1[3]);
                    *(u32x4*)(O + ((size_t)(u.z * 1024 + ch) * 64 + n2) * 256 + part * 128 + n1) = w; } }
    }
};
struct EpiFA2 {
    static constexpr bool PERM = true;
    bf16_t* O;
    __device__ __forceinline__ void operator()(const f32x4 (&acc)[2][2][4][2], const Unit& u, int wr, int wc, int fr, int fq) const {
        const int row0 = wr * 64 + fr, n1 = wc * 32 + 8 * fq, b = u.z >> 3, g = u.z & 7;
#pragma unroll
        for (int ai = 0; ai < 2; ++ai)
#pragma unroll
            for (int m = 0; m < 4; ++m) { const int r = row0 + ai * HALF + m * 16, ch = g * 128 + (r >> 1), part = r & 1;
#pragma unroll
                for (int bj = 0; bj < 2; ++bj) { const int n2 = 2 * u.pn + bj; const f32x4 v0 = acc[ai][bj][m][0], v1 = acc[ai][bj][m][1];
                    u32x4 w; w.x = pk2(v0[0], v0[1]); w.y = pk2(v0[2], v0[3]); w.z = pk2(v1[0], v1[1]); w.w = pk2(v1[2], v1[3]);
                    *(u32x4*)(O + ((size_t)(b * 1024 + ch) * 64 + n2) * 256 + part * 128 + n1) = w; } }
    }
};
struct EpiFB1 {
    static constexpr bool PERM = true;
    bf16_t* O; const float* tw;
    __device__ __forceinline__ void operator()(const f32x4 (&acc)[2][2][4][2], const Unit& u, int wr, int wc, int fr, int fq) const {
        const int n20 = (wc & 1) * 32 + 8 * fq;
#pragma unroll
        for (int m = 0; m < 4; ++m) { const int k1 = wr * 64 + m * 16 + fr;
#pragma unroll
            for (int n = 0; n < 2; ++n) {
                const float* tp = tw + (size_t)(k1 * 64 + n20 + 4 * n) * 2;
                const f32x4 t0 = *(const f32x4*)tp, t1 = *(const f32x4*)(tp + 4);
#pragma unroll
                for (int bj = 0; bj < 2; ++bj) { const int chg = u.pn * 4 + bj * 2 + (wc >> 1), b = chg >> 10, ch = chg & 1023;
                    const f32x4 R = acc[0][bj][m][n], I = acc[1][bj][m][n];
                    const float r0 = R[0] * t0[0] - I[0] * t0[1], i0 = R[0] * t0[1] + I[0] * t0[0], r1 = R[1] * t0[2] - I[1] * t0[3], i1 = R[1] * t0[3] + I[1] * t0[2];
                    const float r2 = R[2] * t1[0] - I[2] * t1[1], i2 = R[2] * t1[1] + I[2] * t1[0], r3 = R[3] * t1[2] - I[3] * t1[3], i3 = R[3] * t1[3] + I[3] * t1[2];
                    bf16_t* op = O + ((((size_t)(b * 32 + (k1 >> 2)) * 1024 + ch) * 4 + (k1 & 3)) * 2) * 64 + n20 + 4 * n;
                    *(u32x2*)op = (u32x2){pk2(r0, r1), pk2(r2, r3)}; *(u32x2*)(op + 64) = (u32x2){pk2(i0, i1), pk2(i2, i3)}; }
                __builtin_amdgcn_sched_barrier(0); } }
    }
};
struct EpiFB3 {
    static constexpr bool PERM = true;
    bf16_t* O; float scale;
    __device__ __forceinline__ void operator()(const f32x4 (&acc)[2][2][4][2], const Unit& u, int wr, int wc, int fr, int fq) const {
#pragma unroll
        for (int ai = 0; ai < 2; ++ai)
#pragma unroll
            for (int m = 0; m < 4; ++m) { const int k1sub = 2 * ai + wr, k2 = m * 16 + fr;
#pragma unroll
                for (int bj = 0; bj < 2; ++bj) { const int n = u.pn * BM + bj * HALF + wc * 32 + 8 * fq, ch = n & 1023, k1q = (n >> 10) & 31, b = n >> 15;
                    const f32x4 v0 = acc[ai][bj][m][0] * scale, v1 = acc[ai][bj][m][1] * scale;
                    u32x4 w; w.x = pk2(v0[0], v0[1]); w.y = pk2(v0[2], v0[3]); w.z = pk2(v1[0], v1[1]); w.w = pk2(v1[2], v1[3]);
                    *(u32x4*)(O + (size_t)(b * SEQ + 4 * k1q + k1sub + 128 * k2) * D + ch) = w; } }
    }
};
}

__device__ __forceinline__ void wtrans_tile(const float* __restrict__ W, int N, int k0, int n0, bf16_t* __restrict__ WT, int K, int dstrow0, LAS bf16_t* scr, int lane) {
#pragma unroll 4
    for (int it = 0; it < 16; ++it) { const int kk = it * 4 + (lane >> 4), c4 = (lane & 15) * 4;
        const f32x4 v = *(const f32x4*)(W + (size_t)(k0 + kk) * N + n0 + c4);
        scr[(c4 + 0) * 72 + kk] = f2bf(v[0]); scr[(c4 + 1) * 72 + kk] = f2bf(v[1]); scr[(c4 + 2) * 72 + kk] = f2bf(v[2]); scr[(c4 + 3) * 72 + kk] = f2bf(v[3]); }
    LDS_WAIT();
#pragma unroll
    for (int it = 0; it < 8; ++it) { const int n = it * 8 + (lane >> 3), kc = (lane & 7) * 8;
        const u32x4 o = *(const LAS u32x4*)(scr + n * 72 + kc);
        *(u32x4*)(WT + (size_t)(dstrow0 + n) * K + k0 + kc) = o; }
    LDS_WAIT();
}
__device__ __forceinline__ void wtrans_tile8(const float* __restrict__ W, int N, int k0, int n0, unsigned char* __restrict__ WT, int K, int dstrow0, LAS unsigned char* scr, int lane) {
#pragma unroll 4
    for (int it = 0; it < 16; ++it) { const int kk = it * 4 + (lane >> 4), c4 = (lane & 15) * 4;
        const f32x4 v = *(const f32x4*)(W + (size_t)(k0 + kk) * N + n0 + c4) * S_W8;
        const unsigned w = pk4_fp8(v[0], v[1], v[2], v[3]);
        scr[(c4 + 0) * 80 + kk] = (unsigned char)(w & 0xff); scr[(c4 + 1) * 80 + kk] = (unsigned char)((w >> 8) & 0xff); scr[(c4 + 2) * 80 + kk] = (unsigned char)((w >> 16) & 0xff); scr[(c4 + 3) * 80 + kk] = (unsigned char)(w >> 24); }
    LDS_WAIT();
#pragma unroll
    for (int it = 0; it < 4; ++it) { const int n = it * 16 + (lane >> 2), kc = (lane & 3) * 16;
        const u32x4 o = *(const LAS u32x4*)(scr + n * 80 + kc);
        *(u32x4*)(WT + (size_t)(dstrow0 + n) * K + k0 + kc) = o; }
    LDS_WAIT();
}
__device__ __forceinline__ int gu_row(int n, int F) { const int part = n >= F, f = n - part * F; return (f >> 7) * 256 + part * 128 + (f & 127); }

__device__ __forceinline__ void phase0(const Params& p, LAS unsigned char* lds) {
    const int tid = otid(), lane = tid & 63, wid = tid >> 6, G = gridDim.x;
    {
        LAS float* sc = (LAS float*)lds;
        LAS float* red = sc + 5 * 1024;
        for (int item = blockIdx.x; item < 192; item += G) {
            const int layer = item / 96, cchunk = item % 96;
            const float* W = p.in[layer ? 19 : 6]; const float* bias = p.in[layer ? 20 : 7];
            __syncthreads();
            for (int i = tid; i < 5 * 1024; i += 512) { const int v = i >> 10, k = i & 1023; const float c = (v < 4) ? p.in[1][v * 1024 + k] : p.in[3][k]; sc[i] = c / (1.0f + __expf(-c)); }
            __syncthreads();
            const int col = cchunk * 64 + (tid & 63), kg = tid >> 6;
            float a0 = 0.f, a1 = 0.f, a2 = 0.f, a3 = 0.f, a4 = 0.f;
#pragma unroll 8
            for (int k = kg * 128; k < kg * 128 + 128; ++k) { const float w = W[(size_t)k * 6144 + col];
                a0 += sc[k] * w; a1 += sc[1024 + k] * w; a2 += sc[2048 + k] * w; a3 += sc[3072 + k] * w; a4 += sc[4096 + k] * w; }
            red[(kg * 5 + 0) * 64 + (tid & 63)] = a0; red[(kg * 5 + 1) * 64 + (tid & 63)] = a1; red[(kg * 5 + 2) * 64 + (tid & 63)] = a2;
            red[(kg * 5 + 3) * 64 + (tid & 63)] = a3; red[(kg * 5 + 4) * 64 + (tid & 63)] = a4;
            __syncthreads();
            if (tid < 320) { const int v = tid >> 6, cl = tid & 63; float s = 0.f;
#pragma unroll
                for (int g = 0; g < 8; ++g) s += red[(g * 5 + v) * 64 + cl];
                s += bias[cchunk * 64 + cl];
                if (layer == 0) ((float*)(p.ws + WS_ADA0))[v * 6144 + cchunk * 64 + cl] = s;
                else if (v < 4) ((float*)(p.ws + WS_ADA1))[v * 6144 + cchunk * 64 + cl] = s; }
        }
        __syncthreads();
    }
    {
        bf16_t* WC = (bf16_t*)(p.ws + WS_WC);
        for (int i = blockIdx.x * 512 + tid; i < 2048 * 128; i += G * 512) { const int row = i >> 7, c8 = (i & 127) * 8; const int ch = row >> 1, part = row & 1, g = ch >> 7, m = ch & 127;
            unsigned w[4];
#pragma unroll
            for (int e = 0; e < 4; ++e) { float v[2];
#pragma unroll
                for (int q = 0; q < 2; ++q) { const int c = c8 + e * 2 + q; float sv, cv; sincospif((float)(((c & 127) * m) & 127) * (1.0f / 64.0f), &sv, &cv); v[q] = ((c >> 7) == g) ? (part ? sv : cv) : 0.f; }
                w[e] = pk2(v[0], v[1]); }
            *(u32x4*)(WC + (size_t)row * 1024 + c8) = (u32x4){w[0], w[1], w[2], w[3]}; }
    }
    {
        bf16_t* WC2 = (bf16_t*)(p.ws + WS_WC2);
        for (int i = blockIdx.x * 512 + tid; i < 256 * 128; i += G * 512) { const int r = i >> 7, c = i & 127, m = r >> 1, part = r & 1;
            float sv, cv; sincospif((float)((c * m) & 127) * (1.0f / 64.0f), &sv, &cv); WC2[i] = f2bf(part ? sv : cv); }
    }
    {
        bf16_t* M1 = (bf16_t*)(p.ws + WS_M1); bf16_t* M3 = (bf16_t*)(p.ws + WS_M3); float* TW = (float*)(p.ws + WS_TW);
        for (int i = blockIdx.x * 512 + tid; i < 256 * 256 + 256 * 512 + 128 * 64; i += G * 512) {
            if (i < 256 * 256) { const int r = i >> 8, kk = i & 255, k1 = r & 127, im = r >> 7, part = kk >> 7, n1 = kk & 127;
                float sv, cv; sincospif((float)((n1 * k1) & 127) * (1.0f / 64.0f), &sv, &cv);
                const float v = im == 0 ? (part == 0 ? cv : -sv) : (part == 0 ? sv : cv); M1[i] = f2bf(v);
            } else if (i < 256 * 256 + 256 * 512) { const int q = i - 256 * 256, r = q >> 9, kk = q & 511, k1s = r >> 6, k2 = r & 63, k1s2 = kk >> 7, part = (kk >> 6) & 1, n2 = kk & 63;
                float sv, cv; sincospif((float)((n2 * k2) & 63) * (1.0f / 32.0f), &sv, &cv);
                M3[q] = f2bf(k1s == k1s2 ? (part == 0 ? cv : -sv) : 0.f);
            } else { const int q = i - 256 * 256 - 256 * 512, k1 = q >> 6, n2 = q & 63;
                float sv, cv; sincospif((float)(n2 * k1) * (1.0f / 4096.0f), &sv, &cv); TW[2 * q] = cv; TW[2 * q + 1] = sv; }
        }
    }
    {
        LAS bf16_t* scr = (LAS bf16_t*)lds + wid * (64 * 72);
        constexpr int T_IN = 16 * 48, T_OUT = 16 * 16, T_GU = 16 * 88, T_DN = 44 * 16, T_FO = 16 * 16, T_EGU = 16 * 112, T_EDN = 56 * 16;
        constexpr int TOTAL = T_IN + T_OUT + T_GU + T_DN + T_FO + NE * T_EGU + NE * T_EDN;
        constexpr int NG = (TOTAL + 7) / 8;
        const int nb = blockIdx.x; const bool bal = (G == 256), spare = bal && nb >= 192;
        for (int rr = 0;; ++rr) {
            int grp; if (bal) { if (spare && rr < 4) grp = (nb - 192) * 4 + rr; else grp = 256 + (rr - (spare ? 4 : 0)) * 256 + nb; } else grp = rr * G + nb;
            if (grp >= NG) break;
            const int it = grp * 8 + wid; if (it >= TOTAL) continue;
            int r = it;
            if (r < T_IN) { const int kb = r / 48, nb = r % 48; wtrans_tile(p.in[8], INW, kb * 64, nb * 64, (bf16_t*)(p.ws + WS_WT_IN), D, nb * 64, scr, lane); continue; } r -= T_IN;
            if (r < T_OUT) { const int kb = r / 16, nb = r % 16; wtrans_tile(p.in[14], D, kb * 64, nb * 64, (bf16_t*)(p.ws + WS_WT_OUT), D, nb * 64, scr, lane); continue; } r -= T_OUT;
#if USE_FP8_FFN
            if (r < T_GU) { const int kb = r / 88, nb = r % 88; wtrans_tile8(p.in[15], 2 * FFN, kb * 64, nb * 64, p.ws + WS_WT_GU, D, gu_row(nb * 64, FFN), (LAS unsigned char*)scr, lane); continue; } r -= T_GU;
#else
            if (r < T_GU) { const int kb = r / 88, nb = r % 88; wtrans_tile(p.in[15], 2 * FFN, kb * 64, nb * 64, (bf16_t*)(p.ws + WS_WT_GU), D, gu_row(nb * 64, FFN), scr, lane); continue; } r -= T_GU;
#endif
#if USE_FP8_FFN || USE_FP8_FFN2
            if (r < T_DN) { const int kb = r / 16, nb = r % 16; wtrans_tile8(p.in[16], D, kb * 64, nb * 64, p.ws + WS_WT_DOWN, FFN, nb * 64, (LAS unsigned char*)scr, lane); continue; } r -= T_DN;
#else
            if (r < T_DN) { const int kb = r / 16, nb = r % 16; wtrans_tile(p.in[16], D, kb * 64, nb * 64, (bf16_t*)(p.ws + WS_WT_DOWN), FFN, nb * 64, scr, lane); continue; } r -= T_DN;
#endif
            if (r < T_FO) { const int kb = r / 16, nb = r % 16; wtrans_tile(p.in[21], D, kb * 64, nb * 64, (bf16_t*)(p.ws + WS_WT_FOUR), D, nb * 64, scr, lane); continue; } r -= T_FO;
            if (r < NE * T_EGU) { const int e = r / T_EGU, q = r % T_EGU, kb = q / 112, nb = q % 112;
#if USE_FP8
                wtrans_tile8(p.in[23] + (size_t)e * D * 2 * EDIM, 2 * EDIM, kb * 64, nb * 64, p.ws + WS_WT_EGU + (size_t)e * 2 * EDIM * D, D, gu_row(nb * 64, EDIM), (LAS unsigned char*)scr, lane); continue; } r -= NE * T_EGU;
#else
                wtrans_tile(p.in[23] + (size_t)e * D * 2 * EDIM, 2 * EDIM, kb * 64, nb * 64, (bf16_t*)(p.ws + WS_WT_EGU) + (size_t)e * 2 * EDIM * D, D, gu_row(nb * 64, EDIM), scr, lane); continue; } r -= NE * T_EGU;
#endif
            { const int e = r / T_EDN, q = r % T_EDN, kb = q / 16, nb = q % 16;
#if USE_FP8
                wtrans_tile8(p.in[24] + (size_t)e * EDIM * D, D, kb * 64, nb * 64, p.ws + WS_WT_EDOWN + (size_t)e * D * EDIM, EDIM, nb * 64, (LAS unsigned char*)scr, lane); }
#else
                wtrans_tile(p.in[24] + (size_t)e * EDIM * D, D, kb * 64, nb * 64, (bf16_t*)(p.ws + WS_WT_EDOWN) + (size_t)e * D * EDIM, EDIM, nb * 64, scr, lane); }
#endif
        }
    }
}

__device__ __forceinline__ void norm_row(const float* __restrict__ xr, const float* __restrict__ gain, const float* __restrict__ sh, const float* __restrict__ sc, bf16_t* __restrict__ orow, int lane, f32x4 (&hv)[4], bool f8 = false) {
    f32x4 v[4]; float s = 0.f;
#pragma unroll
    for (int j = 0; j < 4; ++j) { v[j] = *(const f32x4*)(xr + 4 * lane + 256 * j); s += (v[j][0] * v[j][0] + v[j][1] * v[j][1]) + (v[j][2] * v[j][2] + v[j][3] * v[j][3]); }
    const float rstd = rsqrtf(wave_sum(s) * (1.0f / D) + EPS);
#pragma unroll
    for (int j = 0; j < 4; ++j) { const f32x4 g = *(const f32x4*)(gain + 4 * lane + 256 * j), a = *(const f32x4*)(sh + 4 * lane + 256 * j), b = *(const f32x4*)(sc + 4 * lane + 256 * j);
        f32x4 h;
#pragma unroll
        for (int e = 0; e < 4; ++e) h[e] = (v[j][e] * rstd * g[e]) * (1.0f + b[e]) + a[e];
        hv[j] = h;
        if (f8) *(unsigned*)((unsigned char*)orow + 4 * lane + 256 * j) = pk4_fp8(h[0] * S_A8, h[1] * S_A8, h[2] * S_A8, h[3] * S_A8);
        else *(u32x2*)(orow + 4 * lane + 256 * j) = (u32x2){pk2(h[0], h[1]), pk2(h[2], h[3])}; }
}
template <int NR, bool ROUTER>
__device__ __forceinline__ void norm_rows4(const float* __restrict__ x0, const float* __restrict__ gain, const float* __restrict__ sh, const float* __restrict__ sc,
                                           unsigned char* __restrict__ o0, int opitch, bool f8, int lane, const LAS float* wr, float (&lg)[NR][8]) {
    f32x4 v[NR][4]; float rstd[NR];
#pragma unroll
    for (int r = 0; r < NR; ++r)
#pragma unroll
        for (int j = 0; j < 4; ++j) v[r][j] = *(const f32x4*)(x0 + (size_t)r * D + 4 * lane + 256 * j);
#pragma unroll
    for (int r = 0; r < NR; ++r) { float s = 0.f;
#pragma unroll
        for (int j = 0; j < 4; ++j) s += (v[r][j][0] * v[r][j][0] + v[r][j][1] * v[r][j][1]) + (v[r][j][2] * v[r][j][2] + v[r][j][3] * v[r][j][3]);
        rstd[r] = rsqrtf(wave_sum(s) * (1.0f / D) + EPS); }
    if (ROUTER) {
#pragma unroll
        for (int r = 0; r < NR; ++r)
#pragma unroll
            for (int e = 0; e < 8; ++e) lg[r][e] = 0.f; }
#pragma unroll
    for (int j = 0; j < 4; ++j) { const int c = 4 * lane + 256 * j;
        const f32x4 g = *(const f32x4*)(gain + c), a = *(const f32x4*)(sh + c), b = *(const f32x4*)(sc + c);
        f32x4 h[NR];
#pragma unroll
        for (int r = 0; r < NR; ++r) {
#pragma unroll
            for (int e = 0; e < 4; ++e) h[r][e] = (v[r][j][e] * rstd[r] * g[e]) * (1.0f + b[e]) + a[e];
            if (f8) *(unsigned*)(o0 + (size_t)r * opitch + c) = pk4_fp8(h[r][0] * S_A8, h[r][1] * S_A8, h[r][2] * S_A8, h[r][3] * S_A8);
            else *(u32x2*)(o0 + (size_t)r * opitch + 2 * c) = (u32x2){pk2(h[r][0], h[r][1]), pk2(h[r][2], h[r][3])}; }
        if (ROUTER) {
#pragma unroll
            for (int q = 0; q < 4; ++q) { const f32x4 w0 = *(const LAS f32x4*)(wr + (c + q) * 8), w1 = *(const LAS f32x4*)(wr + (c + q) * 8 + 4);
#pragma unroll
                for (int r = 0; r < NR; ++r) { const float hh = h[r][q];
                    lg[r][0] += hh * w0[0]; lg[r][1] += hh * w0[1]; lg[r][2] += hh * w0[2]; lg[r][3] += hh * w0[3]; lg[r][4] += hh * w1[0]; lg[r][5] += hh * w1[1]; lg[r][6] += hh * w1[2]; lg[r][7] += hh * w1[3]; } } } }
}
__device__ __forceinline__ void phase_norm(const Params& p, const float* X, const float* gain, const float* ada, int chunk_shift, bool with_ctx, bool f8 = false) {
    const int lane = otid() & 63, gw = blockIdx.x * 8 + (otid() >> 6), NW = gridDim.x * 8;
    unsigned char* H = p.ws + WS_H; const int opitch = f8 ? D : 2 * D;
    float lg[8][8];
    for (int r0 = gw * 8; r0 < T; r0 += NW * 8) { const int b = r0 >> 13;
        norm_rows4<8, false>(X + (size_t)r0 * D, gain, ada + b * 6144 + chunk_shift * 1024, ada + b * 6144 + (chunk_shift + 1) * 1024, H + (size_t)r0 * opitch, opitch, f8, lane, nullptr, lg); }
    if (with_ctx) { unsigned char* HX = p.ws + WS_HX;
        for (int r0 = gw * 8; r0 < TX; r0 += NW * 8) norm_rows4<8, false>(p.in[2] + (size_t)r0 * D, gain, ada + 4 * 6144, ada + 4 * 6144 + 1024, HX + (size_t)r0 * 2 * D, 2 * D, false, lane, nullptr, lg); }
}
__device__ __forceinline__ void phase_norm_router(const Params& p, LAS unsigned char* lds) {
    const int tid = otid(), lane = tid & 63, wid = tid >> 6;
    LAS float* wr = (LAS float*)lds;
    LAS int* hist = (LAS int*)(lds + 32768);
    for (int i = tid; i < 8192; i += 512) wr[i] = p.in[22][i];
    const float* X = p.out; const float* gain = p.in[18]; const float* ada = (const float*)(p.ws + WS_ADA1);
    unsigned char* H = p.ws + WS_H; const int opitch = USE_FP8 ? D : 2 * D;
    int* toke = (int*)(p.ws + WS_TOKE); f32x2* tokg = (f32x2*)(p.ws + WS_TOKG); int* histg = (int*)(p.ws + WS_HIST);
    for (int ch = blockIdx.x; ch < 256; ch += gridDim.x) {
        __syncthreads();
        if (tid < 8) hist[tid] = 0;
        __syncthreads();
        for (int rr = wid * 2; rr < 128; rr += 16) { const int row0 = ch * 128 + rr, b = row0 >> 13;
            float lg[2][8];
            norm_rows4<2, true>(X + (size_t)row0 * D, gain, ada + b * 6144 + 3 * 1024, ada + b * 6144 + 4 * 1024, H + (size_t)row0 * opitch, opitch, USE_FP8 != 0, lane, wr, lg);
#pragma unroll
            for (int r = 0; r < 2; ++r) {
#pragma unroll
                for (int e = 0; e < 8; ++e) lg[r][e] = wave_sum(lg[r][e]);
                int e0 = 0; float l0 = lg[r][0];
#pragma unroll
                for (int e = 1; e < 8; ++e) if (lg[r][e] > l0) { l0 = lg[r][e]; e0 = e; }
                int e1 = -1; float l1 = -3.0e38f;
#pragma unroll
                for (int e = 0; e < 8; ++e) if (e != e0 && lg[r][e] > l1) { l1 = lg[r][e]; e1 = e; }
                if (lane == 0) { const float ex = __expf(l1 - l0); const float g0 = 1.0f / (1.0f + ex);
                    toke[row0 + r] = e0 | (e1 << 8); tokg[row0 + r] = (f32x2){g0, ex * g0};
                    lds_add(&hist[e0], 1); lds_add(&hist[e1], 1); } }
        }
        __syncthreads();
        if (tid < 8) histg[ch * 8 + tid] = hist[tid];
    }
}

__device__ __forceinline__ void moe_totals(const Params& p, LAS int* tot  , LAS int* bef  , int ch) {
    const int tid = otid(); const int* histg = (const int*)(p.ws + WS_HIST);
    __syncthreads();
    if (tid < 8) { tot[tid] = 0; bef[tid] = 0; }
    __syncthreads();
    for (int i = tid; i < 2048; i += 512) { const int v = histg[i]; lds_add(&tot[i & 7], v); if ((i >> 3) < ch) lds_add(&bef[i & 7], v); }
    __syncthreads();
}
__device__ __forceinline__ void phase_slots(const Params& p, LAS unsigned char* lds) {
    const int tid = otid(), lane = tid & 63, wid = tid >> 6;
    LAS int* tot = (LAS int*)lds; LAS int* bef = tot + 8; LAS int* pst = bef + 8; LAS int* te = pst + 16; LAS int* sl = te + 128;
    const int* toke = (const int*)(p.ws + WS_TOKE); const f32x2* tokg = (const f32x2*)(p.ws + WS_TOKG);
    int* toks = (int*)(p.ws + WS_TOKS); int* sltok = (int*)(p.ws + WS_SLTOK); float* slg = (float*)(p.ws + WS_SLGATE);
    const unsigned char* H8 = p.ws + WS_H; unsigned char* H8S = p.ws + WS_B + B_H8S;
    for (int ch = blockIdx.x; ch < 256; ch += gridDim.x) {
        moe_totals(p, tot, bef, ch);
        if (tid == 0) { int s = 0; for (int e = 0; e < 8; ++e) { pst[e] = s; s += (tot[e] + 255) & ~255; } pst[8] = s; }
        if (tid < 128) te[tid] = toke[ch * 128 + tid];
        __syncthreads();
        if (tid < 8) { const int e = tid; int slot = pst[e] + bef[e];
            for (int i = 0; i < 128; ++i) { const int w = te[i], t = ch * 128 + i;
                if ((w & 255) == e) { sltok[slot] = t; slg[slot] = tokg[t][0]; toks[2 * t] = slot; sl[2 * i] = slot; ++slot; }
                if ((w >> 8) == e) { sltok[slot] = t; slg[slot] = tokg[t][1]; toks[2 * t + 1] = slot; sl[2 * i + 1] = slot; ++slot; } }
            if (ch == 255) { const int end = pst[e + 1]; for (; slot < end; ++slot) { sltok[slot] = 0; slg[slot] = 0.f; } } }
        __syncthreads();
#if USE_FP8
        for (int i = wid; i < 128; i += 8) { const u32x4 v = *(const u32x4*)(H8 + (size_t)(ch * 128 + i) * D + lane * 16);
            *(u32x4*)(H8S + (size_t)sl[2 * i] * D + lane * 16) = v; *(u32x4*)(H8S + (size_t)sl[2 * i + 1] * D + lane * 16) = v; }
#endif
    }
}

__device__ __forceinline__ void rope4(float (&x)[8], int head_pair0, int pos, float scale) {
    const float row = (float)(pos >> 6), col = (float)(pos & 63);
#pragma unroll
    for (int e = 0; e < 4; ++e) { const int pp = head_pair0 + e; const float base = pp < 16 ? row : col; const int f = pp & 15;
        const float inv = exp2f(-(float)f * (13.287712379549449f / 16.0f));
        float sn, cs; sincosf(base * inv, &sn, &cs);
        const float x1 = x[2 * e], x2 = x[2 * e + 1]; x[2 * e] = (x1 * cs - x2 * sn) * scale; x[2 * e + 1] = (x1 * sn + x2 * cs) * scale; }
}
__device__ __forceinline__ void headnorm_store(const u32x4 w, bf16_t* ptr, const float* gain, int lane) {
    float x[8]; unpack8(w, x);
    float s = 0.f;
#pragma unroll
    for (int e = 0; e < 8; ++e) s += x[e] * x[e];
    s += __shfl_xor(s, 1); s += __shfl_xor(s, 2); s += __shfl_xor(s, 4);
    const float rstd = rsqrtf(s * (1.0f / 64.0f) + EPS);
    const f32x4 g0 = *(const f32x4*)(gain + (lane & 7) * 8), g1 = *(const f32x4*)(gain + (lane & 7) * 8 + 4);
#pragma unroll
    for (int e = 0; e < 4; ++e) { x[e] = x[e] * rstd * g0[e]; x[4 + e] = x[4 + e] * rstd * g1[e]; }
    *(u32x4*)(ptr + lane * 8) = pack8(x);
}
__device__ __forceinline__ void headnorm_inplace(bf16_t* ptr, const float* gain, int lane) { headnorm_store(*(const u32x4*)(ptr + lane * 8), ptr, gain, lane); }
__device__ __forceinline__ void btrans_tile(const bf16_t* __restrict__ src, int lds_, bf16_t* __restrict__ dst, int ldd, int dstrow0, int dstcol0, int mode, int pos0, LAS bf16_t* scr, int lane) {
#pragma unroll 2
    for (int it = 0; it < 8; ++it) { const int rr = it * 8 + (lane >> 3), ck = lane & 7;
        u32x4 w = *(const u32x4*)(src + (size_t)rr * lds_ + ck * 8);
        if (mode) { float x[8]; unpack8(w, x);
            if (mode == 2) rope4(x, ck * 4, pos0 + rr, 0.125f);
            else {
#pragma unroll
                for (int e = 0; e < 8; ++e) x[e] *= 0.125f; }
            w = pack8(x); }
        const int c0 = ck * 8;
        scr[(c0 + 0) * 72 + rr] = (bf16_t)(w.x & 0xffff); scr[(c0 + 1) * 72 + rr] = (bf16_t)(w.x >> 16);
        scr[(c0 + 2) * 72 + rr] = (bf16_t)(w.y & 0xffff); scr[(c0 + 3) * 72 + rr] = (bf16_t)(w.y >> 16);
        scr[(c0 + 4) * 72 + rr] = (bf16_t)(w.z & 0xffff); scr[(c0 + 5) * 72 + rr] = (bf16_t)(w.z >> 16);
        scr[(c0 + 6) * 72 + rr] = (bf16_t)(w.w & 0xffff); scr[(c0 + 7) * 72 + rr] = (bf16_t)(w.w >> 16); }
    LDS_WAIT();
#pragma unroll
    for (int it = 0; it < 8; ++it) { const int c = it * 8 + (lane >> 3), rc = (lane & 7) * 8;
        const u32x4 o = *(const LAS u32x4*)(scr + c * 72 + rc);
        *(u32x4*)(dst + (size_t)(dstrow0 + c) * ldd + dstcol0 + rc) = o; }
    LDS_WAIT();
}
__device__ __forceinline__ void phase3(const Params& p, LAS unsigned char* lds) {
    const int lane = otid() & 63, wid = otid() >> 6, gw = blockIdx.x * 8 + wid, NW = gridDim.x * 8;
    bf16_t* proj = (bf16_t*)(p.ws + WS_B + B_PROJ); bf16_t* projx = (bf16_t*)(p.ws + WS_B + B_PROJX);
    bf16_t* rkr = (bf16_t*)(p.ws + WS_B + B_RKR);
    const float* qg = p.in[9]; const float* kg = p.in[10];
    for (int row0 = gw * 4; row0 < T; row0 += NW * 4) {
        u32x4 wq[4], wk[4], wr_[4];
#pragma unroll
        for (int r = 0; r < 4; ++r) { const bf16_t* pr = proj + (size_t)(row0 + r) * INW; const int l5 = lane & 31;
            wq[r] = *(const u32x4*)(pr + C_NAQ + lane * 8); wk[r] = *(const u32x4*)(pr + C_NAK + lane * 8); wr_[r] = *(const u32x4*)(pr + (lane < 32 ? C_RQ : C_RK) + l5 * 8); }
#pragma unroll
        for (int r = 0; r < 4; ++r) { bf16_t* pr = proj + (size_t)(row0 + r) * INW; const int pos = (row0 + r) & (SEQ - 1), l5 = lane & 31;
            headnorm_store(wq[r], pr + C_NAQ, qg, lane); headnorm_store(wk[r], pr + C_NAK, kg, lane);
            float x[8]; unpack8(wr_[r], x);
            rope4(x, (l5 & 7) * 4, pos, lane < 32 ? 1.0f : 0.125f);
            bf16_t* dstp = lane < 32 ? pr + C_RQ + l5 * 8 : rkr + (size_t)(row0 + r) * 256 + l5 * 8;
            *(u32x4*)dstp = pack8(x); }
    }
    for (int row = gw; row < TX; row += NW) headnorm_inplace(projx + (size_t)row * KVW + X_NAK, kg, lane);
    LAS bf16_t* scr = (LAS bf16_t*)lds + wid * (64 * 72);
    bf16_t* navt = (bf16_t*)(p.ws + WS_B + B_NAVT); bf16_t* retvt = (bf16_t*)(p.ws + WS_B + B_RETVT); bf16_t* retkt = (bf16_t*)(p.ws + WS_B + B_RETKT);
    bf16_t* navxt = (bf16_t*)(p.ws + WS_B + B_NAVXT); bf16_t* retvxt = (bf16_t*)(p.ws + WS_B + B_RETVXT); bf16_t* retkxt = (bf16_t*)(p.ws + WS_B + B_RETKXT);
    constexpr int NT_L = 512 * 20, NT_X = 16 * 20;
    for (int it = gw; it < NT_L + NT_X; it += NW) {
        if (it < NT_L) { const int tt = it / 20, ct = it % 20, b = tt >> 7, n0 = (tt & 127) * 64; const bf16_t* srow = proj + (size_t)tt * 64 * INW;
            if (ct < 8) btrans_tile(srow + C_NAV + ct * 64, INW, navt, SEQ, b * 512 + ct * 64, n0, 0, 0, scr, lane);
            else if (ct < 16) btrans_tile(srow + C_RV + (ct - 8) * 64, INW, retvt, SEQ, b * 512 + (ct - 8) * 64, n0, 0, 0, scr, lane);
            else btrans_tile(srow + C_RK + (ct - 16) * 64, INW, retkt, SEQ, b * 256 + (ct - 16) * 64, n0, 2, n0, scr, lane);
        } else { const int q = it - NT_L, tt = q / 20, ct = q % 20, b = tt >> 2, l0 = (tt & 3) * 64; const bf16_t* srow = projx + (size_t)tt * 64 * KVW;
            if (ct < 8) btrans_tile(srow + X_NAV + ct * 64, KVW, navxt, CTXL, b * 512 + ct * 64, l0, 0, 0, scr, lane);
            else if (ct < 16) btrans_tile(srow + X_RV + (ct - 8) * 64, KVW, retvxt, CTXL, b * 512 + (ct - 8) * 64, l0, 0, 0, scr, lane);
            else btrans_tile(srow + X_RK + (ct - 16) * 64, KVW, retkxt, CTXL, b * 256 + (ct - 16) * 64, l0, 1, 0, scr, lane);
        }
    }
}

struct NaState { f32x4 o[4]; float l; };
struct NaK { u32x4 k[2][2][2]; };
struct NaV { u32x4 v[2][4]; };
struct NaPtrs { const bf16_t* ks0; const bf16_t* vs0; const bf16_t* kx0; const bf16_t* vx0; };
__device__ __forceinline__ void na_loadK(NaK& f, const NaPtrs& P, int ci, int fr, int fq) {
    const bool strip = ci < 4; const size_t kld = strip ? INW : KVW;
    const bf16_t* kb0 = strip ? P.ks0 + (size_t)ci * 128 * INW : P.kx0 + (size_t)(ci - 4) * 64 * KVW;
    const bf16_t* kb1 = kb0 + (strip ? (size_t)64 * INW : (size_t)32 * KVW);
    const int kkrow = 8 * (fr >> 2) + (fr & 3);
#pragma unroll
    for (int i = 0; i < 2; ++i)
#pragma unroll
        for (int t = 0; t < 2; ++t) { const bf16_t* kp = (i ? kb1 : kb0) + (size_t)(kkrow + 4 * t) * kld + fq * 8; f.k[i][t][0] = *(const u32x4*)kp; f.k[i][t][1] = *(const u32x4*)(kp + 32); }
}
__device__ __forceinline__ void na_loadV(NaV& f, const NaPtrs& P, int ci, int fr, int fq) {
    const bool strip = ci < 4; const size_t vld = strip ? SEQ : CTXL;
    const bf16_t* vb0 = strip ? P.vs0 + ci * 128 : P.vx0 + (ci - 4) * 64;
    const bf16_t* vb1 = vb0 + (strip ? 64 : 32);
#pragma unroll
    for (int i = 0; i < 2; ++i)
#pragma unroll
        for (int dt = 0; dt < 4; ++dt) f.v[i][dt] = *(const u32x4*)((i ? vb1 : vb0) + (size_t)(dt * 16 + fr) * vld + 8 * fq);
}
constexpr int NA_LK_PITCH = 144, NA_LV_PITCH = 528, NA_LV_OFF = 256 * NA_LK_PITCH, NA_RPB_OFF = NA_LV_OFF + 64 * NA_LV_PITCH;
__device__ __forceinline__ void na_loadK_x(NaK& f, const LAS unsigned char* lk, int cx, int fr, int fq) {
    const int kkrow = 8 * (fr >> 2) + (fr & 3);
#pragma unroll
    for (int i = 0; i < 2; ++i)
#pragma unroll
        for (int t = 0; t < 2; ++t) { const LAS unsigned char* kp = lk + (64 * cx + 32 * i + kkrow + 4 * t) * NA_LK_PITCH + fq * 16; f.k[i][t][0] = *(const LAS u32x4*)kp; f.k[i][t][1] = *(const LAS u32x4*)(kp + 64); }
}
__device__ __forceinline__ void na_loadV_x(NaV& f, const LAS unsigned char* lv, int cx, int fr, int fq) {
#pragma unroll
    for (int i = 0; i < 2; ++i)
#pragma unroll
        for (int dt = 0; dt < 4; ++dt) f.v[i][dt] = *(const LAS u32x4*)(lv + (dt * 16 + fr) * NA_LV_PITCH + (64 * cx + 32 * i + 8 * fq) * 2);
}
template <bool STRIP>
__device__ __forceinline__ void na_compute(NaState& st, const NaK& fk, const NaV& fv, const u32x4 (&qf)[2], const LAS float* brow0, const LAS float* brow1, int cb, int c0, int qc, int fq, float sref) {
    f32x4 s[2][2];
#pragma unroll
    for (int i = 0; i < 2; ++i)
#pragma unroll
        for (int t = 0; t < 2; ++t) { f32x4 a = mfma16(fk.k[i][t][0], qf[0], (f32x4){0.f, 0.f, 0.f, 0.f}); s[i][t] = mfma16(fk.k[i][t][1], qf[1], a); }
    float sum = 0.f; u32x4 pf[2];
#pragma unroll
    for (int i = 0; i < 2; ++i) { float e[8];
#pragma unroll
        for (int t = 0; t < 2; ++t)
#pragma unroll
            for (int j = 0; j < 4; ++j) { float v = s[i][t][j] * 0.125f - sref;
                if (STRIP) { const int kc = cb + 8 * fq + 4 * t + j; const bool valid = (unsigned)(kc - c0) < 16u; const int co = min(max(kc - qc + 15, 0), 30);
                    v = valid ? v + (i ? brow1 : brow0)[co] : -3.0e38f; }
                const float pe = __expf(v); e[t * 4 + j] = pe; sum += pe; }
        pf[i] = pack8(e); }
    st.l += sum;
#pragma unroll
    for (int i = 0; i < 2; ++i)
#pragma unroll
        for (int dt = 0; dt < 4; ++dt) st.o[dt] = mfma16(fv.v[i][dt], pf[i], st.o[dt]);
}
__device__ __forceinline__ void na_item(const Params& p, int b, int h, int r, int g, int lane, const LAS unsigned char* lds, float sref) {
    const int fr = lane & 15, fq = lane >> 4;
    const bf16_t* proj = (const bf16_t*)(p.ws + WS_B + B_PROJ); const bf16_t* navt = (const bf16_t*)(p.ws + WS_B + B_NAVT);
    const LAS float* rpb = (const LAS float*)(lds + NA_RPB_OFF) + h * (15 * 31);
    const LAS unsigned char* lk = lds; const LAS unsigned char* lv = lds + NA_LV_OFF;
    const int qc = 16 * g + fr, tokq = b * SEQ + r * 64 + qc;
    const int r0 = min(max(r - 4, 0), 120), cb = min(max(16 * g - 8, 0), 32), c0 = min(max(qc - 8, 0), 48);
    u32x4 qf[2];
#pragma unroll
    for (int ks = 0; ks < 2; ++ks) qf[ks] = *(const u32x4*)(proj + (size_t)tokq * INW + C_NAQ + h * 64 + ks * 32 + fq * 8);
    NaState st;
#pragma unroll
    for (int dt = 0; dt < 4; ++dt) st.o[dt] = (f32x4){0.f, 0.f, 0.f, 0.f};
    st.l = 0.f;
    NaPtrs P;
    P.ks0 = proj + (size_t)(b * SEQ + r0 * 64 + cb) * INW + C_NAK + h * 64;
    P.vs0 = navt + (size_t)(b * 512 + h * 64) * SEQ + r0 * 64 + cb;
    P.kx0 = nullptr; P.vx0 = nullptr;
    NaK ka, kb; NaV vv;
    na_loadK(ka, P, 0, fr, fq);
#pragma unroll 1
    for (int cp = 0; cp < 2; ++cp) { const int ci = 2 * cp;
        const LAS float* br0 = rpb + (r0 + 2 * ci - r + 7) * 31;
        na_loadV(vv, P, ci, fr, fq); na_loadK(kb, P, ci + 1, fr, fq);
        na_compute<true>(st, ka, vv, qf, br0, br0 + 31, cb, c0, qc, fq, sref);
        na_loadV(vv, P, ci + 1, fr, fq); if (cp == 0) na_loadK(ka, P, ci + 2, fr, fq); else na_loadK_x(ka, lk, 0, fr, fq);
        na_compute<true>(st, kb, vv, qf, br0 + 62, br0 + 93, cb, c0, qc, fq, sref); }
#pragma unroll 1
    for (int cx = 0; cx < 4; cx += 2) {
        na_loadV_x(vv, lv, cx, fr, fq); na_loadK_x(kb, lk, cx + 1, fr, fq);
        na_compute<false>(st, ka, vv, qf, rpb, rpb, 0, 0, 0, fq, sref);
        na_loadV_x(vv, lv, cx + 1, fr, fq); na_loadK_x(ka, lk, cx + 2 < 4 ? cx + 2 : 3, fr, fq);
        na_compute<false>(st, kb, vv, qf, rpb, rpb, 0, 0, 0, fq, sref); }
    float l1 = st.l;
    l1 += __shfl_xor(l1, 16); l1 += __shfl_xor(l1, 32);
    const float inv = 1.0f / l1;
    bf16_t* mix = (bf16_t*)(p.ws + WS_B + B_MIXIN) + (size_t)tokq * D + h * 64;
#pragma unroll
    for (int dt = 0; dt < 4; ++dt) { const f32x4 v = st.o[dt] * inv; *(u32x2*)(mix + dt * 16 + 4 * fq) = (u32x2){pk2(v[0], v[1]), pk2(v[2], v[3])}; }
}
__device__ __forceinline__ void na_range(const Params& p, int ulo, int uhi, LAS unsigned char* lds) {
    const int tid = otid(), lane = tid & 63, wid = tid >> 6;
    const bf16_t* projx = (const bf16_t*)(p.ws + WS_B + B_PROJX); const bf16_t* navxt = (const bf16_t*)(p.ws + WS_B + B_NAVXT);
    LAS float* rpb_l = (LAS float*)(lds + NA_RPB_OFF);
    for (int u = ulo + blockIdx.x; u < uhi; u += gridDim.x) { const int bh = u >> 3, b = bh >> 3, h = bh & 7, rbase = (u & 7) * 16;
        __syncthreads();
        for (int i = tid; i < 8 * 15 * 31; i += 512) rpb_l[i] = p.in[11][i];
        for (int i = tid; i < 2048; i += 512) { const int l = i >> 3, ck = i & 7;
            *(LAS u32x4*)(lds + l * NA_LK_PITCH + ck * 16) = *(const u32x4*)(projx + (size_t)(b * CTXL + l) * KVW + X_NAK + h * 64 + ck * 8); }
        for (int i = tid; i < 2048; i += 512) { const int d = i >> 5, ck = i & 31;
            *(LAS u32x4*)(lds + NA_LV_OFF + d * NA_LV_PITCH + ck * 16) = *(const u32x4*)(navxt + (size_t)(b * 512 + h * 64 + d) * CTXL + ck * 8); }
        __syncthreads();
        float gq = fabsf(p.in[9][lane]), gk = fabsf(p.in[10][lane]), bm = 0.f;
        for (int i = lane; i < 15 * 31; i += 64) bm = fmaxf(bm, fabsf(rpb_l[h * (15 * 31) + i]));
#pragma unroll
        for (int o = 1; o < 64; o <<= 1) { gq = fmaxf(gq, __shfl_xor(gq, o)); gk = fmaxf(gk, __shfl_xor(gk, o)); bm = fmaxf(bm, __shfl_xor(bm, o)); }
        const float sref = fminf(8.0f * 1.02f * gq * gk + bm, 40.0f);
        for (int it = wid; it < 64; it += 8) na_item(p, b, h, rbase + (it >> 2), it & 3, lane, lds, sref);
    }
}

__device__ __forceinline__ float log2_decay(float a) { return -log1pf(__expf(-a)) * 1.4426950408889634f; }
__device__ __forceinline__ void retU_item(const Params& p, int item, int lane) {
    const int w = item & 7, cc = (item >> 3) % NCC, bh = (item >> 3) / NCC, b = bh >> 2, h = bh & 3;
    const int fr = lane & 15, fq = lane >> 4;
    const float lgf = log2_decay(p.in[12][h]), lgb = log2_decay(p.in[13][h]);
    const bf16_t* vt; const bf16_t* kt; size_t ld; int n0;
    if (cc < 2) { vt = (const bf16_t*)(p.ws + WS_B + B_RETVXT); kt = (const bf16_t*)(p.ws + WS_B + B_RETKXT); ld = CTXL; n0 = cc * 128; }
    else { vt = (const bf16_t*)(p.ws + WS_B + B_RETVT); kt = (const bf16_t*)(p.ws + WS_B + B_RETKT); ld = SEQ; n0 = (cc - 2) * 128; }
    f32x4 af[4], ab[4];
#pragma unroll
    for (int nt = 0; nt < 4; ++nt) { af[nt] = (f32x4){0.f, 0.f, 0.f, 0.f}; ab[nt] = (f32x4){0.f, 0.f, 0.f, 0.f}; }
#pragma unroll
    for (int ks = 0; ks < 4; ++ks) {
        const u32x4 va = *(const u32x4*)(vt + (size_t)(b * 512 + h * 128 + 16 * w + fr) * ld + n0 + 32 * ks + 8 * fq);
        float wf[8], wb[8];
#pragma unroll
        for (int e = 0; e < 8; ++e) { const int j = 32 * ks + 8 * fq + e; wf[e] = exp2f((float)(127 - j) * lgf); wb[e] = exp2f((float)j * lgb); }
#pragma unroll
        for (int nt = 0; nt < 4; ++nt) { const u32x4 kw = *(const u32x4*)(kt + (size_t)(b * 256 + h * 64 + 16 * nt + fr) * ld + n0 + 32 * ks + 8 * fq);
            float x[8], y[8]; unpack8(kw, x);
#pragma unroll
            for (int e = 0; e < 8; ++e) { y[e] = x[e] * wb[e]; x[e] *= wf[e]; }
            af[nt] = mfma16(va, pack8(x), af[nt]); ab[nt] = mfma16(va, pack8(y), ab[nt]); }
    }
    float* U = (float*)(p.ws + WS_B + B_U);
    float* uf = U + ((size_t)(0 * 16 + bh) * NCC + cc) * 8192; float* ub = U + ((size_t)(1 * 16 + bh) * NCC + cc) * 8192;
#pragma unroll
    for (int nt = 0; nt < 4; ++nt)
#pragma unroll
        for (int j = 0; j < 4; ++j) { const int v = 16 * w + 4 * fq + j, d = 16 * nt + fr; uf[v * 64 + d] = af[nt][j]; ub[v * 64 + d] = ab[nt][j]; }
}
__device__ __forceinline__ void phase_retU(const Params& p) {
    const int lane = otid() & 63, gw = blockIdx.x * 8 + (otid() >> 6), NW = gridDim.x * 8;
    for (int it = gw; it < 16 * NCC * 8; it += NW) retU_item(p, it, lane);
}
__device__ __forceinline__ void phase_scan(const Params& p) {
    const float* U = (const float*)(p.ws + WS_B + B_U); bf16_t* S = (bf16_t*)(p.ws + WS_B + B_S);
    for (int i = blockIdx.x * 512 + otid(); i < 2 * 16 * 8192; i += gridDim.x * 512) {
        const int e = i & 8191, bh = (i >> 13) & 15, dir = i >> 17, h = bh & 3;
        const float G = exp2f(128.0f * log2_decay(dir ? p.in[13][h] : p.in[12][h]));
        const float* u = U + (size_t)(dir * 16 + bh) * NCC * 8192 + e; bf16_t* s = S + (size_t)(dir * 16 + bh) * NCHUNK * 8192 + e;
        if (dir == 0) { float st = u[0] * G + u[8192];
#pragma unroll 8
            for (int c = 0; c < NCHUNK; ++c) { s[(size_t)c * 8192] = f2bf(st); st = st * G + u[(size_t)(2 + c) * 8192]; }
        } else { float st = u[0] + G * u[8192];
#pragma unroll 8
            for (int c = NCHUNK - 1; c >= 0; --c) { s[(size_t)c * 8192] = f2bf(st); st = st * G + u[(size_t)(2 + c) * 8192]; } }
    }
}
constexpr int RO_KP = 144, RO_VP = 272, RO_SP = 144, RO_V_OFF = 128 * RO_KP, RO_S_OFF = RO_V_OFF + 128 * RO_VP;
__device__ __forceinline__ void retO_item(const Params& p, int bh, int c, int w, int lane, const LAS unsigned char* lds) {
    const int b = bh >> 2, h = bh & 3;
    const int fr = lane & 15, fq = lane >> 4;
    const float lgf = log2_decay(p.in[12][h]), lgb = log2_decay(p.in[13][h]);
    const bf16_t* proj = (const bf16_t*)(p.ws + WS_B + B_PROJ);
    const int tok0 = b * SEQ + c * 128, qi = 16 * w + fr, tokq = tok0 + qi;
    u32x4 qf[2];
#pragma unroll
    for (int ks = 0; ks < 2; ++ks) qf[ks] = *(const u32x4*)(proj + (size_t)tokq * INW + C_RQ + h * 64 + ks * 32 + fq * 8);
    const int kkrow = 8 * (fr >> 2) + (fr & 3);
    u32x4 pf[4];
#pragma unroll
    for (int kb = 0; kb < 4; ++kb) { float e[8];
#pragma unroll
        for (int t = 0; t < 2; ++t) { const LAS unsigned char* kp = lds + (32 * kb + kkrow + 4 * t) * RO_KP + fq * 16;
            const u32x4 k0 = *(const LAS u32x4*)kp, k1 = *(const LAS u32x4*)(kp + 64);
            f32x4 a = mfma16(k0, qf[0], (f32x4){0.f, 0.f, 0.f, 0.f}); a = mfma16(k1, qf[1], a);
#pragma unroll
            for (int j = 0; j < 4; ++j) { const int kj = 32 * kb + 8 * fq + 4 * t + j, df = qi - kj;
                const float dec = df > 0 ? exp2f((float)df * lgf) : (df < 0 ? exp2f((float)(-df) * lgb) : 2.0f);
                e[t * 4 + j] = a[j] * dec; } }
        pf[kb] = pack8(e); }
    f32x4 o[8];
#pragma unroll
    for (int vt = 0; vt < 8; ++vt) o[vt] = (f32x4){0.f, 0.f, 0.f, 0.f};
#pragma unroll
    for (int kb = 0; kb < 4; ++kb)
#pragma unroll
        for (int vt = 0; vt < 8; ++vt) { const u32x4 vf = *(const LAS u32x4*)(lds + RO_V_OFF + (vt * 16 + fr) * RO_VP + (32 * kb + 8 * fq) * 2);
            o[vt] = mfma16(vf, pf[kb], o[vt]); }
    const float xif = exp2f((float)(qi + 1) * lgf), xib = exp2f((float)(128 - qi) * lgb);
#pragma unroll
    for (int dir = 0; dir < 2; ++dir) { const float xi = dir ? xib : xif; const LAS unsigned char* sp = lds + RO_S_OFF + dir * 128 * RO_SP;
#pragma unroll
        for (int ks = 0; ks < 2; ++ks) { float x[8]; unpack8(qf[ks], x);
#pragma unroll
            for (int e = 0; e < 8; ++e) x[e] *= xi;
            const u32x4 qs = pack8(x);
#pragma unroll
            for (int vt = 0; vt < 8; ++vt) { const u32x4 sf = *(const LAS u32x4*)(sp + (vt * 16 + fr) * RO_SP + ks * 64 + fq * 16); o[vt] = mfma16(sf, qs, o[vt]); } } }
    float ss = 0.f;
#pragma unroll
    for (int vt = 0; vt < 8; ++vt)
#pragma unroll
        for (int j = 0; j < 4; ++j) ss += o[vt][j] * o[vt][j];
    ss += __shfl_xor(ss, 16); ss += __shfl_xor(ss, 32);
    const float rstd = rsqrtf(ss * (1.0f / 128.0f) + EPS);
    const bf16_t* rg = proj + (size_t)tokq * INW + C_RG + h * 128; bf16_t* mix = (bf16_t*)(p.ws + WS_B + B_MIXIN) + (size_t)tokq * D + 512 + h * 128;
#pragma unroll
    for (int vt = 0; vt < 8; ++vt) { const u32x2 gw2 = *(const u32x2*)(rg + vt * 16 + 4 * fq);
        const float g0 = silu_f(bflo(gw2.x)), g1 = silu_f(bfhi(gw2.x)), g2 = silu_f(bflo(gw2.y)), g3 = silu_f(bfhi(gw2.y));
        *(u32x2*)(mix + vt * 16 + 4 * fq) = (u32x2){pk2(o[vt][0] * rstd * g0, o[vt][1] * rstd * g1), pk2(o[vt][2] * rstd * g2, o[vt][3] * rstd * g3)}; }
}
__device__ __forceinline__ void phase_retO(const Params& p, LAS unsigned char* lds) {
    const int tid = otid(), lane = tid & 63, wid = tid >> 6;
    const bf16_t* rkr = (const bf16_t*)(p.ws + WS_B + B_RKR); const bf16_t* retvt = (const bf16_t*)(p.ws + WS_B + B_RETVT); const bf16_t* S = (const bf16_t*)(p.ws + WS_B + B_S);
    for (int u = blockIdx.x; u < 16 * 64; u += gridDim.x) { const int c = u & 63, bh = u >> 6, b = bh >> 2, h = bh & 3;
        __syncthreads();
        for (int i = tid; i < 1024; i += 512) { const int r = i >> 3, ck = i & 7;
            *(LAS u32x4*)(lds + r * RO_KP + ck * 16) = *(const u32x4*)(rkr + (size_t)(b * SEQ + c * 128 + r) * 256 + h * 64 + ck * 8); }
        for (int i = tid; i < 2048; i += 512) { const int r = i >> 4, ck = i & 15;
            *(LAS u32x4*)(lds + RO_V_OFF + r * RO_VP + ck * 16) = *(const u32x4*)(retvt + (size_t)(b * 512 + h * 128 + r) * SEQ + c * 128 + ck * 8); }
        for (int i = tid; i < 2048; i += 512) { const int dir = i >> 10, r = (i >> 3) & 127, ck = i & 7;
            *(LAS u32x4*)(lds + RO_S_OFF + (dir * 128 + r) * RO_SP + ck * 16) = *(const u32x4*)(S + ((size_t)(dir * 16 + bh) * NCHUNK + c) * 8192 + r * 64 + ck * 8); }
        __syncthreads();
        retO_item(p, bh, c, wid, lane, lds);
    }
}

__device__ __forceinline__ void phase_combine(const Params& p) {
    const int lane = otid() & 63, gw = blockIdx.x * 8 + (otid() >> 6), NW = gridDim.x * 8;
    const bf16_t* Y = (const bf16_t*)(p.ws + WS_B + B_Y); const int* toks = (const int*)(p.ws + WS_TOKS); const float* ada = (const float*)(p.ws + WS_ADA1);
    for (int r0 = gw * 4; r0 < T; r0 += NW * 4) { const int b = r0 >> 13; const float* gf = ada + b * 6144 + 5 * 1024;
        int s0[4], s1[4];
#pragma unroll
        for (int r = 0; r < 4; ++r) { s0[r] = toks[2 * (r0 + r)]; s1[r] = toks[2 * (r0 + r) + 1]; }
        f32x4 x[4][4]; u32x2 ya[4][4], yb[4][4];
#pragma unroll
        for (int r = 0; r < 4; ++r)
#pragma unroll
            for (int j = 0; j < 4; ++j) { const int c = 4 * lane + 256 * j; x[r][j] = *(const f32x4*)(p.out + (size_t)(r0 + r) * D + c);
                ya[r][j] = *(const u32x2*)(Y + (size_t)s0[r] * D + c); yb[r][j] = *(const u32x2*)(Y + (size_t)s1[r] * D + c); }
#pragma unroll
        for (int j = 0; j < 4; ++j) { const int c = 4 * lane + 256 * j; const f32x4 g = *(const f32x4*)(gf + c);
#pragma unroll
            for (int r = 0; r < 4; ++r) { const u32x2 a = ya[r][j], bb = yb[r][j];
                f32x4 y = (f32x4){bflo(a.x) + bflo(bb.x), bfhi(a.x) + bfhi(bb.x), bflo(a.y) + bflo(bb.y), bfhi(a.y) + bfhi(bb.y)};
                if (DBG_MASK & 16) y = (f32x4){0.f, 0.f, 0.f, 0.f};
                *(f32x4*)(p.out + (size_t)(r0 + r) * D + c) = x[r][j] + g * y; } } }
}

constexpr int NPHASE = 21;
#define XB_TMO      128
#define XB_XCNT(j)  (256  + 64 * (j))
#define XB_XSUB(j)  (1280 + 64 * (j))
#define XB_XGEN(j)  (2304 + 64 * (j))
#define XB_TOP      3328
#define XB_TOPGEN   3392
#define XCD_BAR_WORDS 3456
#define XB_SPIN_CAP (1u << 22)
__device__ __forceinline__ unsigned xb_ld(unsigned* p)              { return __hip_atomic_load(p, __ATOMIC_RELAXED, __HIP_MEMORY_SCOPE_AGENT); }
__device__ __forceinline__ unsigned xb_add(unsigned* p, unsigned v) { return __hip_atomic_fetch_add(p, v, __ATOMIC_RELAXED, __HIP_MEMORY_SCOPE_AGENT); }
__device__ __forceinline__ unsigned xb_xcc_id() { return (unsigned)__builtin_amdgcn_s_getreg((3 << 11) | 20) & 0xFu; }
#define XB_SPIN(cond, bar) do { unsigned _sp = 0; while (cond) { __builtin_amdgcn_s_sleep(1); \
    if ((++_sp & 255u) == 0u) { if (xb_ld(&(bar)[XB_TMO])) break; if (_sp > XB_SPIN_CAP) { atomicAdd(&(bar)[XB_TMO], 1u); break; } } } } while (0)
struct XcdBarrier { unsigned* bar; unsigned x; volatile LAS unsigned* st; };
__device__ __forceinline__ XcdBarrier xcd_barrier_post(unsigned* bar, volatile LAS unsigned* st) {
    XcdBarrier b; b.bar = bar; b.x = xb_xcc_id(); b.st = st;
    if (threadIdx.x == 0) (void)xb_add(&bar[XB_XCNT(b.x)], 1u);
    return b;
}
__device__ __forceinline__ void xcd_barrier_complete(unsigned* bar, unsigned x, unsigned& nloc, unsigned& nx) {
    const unsigned G = gridDim.x * gridDim.y * gridDim.z;
    unsigned sum, cnt, mine, sp = 0u;
    for (;;) {
        sum = 0u; cnt = 0u; mine = 0u;
#pragma unroll
        for (unsigned j = 0; j < 16; ++j) { const unsigned c = xb_ld(&bar[XB_XCNT(j)]); sum += c; cnt += (c > 0u) ? 1u : 0u; mine = (j == x) ? c : mine; }
        if (sum == G) break;
        __builtin_amdgcn_s_sleep(1);
        if ((++sp & 255u) == 0u) { if (xb_ld(&bar[XB_TMO])) break; if (sp > XB_SPIN_CAP) { atomicAdd(&bar[XB_TMO], 1u); break; } }
    }
    nloc = mine > 0u ? mine : 1u; nx = cnt > 0u ? cnt : 1u;
}
__device__ __forceinline__ void xcd_barrier(const XcdBarrier& b) {
    asm volatile("s_waitcnt vmcnt(0) lgkmcnt(0)" ::: "memory");
    __syncthreads();
    if (threadIdx.x == 0) {
        unsigned* bar = b.bar;
        __builtin_amdgcn_s_waitcnt(0);
        unsigned nloc = b.st[0], nx = b.st[1];
        if (nloc == 0u) { xcd_barrier_complete(bar, b.x, nloc, nx); b.st[0] = nloc; b.st[1] = nx; }
        const unsigned old = xb_add(&bar[XB_XSUB(b.x)], 1u);
        const unsigned gen = old / nloc;
        if (old + 1u == (gen + 1u) * nloc) {
            __builtin_amdgcn_fence(__ATOMIC_RELEASE, "agent");
            asm volatile("s_waitcnt vmcnt(0)" ::: "memory");
            const unsigned og = xb_add(&bar[XB_TOP], 1u);
            const unsigned tg = og / nx;
            if (og + 1u == (tg + 1u) * nx) xb_add(&bar[XB_TOPGEN], 1u);
            else XB_SPIN(xb_ld(&bar[XB_TOPGEN]) == tg, bar);
            __builtin_amdgcn_fence(__ATOMIC_ACQUIRE, "agent");
            xb_add(&bar[XB_XGEN(b.x)], 1u);
            asm volatile("s_waitcnt vmcnt(0)" ::: "memory");
        } else {
            XB_SPIN(xb_ld(&bar[XB_XGEN(b.x)]) == gen, bar);
            __builtin_amdgcn_fence(__ATOMIC_ACQUIRE, "agent");
            asm volatile("s_waitcnt vmcnt(0)" ::: "memory");
        }
    }
    __syncthreads();
}
__global__ void __launch_bounds__(512, 2) mega(Params p) {
    extern __shared__ __attribute__((aligned(16))) unsigned char shm[];
    LAS unsigned char* lds = (LAS unsigned char*)shm;
    const int G = gridDim.x, c = blockIdx.x;
    const float* ada0 = (const float*)(p.ws + WS_ADA0); const float* ada1 = (const float*)(p.ws + WS_ADA1);
    unsigned char* B = p.ws + WS_B;
    unsigned* bar = (unsigned*)(p.ws + WS_BAR);
    volatile LAS unsigned* xst = (volatile LAS unsigned*)(lds + LDS_GEMM + 256);
    if (threadIdx.x == 0) { xst[0] = 0u; xst[1] = 0u; }
    __syncthreads();
    XcdBarrier xb = xcd_barrier_post(bar, xst);
    constexpr size_t TS = (size_t)256 * D * 2;
#ifndef PHASE_MASK
#define PHASE_MASK 0x1FFFFF
#endif
#ifndef DUP_MASK
#define DUP_MASK 0
#endif
#define PH(k) for (int rep_ = 0; rep_ < 1 + ((DUP_MASK >> (k)) & 1); ++rep_) { if (((PHASE_MASK >> (k)) & 1) && p.ph_lo <= (k) && (k) < p.ph_hi)
#define SYNC(k) if (((k) + 1 < p.ph_hi || rep_ == 0 && ((DUP_MASK >> (k)) & 1)) && p.ph_lo <= (k)) { xcd_barrier(xb); } }
    if (p.ph_hi < 0) cg::this_grid().sync();
    PH(0) { phase0(p, lds); } SYNC(0)
#ifdef EXTRA_BAR
    for (int xi = 0; xi < EXTRA_BAR; ++xi) xcd_barrier(xb);
#endif
    PH(1) { phase_norm(p, p.in[0], p.in[4], ada0, 0, true); } SYNC(1)
    PH(2) { g8::InProjSched S{(const char*)(p.ws + WS_H), (const char*)(p.ws + WS_HX), (const char*)(p.ws + WS_WT_IN), G, c};
            g8::EpiStoreBf16 E{(bf16_t*)(B + B_PROJ), (bf16_t*)(B + B_PROJX), INW, KVW, 0, 1.0f, true};
            g8::gemm_phase<g8::EpiStoreBf16, g8::InProjSched, false>(lds, D * 2, D * 2, D * 2, S, E, nullptr, 0); } SYNC(2)
    PH(3) { phase3(p, lds); } SYNC(3)
    PH(4) { phase_retU(p); } SYNC(4)
    PH(5) { phase_scan(p); na_range(p, 0, 256, lds); } SYNC(5)
    PH(6) { phase_retO(p, lds); } SYNC(6)
    PH(7) { g8::DenseSched S{(const char*)(B + B_MIXIN), (const char*)(p.ws + WS_WT_OUT), 0, 0, TS, TS, 128, 4, 1, G, c};
            g8::EpiResid E{p.out, p.in[0], ada0 + 2 * 1024, false, 1.0f};
            g8::gemm_phase<g8::EpiResid, g8::DenseSched, false>(lds, D * 2, D * 2, D * 2, S, E, nullptr, 0); } SYNC(7)
    PH(8) { phase_norm(p, p.out, p.in[5], ada0, 3, false, USE_FP8_FFN != 0); } SYNC(8)
    PH(9) {
#if USE_FP8_FFN
            g8::DenseSched S{(const char*)(p.ws + WS_H), (const char*)(p.ws + WS_WT_GU), 0, 0, TS / 2, TS / 2, 128, 22, 1, G, c};
            g8::EpiSwiglu8 E{B + B_ACT, FFN, DESCALE8};
            g8::gemm_phase<g8::EpiSwiglu8, g8::DenseSched, false, true>(lds, D, D, D, S, E, nullptr, 0); } SYNC(9)
#else
            g8::DenseSched S{(const char*)(p.ws + WS_H), (const char*)(p.ws + WS_WT_GU), 0, 0, TS, TS, 128, 22, 1, G, c};
#if USE_FP8_FFN2
            g8::EpiSwiglu8 E{B + B_ACT, FFN, 1.0f};
            g8::gemm_phase<g8::EpiSwiglu8, g8::DenseSched, false>(lds, D * 2, D * 2, D * 2, S, E, nullptr, 0); } SYNC(9)
#else
            g8::EpiSwiglu E{(bf16_t*)(B + B_ACT), FFN};
            g8::gemm_phase<g8::EpiSwiglu, g8::DenseSched, false>(lds, D * 2, D * 2, D * 2, S, E, nullptr, 0); } SYNC(9)
#endif
#endif

    PH(10) {
#if USE_FP8_FFN || USE_FP8_FFN2
             g8::DenseSched S{(const char*)(B + B_ACT), (const char*)(p.ws + WS_WT_DOWN), 0, 0, (size_t)256 * FFN, (size_t)256 * FFN, 128, 4, 1, G, c};
             g8::EpiResid E{p.out, p.out, ada0 + 5 * 1024, (DBG_MASK & 4) != 0, DESCALE8};
             g8::gemm_phase<g8::EpiResid, g8::DenseSched, false, true>(lds, FFN, FFN, FFN, S, E, nullptr, 0); } SYNC(10)
#else
             g8::DenseSched S{(const char*)(B + B_ACT), (const char*)(p.ws + WS_WT_DOWN), 0, 0, (size_t)256 * FFN * 2, (size_t)256 * FFN * 2, 128, 4, 1, G, c};
             g8::EpiResid E{p.out, p.out, ada0 + 5 * 1024, (DBG_MASK & 4) != 0, 1.0f};
             g8::gemm_phase<g8::EpiResid, g8::DenseSched, false>(lds, FFN * 2, FFN * 2, FFN * 2, S, E, nullptr, 0); } SYNC(10)
#endif

    PH(11) { phase_norm(p, p.out, p.in[17], ada1, 0, false); } SYNC(11)
    PH(12) { g8::FourASched S{(const char*)(p.ws + WS_WC2), (const char*)(p.ws + WS_H), G, c};
             g8::EpiFA2 E{(bf16_t*)(B + B_ZT)};
             g8::gemm_phase<g8::EpiFA2, g8::FourASched, false>(lds, 256, 256, 64 * D * 2, S, E, nullptr, (size_t)D * 2); } SYNC(12)
    PH(13) { g8::DenseSched S{(const char*)(p.ws + WS_M1), (const char*)(B + B_ZT), 0, 0, 0, (size_t)256 * 256 * 2, 1, 1024, 1, G, c};
             g8::EpiFB1 E{(bf16_t*)(B + B_T2), (const float*)(p.ws + WS_TW)};
             g8::gemm_phase<g8::EpiFB1, g8::DenseSched, false>(lds, 512, 512, 512, S, E, nullptr, 0); } SYNC(13)
    PH(14) { g8::DenseSched S{(const char*)(p.ws + WS_M3), (const char*)(B + B_T2), 0, 0, 0, (size_t)256 * 512 * 2, 1, 512, 1, G, c};
             g8::EpiFB3 E{(bf16_t*)(B + B_FOUR), 1.0f / 1024.0f};
             g8::gemm_phase<g8::EpiFB3, g8::DenseSched, false>(lds, 1024, 1024, 1024, S, E, nullptr, 0); } SYNC(14)
    PH(15) { g8::DenseSched S{(const char*)(B + B_FOUR), (const char*)(p.ws + WS_WT_FOUR), 0, 0, TS, TS, 128, 4, 1, G, c};
             g8::EpiResid E{p.out, p.out, ada1 + 2 * 1024, (DBG_MASK & 8) != 0, 1.0f};
             g8::gemm_phase<g8::EpiResid, g8::DenseSched, false>(lds, D * 2, D * 2, D * 2, S, E, nullptr, 0); } SYNC(15)
    PH(16) { phase_norm_router(p, lds); } SYNC(16)
    PH(17) { phase_slots(p, lds); } SYNC(17)
    PH(18) { LAS int* tot = (LAS int*)(lds + LDS_GEMM); LAS int* bef = tot + 8; moe_totals(p, tot, bef, 0);
             int pe[8]; int s = 0;
#pragma unroll
             for (int e = 0; e < 8; ++e) { s += (tot[e] + 255) >> 8; pe[e] = s; }
#if USE_FP8
             g8::MoeSched S{(const char*)(B + B_H8S), (const char*)(p.ws + WS_WT_EGU), (size_t)2 * EDIM * D, D, D, pe[7], 28, G, c, pe[0], pe[1], pe[2], pe[3], pe[4], pe[5], pe[6], pe[7], false};
             g8::EpiSwiglu8 E{B + B_ACTE, EDIM, DESCALE8};
             g8::gemm_phase<g8::EpiSwiglu8, g8::MoeSched, false, true>(lds, D, D, D, S, E, nullptr, 0); } SYNC(18)
#else
             g8::MoeSched S{(const char*)(p.ws + WS_H), (const char*)(p.ws + WS_WT_EGU), (size_t)2 * EDIM * D * 2, D * 2, D * 2, pe[7], 28, G, c, pe[0], pe[1], pe[2], pe[3], pe[4], pe[5], pe[6], pe[7], true};
             g8::EpiSwiglu E{(bf16_t*)(B + B_ACTE), EDIM};
             g8::gemm_phase<g8::EpiSwiglu, g8::MoeSched, true>(lds, D * 2, D * 2, D * 2, S, E, (const int*)(p.ws + WS_SLTOK), 0); } SYNC(18)
#endif

    PH(19) { LAS int* tot = (LAS int*)(lds + LDS_GEMM); LAS int* bef = tot + 8; moe_totals(p, tot, bef, 0);
             int pe[8]; int s = 0;
#pragma unroll
             for (int e = 0; e < 8; ++e) { s += (tot[e] + 255) >> 8; pe[e] = s; }
#if USE_FP8
             g8::MoeSched S{(const char*)(B + B_ACTE), (const char*)(p.ws + WS_WT_EDOWN), (size_t)D * EDIM, EDIM, EDIM, pe[7], 4, G, c, pe[0], pe[1], pe[2], pe[3], pe[4], pe[5], pe[6], pe[7], false};
             g8::EpiMoeDown E{(bf16_t*)(B + B_Y), (const float*)(p.ws + WS_SLGATE)};
             g8::gemm_phase<g8::EpiMoeDown, g8::MoeSched, false, true>(lds, EDIM, EDIM, EDIM, S, E, nullptr, 0); } SYNC(19)
#else
             g8::MoeSched S{(const char*)(B + B_ACTE), (const char*)(p.ws + WS_WT_EDOWN), (size_t)D * EDIM * 2, EDIM * 2, EDIM * 2, pe[7], 4, G, c, pe[0], pe[1], pe[2], pe[3], pe[4], pe[5], pe[6], pe[7], false};
             g8::EpiMoeDown E{(bf16_t*)(B + B_Y), (const float*)(p.ws + WS_SLGATE)};
             g8::gemm_phase<g8::EpiMoeDown, g8::MoeSched, false>(lds, EDIM * 2, EDIM * 2, EDIM * 2, S, E, nullptr, 0); } SYNC(19)
#endif

    PH(20) { phase_combine(p); } }
#ifdef PROBE_PH
    if (p.ph_lo == 30) { const bf16_t* src = (const bf16_t*)(p.ws + (size_t)(PROBE_OFF));
        for (size_t i = (size_t)blockIdx.x * 512 + threadIdx.x; i < (size_t)T * D; i += (size_t)gridDim.x * 512) p.out[i] = i < (size_t)(PROBE_N) ? __uint_as_float(((unsigned)src[i]) << 16) : 0.f; }
#endif
#undef PH
#undef SYNC
}

extern "C" void kernel_launch(void* const* d_in, const int* in_sizes, int n_in, void* d_out, int out_size, void* d_ws, size_t ws_size, hipStream_t stream) {
    static int grid = 0;
    if (grid == 0) {
        if (n_in != 25 || out_size != T * D || ws_size < WS_END) { fprintf(stderr, "kernel_launch: unexpected shapes (n_in %d out %d ws %zu need %zu)\n", n_in, out_size, ws_size, (size_t)WS_END); grid = -1; return; }
        int dev = 0, cus = 0, per_cu = 0;
        hipGetDevice(&dev); hipDeviceGetAttribute(&cus, hipDeviceAttributeMultiprocessorCount, dev);
        if (hipFuncSetAttribute((const void*)mega, hipFuncAttributeMaxDynamicSharedMemorySize, LDS_TOTAL) != hipSuccess) { fprintf(stderr, "kernel_launch: hipFuncSetAttribute failed\n"); grid = -1; return; }
        if (hipOccupancyMaxActiveBlocksPerMultiprocessor(&per_cu, (const void*)mega, 512, LDS_TOTAL) != hipSuccess || per_cu < 1) { fprintf(stderr, "kernel_launch: occupancy query failed (%d)\n", per_cu); per_cu = 1; (void)hipGetLastError(); }
        grid = cus * per_cu; if (grid > 256) grid = 256;
    }
    if (grid < 0) return;
    Params p{};
    for (int i = 0; i < 25; ++i) p.in[i] = (const float*)d_in[i];
    p.out = (float*)d_out; p.ws = (unsigned char*)d_ws;
    (void)hipMemsetAsync((unsigned char*)d_ws + WS_BAR, 0, 16384, stream);
#if MK_SPLIT
#ifdef PROBE_PH
    for (int ph = 0; ph < PROBE_PH; ++ph) { p.ph_lo = ph; p.ph_hi = ph + 1; hipLaunchKernelGGL(mega, dim3(grid), dim3(512), LDS_TOTAL, stream, p); }
    p.ph_lo = 30; p.ph_hi = 31; hipLaunchKernelGGL(mega, dim3(grid), dim3(512), LDS_TOTAL, stream, p);
    return;
#endif
    for (int ph = 0; ph < NPHASE; ++ph) { p.ph_lo = ph; p.ph_hi = ph + 1; hipLaunchKernelGGL(mega, dim3(grid), dim3(512), LDS_TOTAL, stream, p); }
#else
    p.ph_lo = 0; p.ph_hi = NPHASE;
    void* args[] = {&p};
    hipError_t e = hipLaunchCooperativeKernel((const void*)mega, dim3(grid), dim3(512), args, LDS_TOTAL, stream);
    if (e != hipSuccess) fprintf(stderr, "cooperative launch failed: %s (grid %d)\n", hipGetErrorString(e), grid);
#endif
}
```

```cpp
#include <hip/hip_runtime.h>
#include <hip/hip_cooperative_groups.h>
#include <cstdio>
#include <cstdint>
namespace cg = cooperative_groups;

#ifndef MK_SPLIT
#define MK_SPLIT 0
#endif
#ifndef DBG_MASK
#define DBG_MASK 0
#endif

#define FP8_DIAG 0
#define USE_FP8 1
#define USE_FP8_FFN2 1
#define USE_FP8_FFN 0
#define LAS __attribute__((address_space(3)))
typedef unsigned short bf16_t;
typedef short bf16x8 __attribute__((ext_vector_type(8)));
typedef float f32x4 __attribute__((ext_vector_type(4)));
typedef float f32x2 __attribute__((ext_vector_type(2)));
typedef unsigned u32x4 __attribute__((ext_vector_type(4)));
typedef unsigned u32x2 __attribute__((ext_vector_type(2)));

constexpr int D = 1024, NBATCH = 4, SEQ = 8192, T = NBATCH * SEQ, CTXL = 256, TX = NBATCH * CTXL;
constexpr int INW = 3072, KVW = 1792;
constexpr int C_NAQ = 0, C_RQ = 512, C_RG = 768, C_NAK = 1280, C_NAV = 1792, C_RK = 2304, C_RV = 2560;
constexpr int X_NAK = 0, X_NAV = 512, X_RK = 1024, X_RV = 1280;
constexpr int FFN = 2816, NE = 8, EDIM = 3584;
constexpr int MOE_TILES = 264, NSLOTS = MOE_TILES * 256;
constexpr int NCHUNK = 64, NCC = 66;
constexpr float EPS = 1e-6f;

constexpr size_t AL(size_t x) { return (x + 255) & ~(size_t)255; }
constexpr size_t WS_WT_IN = 0;
constexpr size_t WS_WT_OUT = WS_WT_IN + (size_t)INW * D * 2;
constexpr size_t WS_WT_GU = WS_WT_OUT + (size_t)D * D * 2;
constexpr size_t WS_WT_DOWN = WS_WT_GU + (size_t)2 * FFN * D * 2;
constexpr size_t WS_WT_FOUR = WS_WT_DOWN + (size_t)D * FFN * 2;
constexpr size_t WS_WT_EGU = WS_WT_FOUR + (size_t)D * D * 2;
constexpr size_t WS_WT_EDOWN = WS_WT_EGU + (size_t)NE * 2 * EDIM * D * 2;
constexpr size_t WS_WC = WS_WT_EDOWN + (size_t)NE * D * EDIM * 2;
constexpr size_t WS_WC2 = WS_WC + (size_t)2048 * 1024 * 2;
constexpr size_t WS_M1 = WS_WC2 + (size_t)256 * 128 * 2;
constexpr size_t WS_M3 = WS_M1 + (size_t)256 * 256 * 2;
constexpr size_t WS_TW = WS_M3 + (size_t)256 * 512 * 2;
constexpr size_t WS_BAR = WS_TW + (size_t)128 * 64 * 8;
constexpr size_t WS_ADA0 = WS_BAR + 16384;
constexpr size_t WS_ADA1 = WS_ADA0 + AL(5 * 6144 * 4);
constexpr size_t WS_HIST = WS_ADA1 + AL(4 * 6144 * 4);
constexpr size_t WS_TOKE = WS_HIST + AL(256 * 8 * 4);
constexpr size_t WS_TOKG = WS_TOKE + AL((size_t)T * 4);
constexpr size_t WS_TOKS = WS_TOKG + AL((size_t)T * 8);
constexpr size_t WS_SLTOK = WS_TOKS + AL((size_t)T * 8);
constexpr size_t WS_SLGATE = WS_SLTOK + AL((size_t)NSLOTS * 4);
constexpr size_t WS_H = WS_SLGATE + AL((size_t)NSLOTS * 4);
constexpr size_t WS_HX = WS_H + (size_t)T * D * 2;
constexpr size_t WS_B = WS_HX + (size_t)TX * D * 2;
constexpr size_t B_PROJ = 0;
constexpr size_t B_ACT = 0;
constexpr size_t B_PROJX = B_PROJ + (size_t)T * INW * 2;
constexpr size_t B_MIXIN = B_PROJX + (size_t)TX * KVW * 2;
constexpr size_t B_U = B_MIXIN + (size_t)T * D * 2;
constexpr size_t B_S = B_U + (size_t)2 * 16 * NCC * 8192 * 4;
constexpr size_t B_NAVT = B_S + (size_t)2 * 16 * NCHUNK * 8192 * 2;
constexpr size_t B_RETVT = B_NAVT + (size_t)NBATCH * 512 * SEQ * 2;
constexpr size_t B_RETKT = B_RETVT + (size_t)NBATCH * 512 * SEQ * 2;
constexpr size_t B_RKR = B_RETKT + (size_t)NBATCH * 256 * SEQ * 2;
constexpr size_t B_NAVXT = B_RKR + (size_t)T * 256 * 2;
constexpr size_t B_RETVXT = B_NAVXT + (size_t)NBATCH * 512 * CTXL * 2;
constexpr size_t B_RETKXT = B_RETVXT + (size_t)NBATCH * 512 * CTXL * 2;
constexpr size_t B_L0_END = B_RETKXT + (size_t)NBATCH * 256 * CTXL * 2;
constexpr size_t B_ZT = 0;
constexpr size_t B_T2 = B_ZT + (size_t)NBATCH * 2048 * SEQ * 2;
constexpr size_t B_FOUR = B_T2 + (size_t)NBATCH * 2048 * SEQ * 2;
constexpr size_t B_F_END = B_FOUR + (size_t)T * D * 2;
constexpr size_t B_ACTE = 0;
constexpr size_t B_H8S = (size_t)256 << 20;
constexpr size_t B_Y = B_ACTE + (size_t)NSLOTS * EDIM * 2;
constexpr size_t B_M_END = B_Y + (size_t)NSLOTS * D * 2;
constexpr size_t BMAX1 = B_L0_END > B_F_END ? B_L0_END : B_F_END;
constexpr size_t WS_END = WS_B + (BMAX1 > B_M_END ? BMAX1 : B_M_END);

constexpr int LDS_GEMM = 131072, LDS_TOTAL = LDS_GEMM + 512;

struct Params {
    const float* in[25];
    float* out;
    unsigned char* ws;
    int ph_lo, ph_hi;
};

typedef __bf16 bf16x2_t __attribute__((ext_vector_type(2)));
__device__ __forceinline__ unsigned pk2(float lo, float hi) { const f32x2 v = {lo, hi}; const bf16x2_t r = __builtin_convertvector(v, bf16x2_t); return __builtin_bit_cast(unsigned, r); }
__device__ __forceinline__ float bflo(unsigned w) { return __uint_as_float(w << 16); }
__device__ __forceinline__ float bfhi(unsigned w) { return __uint_as_float(w & 0xffff0000u); }
__device__ __forceinline__ bf16_t f2bf(float f) { return (bf16_t)(pk2(f, 0.f) & 0xffffu); }
__device__ __forceinline__ float wave_sum(float v) {
#pragma unroll
    for (int o = 1; o < 64; o <<= 1) v += __shfl_xor(v, o);
    return v;
}
__device__ __forceinline__ float silu_f(float g) { return g * __builtin_amdgcn_rcpf(1.0f + __expf(-g)); }
__device__ __forceinline__ f32x4 mfma16(u32x4 a, u32x4 b, f32x4 c) {
    return __builtin_amdgcn_mfma_f32_16x16x32_bf16(__builtin_bit_cast(bf16x8, a), __builtin_bit_cast(bf16x8, b), c, 0, 0, 0);
}
__device__ __forceinline__ void lds_add(LAS int* p, int v) { __hip_atomic_fetch_add((int*)p, v, __ATOMIC_RELAXED, __HIP_MEMORY_SCOPE_WORKGROUP); }
__device__ __forceinline__ void unpack8(const u32x4 w, float (&x)[8]) {
    x[0] = bflo(w.x); x[1] = bfhi(w.x); x[2] = bflo(w.y); x[3] = bfhi(w.y); x[4] = bflo(w.z); x[5] = bfhi(w.z); x[6] = bflo(w.w); x[7] = bfhi(w.w);
}
__device__ __forceinline__ u32x4 pack8(const float (&x)[8]) { return (u32x4){pk2(x[0], x[1]), pk2(x[2], x[3]), pk2(x[4], x[5]), pk2(x[6], x[7])}; }
__device__ __forceinline__ int otid() { int t = threadIdx.x; asm volatile("" : "+v"(t)); return t; }
typedef int i32x8 __attribute__((ext_vector_type(8)));
typedef int u32x4i __attribute__((ext_vector_type(4)));
__device__ __forceinline__ float clamp448(float x) { return __builtin_amdgcn_fmed3f(x, -448.0f, 448.0f); }
__device__ __forceinline__ unsigned pk4_fp8(float a, float b, float c, float d) {
    int w = 0; w = __builtin_amdgcn_cvt_pk_fp8_f32(clamp448(a), clamp448(b), w, false); w = __builtin_amdgcn_cvt_pk_fp8_f32(clamp448(c), clamp448(d), w, true); return (unsigned)w; }
constexpr float S_W8 = 64.0f, S_A8 = 4.0f, DESCALE8 = 1.0f / (S_W8 * S_A8);
#define LDS_WAIT() asm volatile("s_waitcnt lgkmcnt(0)" ::: "memory")

namespace g8 {
constexpr int BM = 256, BK = 64, HALF = 128, HTB = HALF * BK * 2, NXCD = 8, WGM = 8;
__device__ __forceinline__ int lds_byte(int r, int c) { const int st = (r >> 4) * 2 + (c >> 5), rr = r & 15, cc = c & 31, ob = rr * 64 + cc * 2; return st * 1024 + (ob ^ (((ob >> 9) & 1) << 5)); }
__device__ __forceinline__ void stage_rc(int b, int& R, int& C) { const int st = b / 1024, sb = b % 1024, swz = sb ^ (((sb >> 9) & 1) << 5); R = (st >> 1) * 16 + swz / 64; C = (st & 1) * 32 + (swz % 64) / 2; }
__device__ __forceinline__ int perm32(int rho) { const int n = rho >> 4, i = rho & 15; return 8 * (i >> 2) + 4 * n + (i & 3); }

struct Unit { const char* A; const char* B; int pm, pn, z; };

__device__ __forceinline__ void remap(int w, int nM, int nN, int& pm, int& pn) {
    const int nwg = nM * nN; int wgid = w;
    { const int q = nwg / NXCD, r = nwg % NXCD, xcd = wgid % NXCD, off = wgid / NXCD; wgid = (xcd < r ? xcd * (q + 1) : r * (q + 1) + (xcd - r) * q) + off; }
    const int nig = WGM * nN, gid = wgid / nig, fm = gid * WGM, gsz = (nM - fm) < WGM ? (nM - fm) : WGM;
    pm = fm + ((wgid % nig) % gsz); pn = (wgid % nig) / gsz;
}

struct DenseSched {
    const char* A; const char* B; size_t azs, bzs, aps, bps; int nM, nN, nz, G, c;
    __device__ __forceinline__ bool next(int i, Unit& u) const {
        const long L = (long)i * G + c; const int per = nM * nN; if (L >= (long)per * nz) return false;
        const int z = (int)(L / per), w = (int)(L % per); int pm, pn; remap(w, nM, nN, pm, pn);
        u.pm = pm; u.pn = pn; u.z = z; u.A = A + z * azs + (size_t)pm * aps; u.B = B + z * bzs + (size_t)pn * bps; return true;
    }
};
struct InProjSched {
    const char* H; const char* HX; const char* W; int G, c;
    __device__ __forceinline__ bool next(int i, Unit& u) const {
        const long L = (long)i * G + c; const int n0 = 128 * 12;
        if (L < n0) { int pm, pn; remap((int)L, 128, 12, pm, pn); u.pm = pm; u.pn = pn; u.z = 0; u.A = H + (size_t)pm * 256 * D * 2; u.B = W + (size_t)pn * 256 * D * 2; return true; }
        const int w = (int)(L - n0); if (w >= 28) return false;
        u.pm = w / 7; u.pn = w % 7; u.z = 1; u.A = HX + (size_t)u.pm * 256 * D * 2; u.B = W + (size_t)(1280 + u.pn * 256) * D * 2; return true;
    }
};
struct FourASched {
    const char* A; const char* H; int G, c;
    __device__ __forceinline__ bool next(int i, Unit& u) const {
        const long L = (long)i * G + c; if (L >= 1024) return false;
        const int pn = (int)(L & 31), g = (int)((L >> 5) & 7), b = (int)(L >> 8);
        u.pm = 0; u.pn = pn; u.z = b * 8 + g; u.A = A; u.B = H + (size_t)b * SEQ * D * 2 + (size_t)pn * 2 * D * 2 + g * 256; return true;
    }
};
struct MoeSched {
    const char* A; const char* W; size_t wes; int lda, ldb, nM, nN, G, c; int pe0, pe1, pe2, pe3, pe4, pe5, pe6, pe7; bool gather;
    __device__ __forceinline__ bool next(int i, Unit& u) const {
        const long L = (long)i * G + c; if (L >= (long)nM * nN) return false;
        int pm, pn; remap((int)L, nM, nN, pm, pn);
        const int e = (pm >= pe0) + (pm >= pe1) + (pm >= pe2) + (pm >= pe3) + (pm >= pe4) + (pm >= pe5) + (pm >= pe6);
        u.pm = pm; u.pn = pn; u.z = e; u.A = gather ? A : A + (size_t)pm * 256 * lda; u.B = W + e * wes + (size_t)pn * 256 * ldb; return true;
    }
};

template <class Epi, class Sched, bool GATHER, bool FP8 = false>
__device__ __forceinline__ void gemm_phase(LAS unsigned char* lds, const int K_, const int lda, const int ldb, const Sched& S, const Epi& E, const int* __restrict__ rowidx, const size_t hstepB_) {
    int tid = threadIdx.x; asm volatile("" : "+v"(tid));
    const int wid = __builtin_amdgcn_readfirstlane(tid >> 6), lane = tid & 63, wr = wid >> 2, wc = wid & 3, fr = lane & 15, fq = lane >> 4;
    int K = K_; asm volatile("" : "+s"(K));
    const int nt = K / (BK * 2);
    int Rr[2], Cc[2]; unsigned voffB[2];
#pragma unroll
    for (int i = 0; i < 2; ++i) { int R, C; stage_rc(tid * 16 + i * 8192, R, C); const int Rb = Epi::PERM ? ((R & ~31) + perm32(R & 31)) : R;
        Rr[i] = R; Cc[i] = C; voffB[i] = (unsigned)(Rb * ldb + C * 2); }
    const size_t kstep = (size_t)(BK * 2);
    const size_t hstepB = hstepB_ ? hstepB_ : (size_t)HALF * ldb;
    const unsigned ldsw = (unsigned)wid * 1024u;
    const int aoff = lds_byte(wr * 64 + fr, fq * 8), boff = lds_byte(wc * 32 + fr, fq * 8);
#define G8_SA(b, h) (((b) * 2 + (h)) * HTB)
#define G8_SB(b, h) ((4 + (b) * 2 + (h)) * HTB)
#define G8_STAGE(bufoff, gbase, voff) do { _Pragma("unroll") for (int _i = 0; _i < 2; ++_i) \
        __builtin_amdgcn_global_load_lds((const unsigned*)((const char*)(gbase) + (voff)[_i]), (LAS unsigned*)(lds + (bufoff) + ldsw + _i * 8192), 16, 0, 0); } while (0)
#define G8_LDA(dst, b, h) do { _Pragma("unroll") for (int m = 0; m < 4; ++m) { const u32x4i l_ = *(const LAS u32x4i*)(lds + G8_SA(b, h) + aoff + m * 2048), h_ = *(const LAS u32x4i*)(lds + G8_SA(b, h) + aoff + m * 2048 + 1024); \
        dst[m] = __builtin_shufflevector(l_, h_, 0, 1, 2, 3, 4, 5, 6, 7); } } while (0)
#define G8_LDB(dst, b, h) do { _Pragma("unroll") for (int n = 0; n < 2; ++n) { const u32x4i l_ = *(const LAS u32x4i*)(lds + G8_SB(b, h) + boff + n * 2048), h_ = *(const LAS u32x4i*)(lds + G8_SB(b, h) + boff + n * 2048 + 1024); \
        dst[n] = __builtin_shufflevector(l_, h_, 0, 1, 2, 3, 4, 5, 6, 7); } } while (0)
#define G8_LO(v) __builtin_bit_cast(bf16x8, __builtin_shufflevector(v, v, 0, 1, 2, 3))
#define G8_HI(v) __builtin_bit_cast(bf16x8, __builtin_shufflevector(v, v, 4, 5, 6, 7))
#define G8_MMA(ai, bj, At, Bt) do { __builtin_amdgcn_s_setprio(1); _Pragma("unroll") for (int m = 0; m < 4; ++m) _Pragma("unroll") for (int n = 0; n < 2; ++n) { \
        if constexpr (FP8) { if (FP8_DIAG) { typedef long l4 __attribute__((ext_vector_type(4))); const l4 bb = __builtin_bit_cast(l4, Bt[n]), aa = __builtin_bit_cast(l4, At[m]); \
            _Pragma("unroll") for (int q = 0; q < 4; ++q) acc[ai][bj][m][n] = __builtin_amdgcn_mfma_f32_16x16x32_fp8_fp8(bb[q], aa[q], acc[ai][bj][m][n], 0, 0, 0); } \
          else asm volatile("v_mfma_f32_16x16x128_f8f6f4 %0, %1, %2, %0" : "+v"(acc[ai][bj][m][n]) : "v"(Bt[n]), "v"(At[m])); } \
        else { acc[ai][bj][m][n] = __builtin_amdgcn_mfma_f32_16x16x32_bf16(G8_LO(Bt[n]), G8_LO(At[m]), acc[ai][bj][m][n], 0, 0, 0); \
               acc[ai][bj][m][n] = __builtin_amdgcn_mfma_f32_16x16x32_bf16(G8_HI(Bt[n]), G8_HI(At[m]), acc[ai][bj][m][n], 0, 0, 0); } } \
        __builtin_amdgcn_s_setprio(0); } while (0)
#define G8_WAIT_V(n) asm volatile("s_waitcnt vmcnt(" #n ")" ::: "memory")
#define G8_WAIT_L(n) asm volatile("s_waitcnt lgkmcnt(" #n ")" ::: "memory")
#define G8_BAR __builtin_amdgcn_s_barrier()
#define G8_SCHED __builtin_amdgcn_sched_barrier(0)
    Unit cur, nxt; int ui = 0;
    if (!S.next(0, cur)) return;
    unsigned ca[2][2], na[2][2];
#pragma unroll
    for (int h = 0; h < 2; ++h)
#pragma unroll
        for (int i = 0; i < 2; ++i) {
            if constexpr (GATHER) ca[h][i] = (unsigned)rowidx[cur.pm * 256 + h * 128 + Rr[i]] * (unsigned)lda + (unsigned)(Cc[i] * 2);
            else ca[h][i] = (unsigned)((h * 128 + Rr[i]) * lda + Cc[i] * 2);
            na[h][i] = ca[h][i];
        }
    f32x4 acc[2][2][4][2];
#pragma unroll
    for (int a = 0; a < 2; ++a)
#pragma unroll
        for (int b = 0; b < 2; ++b)
#pragma unroll
            for (int m = 0; m < 4; ++m)
#pragma unroll
                for (int n = 0; n < 2; ++n) acc[a][b][m][n] = (f32x4){0.f, 0.f, 0.f, 0.f};
    i32x8 At[4], B0[2], B1[2];
    const char* cA = cur.A; const char* cB = cur.B;
    G8_STAGE(G8_SB(0, 0), cB, voffB); G8_STAGE(G8_SB(0, 1), cB + hstepB, voffB); G8_STAGE(G8_SA(0, 0), cA, ca[0]); G8_STAGE(G8_SA(0, 1), cA, ca[1]);
    if (wr == 1) G8_BAR;
    G8_WAIT_V(2); G8_BAR;
    G8_STAGE(G8_SB(1, 0), cB + kstep, voffB); G8_STAGE(G8_SA(1, 0), cA + kstep, ca[0]); G8_STAGE(G8_SB(1, 1), cB + hstepB + kstep, voffB);
    G8_WAIT_V(6); G8_BAR;
    for (;;) {
        const bool has_next = S.next(ui + 1, nxt);
        const char* nA = has_next ? nxt.A : cA; const char* nB = has_next ? nxt.B : cB;
        if constexpr (GATHER) {
            if (has_next) {
#pragma unroll
                for (int h = 0; h < 2; ++h)
#pragma unroll
                    for (int i = 0; i < 2; ++i) na[h][i] = (unsigned)rowidx[nxt.pm * 256 + h * 128 + Rr[i]] * (unsigned)lda + (unsigned)(Cc[i] * 2);
            }
        }
        for (int t = 0; t < nt; t += 2) {
            const bool last = (t == nt - 2);
            const char* a1 = cA + (size_t)(t + 1) * kstep;
            const char* a2 = last ? nA : cA + (size_t)(t + 2) * kstep; const char* b2 = last ? nB : cB + (size_t)(t + 2) * kstep;
            const char* a3 = a2 + kstep; const char* b3 = b2 + kstep;
            unsigned o2[2][2];
#pragma unroll
            for (int h = 0; h < 2; ++h)
#pragma unroll
                for (int i = 0; i < 2; ++i) { if constexpr (GATHER) o2[h][i] = last ? na[h][i] : ca[h][i]; else o2[h][i] = ca[h][i]; }
            G8_LDB(B0, 0, 0); G8_LDB(B1, 0, 1); G8_SCHED; G8_LDA(At, 0, 0); G8_STAGE(G8_SA(1, 1), a1, ca[1]);
            G8_WAIT_V(8); G8_WAIT_L(0); G8_BAR; G8_MMA(0, 0, At, B0); G8_MMA(0, 1, At, B1); G8_BAR; G8_SCHED;
            G8_LDA(At, 0, 1); G8_STAGE(G8_SB(0, 0), b2, voffB); G8_STAGE(G8_SB(0, 1), b2 + hstepB, voffB); G8_STAGE(G8_SA(0, 0), a2, o2[0]);
            G8_WAIT_V(8); G8_WAIT_L(0); G8_BAR; G8_MMA(1, 0, At, B0); G8_MMA(1, 1, At, B1); G8_BAR; G8_SCHED;
            G8_LDB(B0, 1, 0); G8_LDB(B1, 1, 1); G8_SCHED; G8_LDA(At, 1, 0); G8_STAGE(G8_SA(0, 1), a2, o2[1]);
            G8_WAIT_V(8); G8_WAIT_L(0); G8_BAR; G8_MMA(0, 0, At, B0); G8_MMA(0, 1, At, B1); G8_BAR; G8_SCHED;
            G8_LDA(At, 1, 1); G8_STAGE(G8_SB(1, 0), b3, voffB); G8_STAGE(G8_SB(1, 1), b3 + hstepB, voffB); G8_STAGE(G8_SA(1, 0), a3, o2[0]);
            G8_WAIT_V(8); G8_WAIT_L(0); G8_BAR; G8_MMA(1, 0, At, B0); G8_MMA(1, 1, At, B1); G8_BAR; G8_SCHED;
        }
        if (wr == 0) G8_BAR;
        E(acc, cur, wr, wc, fr, fq);
        if (!has_next) break;
#pragma unroll
        for (int a = 0; a < 2; ++a)
#pragma unroll
            for (int b = 0; b < 2; ++b)
#pragma unroll
                for (int m = 0; m < 4; ++m)
#pragma unroll
                    for (int n = 0; n < 2; ++n) acc[a][b][m][n] = (f32x4){0.f, 0.f, 0.f, 0.f};
        cur = nxt; cA = nA; cB = nB; ++ui;
        if (wr == 1) G8_BAR;
        if constexpr (GATHER) {
#pragma unroll
            for (int h = 0; h < 2; ++h)
#pragma unroll
                for (int i = 0; i < 2; ++i) ca[h][i] = na[h][i];
        }
    }
    G8_WAIT_V(0);
    G8_BAR;
#undef G8_SA
#undef G8_SB
#undef G8_STAGE
#undef G8_LDA
#undef G8_LDB
#undef G8_LO
#undef G8_HI
#undef G8_MMA
#undef G8_WAIT_V
#undef G8_WAIT_L
#undef G8_BAR
#undef G8_SCHED
}

struct EpiStoreBf16 {
    static constexpr bool PERM = true;
    bf16_t* O0; bf16_t* O1; int ldc0, ldc1; size_t zs; float scale; bool inproj;
    __device__ __forceinline__ void operator()(const f32x4 (&acc)[2][2][4][2], const Unit& u, int wr, int wc, int fr, int fq) const {
        bf16_t* base; int ldc;
        if (inproj) { base = u.z ? O1 : O0; ldc = u.z ? ldc1 : ldc0; } else { base = O0 + u.z * zs; ldc = ldc0; }
        const int row0 = u.pm * BM + wr * 64 + fr, col0 = u.pn * BM + wc * 32 + 8 * fq;
#pragma unroll
        for (int ai = 0; ai < 2; ++ai)
#pragma unroll
            for (int m = 0; m < 4; ++m) { bf16_t* rowp = base + (size_t)(row0 + ai * HALF + m * 16) * ldc + col0;
#pragma unroll
                for (int bj = 0; bj < 2; ++bj) { const f32x4 v0 = acc[ai][bj][m][0] * scale, v1 = acc[ai][bj][m][1] * scale;
                    u32x4 w; w.x = pk2(v0[0], v0[1]); w.y = pk2(v0[2], v0[3]); w.z = pk2(v1[0], v1[1]); w.w = pk2(v1[2], v1[3]);
                    *(u32x4*)(rowp + bj * HALF) = w; } }
    }
};
struct EpiResid {
    static constexpr bool PERM = false;
    float* out; const float* resid; const float* gate; bool zero; float ascale;
    __device__ __forceinline__ void operator()(const f32x4 (&acc)[2][2][4][2], const Unit& u, int wr, int wc, int fr, int fq) const {
        const int row0 = u.pm * BM + wr * 64 + fr, col0 = u.pn * BM + wc * 32 + 4 * fq;
        const float* gp = gate + (size_t)(row0 >> 13) * 6144 + col0;
        f32x4 gv[2][2];
#pragma unroll
        for (int bj = 0; bj < 2; ++bj)
#pragma unroll
            for (int n = 0; n < 2; ++n) { gv[bj][n] = *(const f32x4*)(gp + bj * HALF + n * 16) * ascale; if (zero) gv[bj][n] = (f32x4){0.f, 0.f, 0.f, 0.f}; }
#pragma unroll
        for (int ai = 0; ai < 2; ++ai)
#pragma unroll
            for (int m = 0; m < 4; ++m) { const size_t ro = (size_t)(row0 + ai * HALF + m * 16) * D + col0;
#pragma unroll
                for (int bj = 0; bj < 2; ++bj)
#pragma unroll
                    for (int n = 0; n < 2; ++n) { const f32x4 r = *(const f32x4*)(resid + ro + bj * HALF + n * 16);
                        *(f32x4*)(out + ro + bj * HALF + n * 16) = r + gv[bj][n] * acc[ai][bj][m][n]; } }
    }
};
struct EpiSwiglu {
    static constexpr bool PERM = true;
    bf16_t* O; int ldc;
    __device__ __forceinline__ void operator()(const f32x4 (&acc)[2][2][4][2], const Unit& u, int wr, int wc, int fr, int fq) const {
        const int row0 = u.pm * BM + wr * 64 + fr, col0 = u.pn * HALF + wc * 32 + 8 * fq;
#pragma unroll
        for (int ai = 0; ai < 2; ++ai)
#pragma unroll
            for (int m = 0; m < 4; ++m) { bf16_t* rowp = O + (size_t)(row0 + ai * HALF + m * 16) * ldc + col0;
                float v[8];
#pragma unroll
                for (int n = 0; n < 2; ++n)
#pragma unroll
                    for (int j = 0; j < 4; ++j) v[n * 4 + j] = silu_f(acc[ai][0][m][n][j]) * acc[ai][1][m][n][j];
                u32x4 w; w.x = pk2(v[0], v[1]); w.y = pk2(v[2], v[3]); w.z = pk2(v[4], v[5]); w.w = pk2(v[6], v[7]);
                *(u32x4*)rowp = w; }
    }
};
struct EpiSwiglu8 {
    static constexpr bool PERM = true;
    unsigned char* O; int ldc; float dsc;
    __device__ __forceinline__ void operator()(const f32x4 (&acc)[2][2][4][2], const Unit& u, int wr, int wc, int fr, int fq) const {
        const int row0 = u.pm * BM + wr * 64 + fr, col0 = u.pn * HALF + wc * 32 + 8 * fq;
#pragma unroll
        for (int ai = 0; ai < 2; ++ai)
#pragma unroll
            for (int m = 0; m < 4; ++m) { unsigned char* rowp = O + (size_t)(row0 + ai * HALF + m * 16) * ldc + col0;
                float v[8];
#pragma unroll
                for (int n = 0; n < 2; ++n)
#pragma unroll
                    for (int j = 0; j < 4; ++j) v[n * 4 + j] = silu_f(acc[ai][0][m][n][j] * dsc) * (acc[ai][1][m][n][j] * (dsc * S_A8));
                *(u32x2*)rowp = (u32x2){pk4_fp8(v[0], v[1], v[2], v[3]), pk4_fp8(v[4], v[5], v[6], v[7])}; }
    }
};
struct EpiMoeDown {
    static constexpr bool PERM = true;
    bf16_t* Y; const float* sg;
    __device__ __forceinline__ void operator()(const f32x4 (&acc)[2][2][4][2], const Unit& u, int wr, int wc, int fr, int fq) const {
        const int row0 = u.pm * BM + wr * 64 + fr, col0 = u.pn * BM + wc * 32 + 8 * fq;
#pragma unroll
        for (int ai = 0; ai < 2; ++ai)
#pragma unroll
            for (int m = 0; m < 4; ++m) { const int row = row0 + ai * HALF + m * 16; const float g = sg[row] * (USE_FP8 ? DESCALE8 : 1.0f); bf16_t* rowp = Y + (size_t)row * D + col0;
#pragma unroll
                for (int bj = 0; bj < 2; ++bj) { const f32x4 v0 = acc[ai][bj][m][0] * g, v1 = acc[ai][bj][m][1] * g;
                    u32x4 w; w.x = pk2(v0[0], v0[1]); w.y = pk2(v0[2], v0[3]); w.z = pk2(v1[0], v1[1]); w.w = pk2(v1[2], v1[3]);
                    *(u32x4*)(rowp + bj * HALF) = w; } }
    }
};
struct EpiFA {
    static constexpr bool PERM = true;
    bf16_t* O;
    __device__ __forceinline__ void operator()(const f32x4 (&acc)[2][2][4][2], const Unit& u, int wr, int wc, int fr, int fq) const {
        const int row0 = u.pm * BM + wr * 64 + fr, n1 = wc * 32 + 8 * fq;
#pragma unroll
        for (int ai = 0; ai < 2; ++ai)
#pragma unroll
            for (int m = 0; m < 4; ++m) { const int r = row0 + ai * HALF + m * 16, ch = r >> 1, part = r & 1;
#pragma unroll
                for (int bj = 0; bj < 2; ++bj) { const int n2 = 2 * u.pn + bj; const f32x4 v0 = acc[ai][bj][m][0], v1 = acc[ai][bj][m][1];
                    u32x4 w; w.x = pk2(v0[0], v0[1]); w.y = pk2(v0[2], v0[3]); w.z = pk2(v1[0], v1[1]); w.w = pk2(v1[2], v1[3]);
                    *(u32x4*)(O + ((size_t)(u.z * 1024 + ch) * 64 + n2) * 256 + part * 128 + n1) = w; } }
    }
};
struct EpiFA2 {
    static constexpr bool PERM = true;
    bf16_t* O;
    __device__ __forceinline__ void operator()(const f32x4 (&acc)[2][2][4][2], const Unit& u, int wr, int wc, int fr, int fq) const {
        const int row0 = wr * 64 + fr, n1 = wc * 32 + 8 * fq, b = u.z >> 3, g = u.z & 7;
#pragma unroll
        for (int ai = 0; ai < 2; ++ai)
#pragma unroll
            for (int m = 0; m < 4; ++m) { const int r = row0 + ai * HALF + m * 16, ch = g * 128 + (r >> 1), part = r & 1;
#pragma unroll
                for (int bj = 0; bj < 2; ++bj) { const int n2 = 2 * u.pn + bj; const f32x4 v0 = acc[ai][bj][m][0], v1 = acc[ai][bj][m][1];
                    u32x4 w; w.x = pk2(v0[0], v0[1]); w.y = pk2(v0[2], v0[3]); w.z = pk2(v1[0], v1[1]); w.w = pk2(v1[2], v1[3]);
                    *(u32x4*)(O + ((size_t)(b * 1024 + ch) * 64 + n2) * 256 + part * 128 + n1) = w; } }
    }
};
struct EpiFB1 {
    static constexpr bool PERM = true;
    bf16_t* O; const float* tw;
    __device__ __forceinline__ void operator()(const f32x4 (&acc)[2][2][4][2], const Unit& u, int wr, int wc, int fr, int fq) const {
        const int n20 = (wc & 1) * 32 + 8 * fq;
#pragma unroll
        for (int m = 0; m < 4; ++m) { const int k1 = wr * 64 + m * 16 + fr;
#pragma unroll
            for (int n = 0; n < 2; ++n) {
                const float* tp = tw + (size_t)(k1 * 64 + n20 + 4 * n) * 2;
                const f32x4 t0 = *(const f32x4*)tp, t1 = *(const f32x4*)(tp + 4);
#pragma unroll
                for (int bj = 0; bj < 2; ++bj) { const int chg = u.pn * 4 + bj * 2 + (wc >> 1), b = chg >> 10, ch = chg & 1023;
                    const f32x4 R = acc[0][bj][m][n], I = acc[1][bj][m][n];
                    const float r0 = R[0] * t0[0] - I[0] * t0[1], i0 = R[0] * t0[1] + I[0] * t0[0], r1 = R[1] * t0[2] - I[1] * t0[3], i1 = R[1] * t0[3] + I[1] * t0[2];
                    const float r2 = R[2] * t1[0] - I[2] * t1[1], i2 = R[2] * t1[1] + I[2] * t1[0], r3 = R[3] * t1[2] - I[3] * t1[3], i3 = R[3] * t1[3] + I[3] * t1[2];
                    bf16_t* op = O + ((((size_t)(b * 32 + (k1 >> 2)) * 1024 + ch) * 4 + (k1 & 3)) * 2) * 64 + n20 + 4 * n;
                    *(u32x2*)op = (u32x2){pk2(r0, r1), pk2(r2, r3)}; *(u32x2*)(op + 64) = (u32x2){pk2(i0, i1), pk2(i2, i3)}; }
                __builtin_amdgcn_sched_barrier(0); } }
    }
};
struct EpiFB3 {
    static constexpr bool PERM = true;
    bf16_t* O; float scale;
    __device__ __forceinline__ void operator()(const f32x4 (&acc)[2][2][4][2], const Unit& u, int wr, int wc, int fr, int fq) const {
#pragma unroll
        for (int ai = 0; ai < 2; ++ai)
#pragma unroll
            for (int m = 0; m < 4; ++m) { const int k1sub = 2 * ai + wr, k2 = m * 16 + fr;
#pragma unroll
                for (int bj = 0; bj < 2; ++bj) { const int n = u.pn * BM + bj * HALF + wc * 32 + 8 * fq, ch = n & 1023, k1q = (n >> 10) & 31, b = n >> 15;
                    const f32x4 v0 = acc[ai][bj][m][0] * scale, v1 = acc[ai][bj][m][1] * scale;
                    u32x4 w; w.x = pk2(v0[0], v0[1]); w.y = pk2(v0[2], v0[3]); w.z = pk2(v1[0], v1[1]); w.w = pk2(v1[2], v1[3]);
                    *(u32x4*)(O + (size_t)(b * SEQ + 4 * k1q + k1sub + 128 * k2) * D + ch) = w; } }
    }
};
}

__device__ __forceinline__ void wtrans_tile(const float* __restrict__ W, int N, int k0, int n0, bf16_t* __restrict__ WT, int K, int dstrow0, LAS bf16_t* scr, int lane) {
#pragma unroll 4
    for (int it = 0; it < 16; ++it) { const int kk = it * 4 + (lane >> 4), c4 = (lane & 15) * 4;
        const f32x4 v = *(const f32x4*)(W + (size_t)(k0 + kk) * N + n0 + c4);
        scr[(c4 + 0) * 72 + kk] = f2bf(v[0]); scr[(c4 + 1) * 72 + kk] = f2bf(v[1]); scr[(c4 + 2) * 72 + kk] = f2bf(v[2]); scr[(c4 + 3) * 72 + kk] = f2bf(v[3]); }
    LDS_WAIT();
#pragma unroll
    for (int it = 0; it < 8; ++it) { const int n = it * 8 + (lane >> 3), kc = (lane & 7) * 8;
        const u32x4 o = *(const LAS u32x4*)(scr + n * 72 + kc);
        *(u32x4*)(WT + (size_t)(dstrow0 + n) * K + k0 + kc) = o; }
    LDS_WAIT();
}
__device__ __forceinline__ void wtrans_tile8(const float* __restrict__ W, int N, int k0, int n0, unsigned char* __restrict__ WT, int K, int dstrow0, LAS unsigned char* scr, int lane) {
#pragma unroll 4
    for (int it = 0; it < 16; ++it) { const int kk = it * 4 + (lane >> 4), c4 = (lane & 15) * 4;
        const f32x4 v = *(const f32x4*)(W + (size_t)(k0 + kk) * N + n0 + c4) * S_W8;
        const unsigned w = pk4_fp8(v[0], v[1], v[2], v[3]);
        scr[(c4 + 0) * 80 + kk] = (unsigned char)(w & 0xff); scr[(c4 + 1) * 80 + kk] = (unsigned char)((w >> 8) & 0xff); scr[(c4 + 2) * 80 + kk] = (unsigned char)((w >> 16) & 0xff); scr[(c4 + 3) * 80 + kk] = (unsigned char)(w >> 24); }
    LDS_WAIT();
#pragma unroll
    for (int it = 0; it < 4; ++it) { const int n = it * 16 + (lane >> 2), kc = (lane & 3) * 16;
        const u32x4 o = *(const LAS u32x4*)(scr + n * 80 + kc);
        *(u32x4*)(WT + (size_t)(dstrow0 + n) * K + k0 + kc) = o; }
    LDS_WAIT();
}
__device__ __forceinline__ int gu_row(int n, int F) { const int part = n >= F, f = n - part * F; return (f >> 7) * 256 + part * 128 + (f & 127); }

__device__ __forceinline__ void phase0(const Params& p, LAS unsigned char* lds) {
    const int tid = otid(), lane = tid & 63, wid = tid >> 6, G = gridDim.x;
    {
        LAS float* sc = (LAS float*)lds;
        LAS float* red = sc + 5 * 1024;
        for (int item = blockIdx.x; item < 192; item += G) {
            const int layer = item / 96, cchunk = item % 96;
            const float* W = p.in[layer ? 19 : 6]; const float* bias = p.in[layer ? 20 : 7];
            __syncthreads();
            for (int i = tid; i < 5 * 1024; i += 512) { const int v = i >> 10, k = i & 1023; const float c = (v < 4) ? p.in[1][v * 1024 + k] : p.in[3][k]; sc[i] = c / (1.0f + __expf(-c)); }
            __syncthreads();
            const int col = cchunk * 64 + (tid & 63), kg = tid >> 6;
            float a0 = 0.f, a1 = 0.f, a2 = 0.f, a3 = 0.f, a4 = 0.f;
#pragma unroll 8
            for (int k = kg * 128; k < kg * 128 + 128; ++k) { const float w = W[(size_t)k * 6144 + col];
                a0 += sc[k] * w; a1 += sc[1024 + k] * w; a2 += sc[2048 + k] * w; a3 += sc[3072 + k] * w; a4 += sc[4096 + k] * w; }
            red[(kg * 5 + 0) * 64 + (tid & 63)] = a0; red[(kg * 5 + 1) * 64 + (tid & 63)] = a1; red[(kg * 5 + 2) * 64 + (tid & 63)] = a2;
            red[(kg * 5 + 3) * 64 + (tid & 63)] = a3; red[(kg * 5 + 4) * 64 + (tid & 63)] = a4;
            __syncthreads();
            if (tid < 320) { const int v = tid >> 6, cl = tid & 63; float s = 0.f;
#pragma unroll
                for (int g = 0; g < 8; ++g) s += red[(g * 5 + v) * 64 + cl];
                s += bias[cchunk * 64 + cl];
                if (layer == 0) ((float*)(p.ws + WS_ADA0))[v * 6144 + cchunk * 64 + cl] = s;
                else if (v < 4) ((float*)(p.ws + WS_ADA1))[v * 6144 + cchunk * 64 + cl] = s; }
        }
        __syncthreads();
    }
    {
        bf16_t* WC2 = (bf16_t*)(p.ws + WS_WC2);
        for (int i = blockIdx.x * 512 + tid; i < 256 * 128; i += G * 512) { const int r = i >> 7, c = i & 127, m = r >> 1, part = r & 1;
            float sv, cv; sincospif((float)((c * m) & 127) * (1.0f / 64.0f), &sv, &cv); WC2[i] = f2bf(part ? sv : cv); }
    }
    {
        bf16_t* M1 = (bf16_t*)(p.ws + WS_M1); bf16_t* M3 = (bf16_t*)(p.ws + WS_M3); float* TW = (float*)(p.ws + WS_TW);
        for (int i = blockIdx.x * 512 + tid; i < 256 * 256 + 256 * 512 + 128 * 64; i += G * 512) {
            if (i < 256 * 256) { const int r = i >> 8, kk = i & 255, k1 = r & 127, im = r >> 7, part = kk >> 7, n1 = kk & 127;
                float sv, cv; sincospif((float)((n1 * k1) & 127) * (1.0f / 64.0f), &sv, &cv);
                const float v = im == 0 ? (part == 0 ? cv : -sv) : (part == 0 ? sv : cv); M1[i] = f2bf(v);
            } else if (i < 256 * 256 + 256 * 512) { const int q = i - 256 * 256, r = q >> 9, kk = q & 511, k1s = r >> 6, k2 = r & 63, k1s2 = kk >> 7, part = (kk >> 6) & 1, n2 = kk & 63;
                float sv, cv; sincospif((float)((n2 * k2) & 63) * (1.0f / 32.0f), &sv, &cv);
                M3[q] = f2bf(k1s == k1s2 ? (part == 0 ? cv : -sv) : 0.f);
            } else { const int q = i - 256 * 256 - 256 * 512, k1 = q >> 6, n2 = q & 63;
                float sv, cv; sincospif((float)(n2 * k1) * (1.0f / 4096.0f), &sv, &cv); TW[2 * q] = cv; TW[2 * q + 1] = sv; }
        }
    }
    {
        LAS bf16_t* scr = (LAS bf16_t*)lds + wid * (64 * 72);
        constexpr int T_IN = 16 * 48, T_OUT = 16 * 16, T_GU = 16 * 88, T_DN = 44 * 16, T_FO = 16 * 16, T_EGU = 16 * 112, T_EDN = 56 * 16;
        constexpr int TOTAL = T_IN + T_OUT + T_GU + T_DN + T_FO + NE * T_EGU + NE * T_EDN;
        constexpr int NG = (TOTAL + 7) / 8;
        const int nb = blockIdx.x; const bool bal = (G == 256), spare = bal && nb >= 192;
        for (int rr = 0;; ++rr) {
            int grp; if (bal) { if (spare && rr < 4) grp = (nb - 192) * 4 + rr; else grp = 256 + (rr - (spare ? 4 : 0)) * 256 + nb; } else grp = rr * G + nb;
            if (grp >= NG) break;
            const int it = grp * 8 + wid; if (it >= TOTAL) continue;
            int r = it;
            if (r < T_IN) { const int kb = r / 48, nb = r % 48; wtrans_tile(p.in[8], INW, kb * 64, nb * 64, (bf16_t*)(p.ws + WS_WT_IN), D, nb * 64, scr, lane); continue; } r -= T_IN;
            if (r < T_OUT) { const int kb = r / 16, nb = r % 16; wtrans_tile(p.in[14], D, kb * 64, nb * 64, (bf16_t*)(p.ws + WS_WT_OUT), D, nb * 64, scr, lane); continue; } r -= T_OUT;
#if USE_FP8_FFN
            if (r < T_GU) { const int kb = r / 88, nb = r % 88; wtrans_tile8(p.in[15], 2 * FFN, kb * 64, nb * 64, p.ws + WS_WT_GU, D, gu_row(nb * 64, FFN), (LAS unsigned char*)scr, lane); continue; } r -= T_GU;
#else
            if (r < T_GU) { const int kb = r / 88, nb = r % 88; wtrans_tile(p.in[15], 2 * FFN, kb * 64, nb * 64, (bf16_t*)(p.ws + WS_WT_GU), D, gu_row(nb * 64, FFN), scr, lane); continue; } r -= T_GU;
#endif
#if USE_FP8_FFN || USE_FP8_FFN2
            if (r < T_DN) { const int kb = r / 16, nb = r % 16; wtrans_tile8(p.in[16], D, kb * 64, nb * 64, p.ws + WS_WT_DOWN, FFN, nb * 64, (LAS unsigned char*)scr, lane); continue; } r -= T_DN;
#else
            if (r < T_DN) { const int kb = r / 16, nb = r % 16; wtrans_tile(p.in[16], D, kb * 64, nb * 64, (bf16_t*)(p.ws + WS_WT_DOWN), FFN, nb * 64, scr, lane); continue; } r -= T_DN;
#endif
            if (r < T_FO) { const int kb = r / 16, nb = r % 16; wtrans_tile(p.in[21], D, kb * 64, nb * 64, (bf16_t*)(p.ws + WS_WT_FOUR), D, nb * 64, scr, lane); continue; } r -= T_FO;
            if (r < NE * T_EGU) { const int e = r / T_EGU, q = r % T_EGU, kb = q / 112, nb = q % 112;
#if USE_FP8
                wtrans_tile8(p.in[23] + (size_t)e * D * 2 * EDIM, 2 * EDIM, kb * 64, nb * 64, p.ws + WS_WT_EGU + (size_t)e * 2 * EDIM * D, D, gu_row(nb * 64, EDIM), (LAS unsigned char*)scr, lane); continue; } r -= NE * T_EGU;
#else
                wtrans_tile(p.in[23] + (size_t)e * D * 2 * EDIM, 2 * EDIM, kb * 64, nb * 64, (bf16_t*)(p.ws + WS_WT_EGU) + (size_t)e * 2 * EDIM * D, D, gu_row(nb * 64, EDIM), scr, lane); continue; } r -= NE * T_EGU;
#endif
            { const int e = r / T_EDN, q = r % T_EDN, kb = q / 16, nb = q % 16;
#if USE_FP8
                wtrans_tile8(p.in[24] + (size_t)e * EDIM * D, D, kb * 64, nb * 64, p.ws + WS_WT_EDOWN + (size_t)e * D * EDIM, EDIM, nb * 64, (LAS unsigned char*)scr, lane); }
#else
                wtrans_tile(p.in[24] + (size_t)e * EDIM * D, D, kb * 64, nb * 64, (bf16_t*)(p.ws + WS_WT_EDOWN) + (size_t)e * D * EDIM, EDIM, nb * 64, scr, lane); }
#endif
        }
    }
}

__device__ __forceinline__ void norm_row(const float* __restrict__ xr, const float* __restrict__ gain, const float* __restrict__ sh, const float* __restrict__ sc, bf16_t* __restrict__ orow, int lane, f32x4 (&hv)[4], bool f8 = false) {
    f32x4 v[4]; float s = 0.f;
#pragma unroll
    for (int j = 0; j < 4; ++j) { v[j] = *(const f32x4*)(xr + 4 * lane + 256 * j); s += (v[j][0] * v[j][0] + v[j][1] * v[j][1]) + (v[j][2] * v[j][2] + v[j][3] * v[j][3]); }
    const float rstd = rsqrtf(wave_sum(s) * (1.0f / D) + EPS);
#pragma unroll
    for (int j = 0; j < 4; ++j) { const f32x4 g = *(const f32x4*)(gain + 4 * lane + 256 * j), a = *(const f32x4*)(sh + 4 * lane + 256 * j), b = *(const f32x4*)(sc + 4 * lane + 256 * j);
        f32x4 h;
#pragma unroll
        for (int e = 0; e < 4; ++e) h[e] = (v[j][e] * rstd * g[e]) * (1.0f + b[e]) + a[e];
        hv[j] = h;
        if (f8) *(unsigned*)((unsigned char*)orow + 4 * lane + 256 * j) = pk4_fp8(h[0] * S_A8, h[1] * S_A8, h[2] * S_A8, h[3] * S_A8);
        else *(u32x2*)(orow + 4 * lane + 256 * j) = (u32x2){pk2(h[0], h[1]), pk2(h[2], h[3])}; }
}
template <int NR, bool ROUTER>
__device__ __forceinline__ void norm_rows4(const float* __restrict__ x0, const float* __restrict__ gain, const float* __restrict__ sh, const float* __restrict__ sc,
                                           unsigned char* __restrict__ o0, int opitch, bool f8, int lane, const LAS float* wr, float (&lg)[NR][8]) {
    f32x4 v[NR][4]; float rstd[NR];
#pragma unroll
    for (int r = 0; r < NR; ++r)
#pragma unroll
        for (int j = 0; j < 4; ++j) v[r][j] = *(const f32x4*)(x0 + (size_t)r * D + 4 * lane + 256 * j);
#pragma unroll
    for (int r = 0; r < NR; ++r) { float s = 0.f;
#pragma unroll
        for (int j = 0; j < 4; ++j) s += (v[r][j][0] * v[r][j][0] + v[r][j][1] * v[r][j][1]) + (v[r][j][2] * v[r][j][2] + v[r][j][3] * v[r][j][3]);
        rstd[r] = rsqrtf(wave_sum(s) * (1.0f / D) + EPS); }
    if (ROUTER) {
#pragma unroll
        for (int r = 0; r < NR; ++r)
#pragma unroll
            for (int e = 0; e < 8; ++e) lg[r][e] = 0.f; }
#pragma unroll
    for (int j = 0; j < 4; ++j) { const int c = 4 * lane + 256 * j;
        const f32x4 g = *(const f32x4*)(gain + c), a = *(const f32x4*)(sh + c), b = *(const f32x4*)(sc + c);
        f32x4 h[NR];
#pragma unroll
        for (int r = 0; r < NR; ++r) {
#pragma unroll
            for (int e = 0; e < 4; ++e) h[r][e] = (v[r][j][e] * rstd[r] * g[e]) * (1.0f + b[e]) + a[e];
            if (f8) *(unsigned*)(o0 + (size_t)r * opitch + c) = pk4_fp8(h[r][0] * S_A8, h[r][1] * S_A8, h[r][2] * S_A8, h[r][3] * S_A8);
            else *(u32x2*)(o0 + (size_t)r * opitch + 2 * c) = (u32x2){pk2(h[r][0], h[r][1]), pk2(h[r][2], h[r][3])}; }
        if (ROUTER) {
#pragma unroll
            for (int q = 0; q < 4; ++q) { const f32x4 w0 = *(const LAS f32x4*)(wr + (c + q) * 8), w1 = *(const LAS f32x4*)(wr + (c + q) * 8 + 4);
#pragma unroll
                for (int r = 0; r < NR; ++r) { const float hh = h[r][q];
                    lg[r][0] += hh * w0[0]; lg[r][1] += hh * w0[1]; lg[r][2] += hh * w0[2]; lg[r][3] += hh * w0[3]; lg[r][4] += hh * w1[0]; lg[r][5] += hh * w1[1]; lg[r][6] += hh * w1[2]; lg[r][7] += hh * w1[3]; } } } }
}
__device__ __forceinline__ void phase_norm(const Params& p, const float* X, const float* gain, const float* ada, int chunk_shift, bool with_ctx, bool f8 = false) {
    const int lane = otid() & 63, gw = blockIdx.x * 8 + (otid() >> 6), NW = gridDim.x * 8;
    unsigned char* H = p.ws + WS_H; const int opitch = f8 ? D : 2 * D;
    float lg[8][8];
    for (int r0 = gw * 8; r0 < T; r0 += NW * 8) { const int b = r0 >> 13;
        norm_rows4<8, false>(X + (size_t)r0 * D, gain, ada + b * 6144 + chunk_shift * 1024, ada + b * 6144 + (chunk_shift + 1) * 1024, H + (size_t)r0 * opitch, opitch, f8, lane, nullptr, lg); }
    if (with_ctx) { unsigned char* HX = p.ws + WS_HX;
        for (int r0 = gw * 8; r0 < TX; r0 += NW * 8) norm_rows4<8, false>(p.in[2] + (size_t)r0 * D, gain, ada + 4 * 6144, ada + 4 * 6144 + 1024, HX + (size_t)r0 * 2 * D, 2 * D, false, lane, nullptr, lg); }
}
__device__ __forceinline__ void phase_norm_router(const Params& p, LAS unsigned char* lds) {
    const int tid = otid(), lane = tid & 63, wid = tid >> 6;
    LAS float* wr = (LAS float*)lds;
    LAS int* hist = (LAS int*)(lds + 32768);
    for (int i = tid; i < 8192; i += 512) wr[i] = p.in[22][i];
    const float* X = p.out; const float* gain = p.in[18]; const float* ada = (const float*)(p.ws + WS_ADA1);
    unsigned char* H = p.ws + WS_H; const int opitch = USE_FP8 ? D : 2 * D;
    int* toke = (int*)(p.ws + WS_TOKE); f32x2* tokg = (f32x2*)(p.ws + WS_TOKG); int* histg = (int*)(p.ws + WS_HIST);
    for (int ch = blockIdx.x; ch < 256; ch += gridDim.x) {
        __syncthreads();
        if (tid < 8) hist[tid] = 0;
        __syncthreads();
        for (int rr = wid * 2; rr < 128; rr += 16) { const int row0 = ch * 128 + rr, b = row0 >> 13;
            float lg[2][8];
            norm_rows4<2, true>(X + (size_t)row0 * D, gain, ada + b * 6144 + 3 * 1024, ada + b * 6144 + 4 * 1024, H + (size_t)row0 * opitch, opitch, USE_FP8 != 0, lane, wr, lg);
#pragma unroll
            for (int r = 0; r < 2; ++r) {
#pragma unroll
                for (int e = 0; e < 8; ++e) lg[r][e] = wave_sum(lg[r][e]);
                int e0 = 0; float l0 = lg[r][0];
#pragma unroll
                for (int e = 1; e < 8; ++e) if (lg[r][e] > l0) { l0 = lg[r][e]; e0 = e; }
                int e1 = -1; float l1 = -3.0e38f;
#pragma unroll
                for (int e = 0; e < 8; ++e) if (e != e0 && lg[r][e] > l1) { l1 = lg[r][e]; e1 = e; }
                if (lane == 0) { const float ex = __expf(l1 - l0); const float g0 = 1.0f / (1.0f + ex);
                    toke[row0 + r] = e0 | (e1 << 8); tokg[row0 + r] = (f32x2){g0, ex * g0};
                    lds_add(&hist[e0], 1); lds_add(&hist[e1], 1); } }
        }
        __syncthreads();
        if (tid < 8) histg[ch * 8 + tid] = hist[tid];
    }
}

__device__ __forceinline__ void moe_totals(const Params& p, LAS int* tot  , LAS int* bef  , int ch) {
    const int tid = otid(); const int* histg = (const int*)(p.ws + WS_HIST);
    __syncthreads();
    if (tid < 8) { tot[tid] = 0; bef[tid] = 0; }
    __syncthreads();
    for (int i = tid; i < 2048; i += 512) { const int v = histg[i]; lds_add(&tot[i & 7], v); if ((i >> 3) < ch) lds_add(&bef[i & 7], v); }
    __syncthreads();
}
__device__ __forceinline__ void phase_slots(const Params& p, LAS unsigned char* lds) {
    const int tid = otid(), lane = tid & 63, wid = tid >> 6;
    LAS int* tot = (LAS int*)lds; LAS int* bef = tot + 8; LAS int* pst = bef + 8; LAS int* te = pst + 16; LAS int* sl = te + 128;
    const int* toke = (const int*)(p.ws + WS_TOKE); const f32x2* tokg = (const f32x2*)(p.ws + WS_TOKG);
    int* toks = (int*)(p.ws + WS_TOKS); int* sltok = (int*)(p.ws + WS_SLTOK); float* slg = (float*)(p.ws + WS_SLGATE);
    const unsigned char* H8 = p.ws + WS_H; unsigned char* H8S = p.ws + WS_B + B_H8S;
    for (int ch = blockIdx.x; ch < 256; ch += gridDim.x) {
        moe_totals(p, tot, bef, ch);
        if (tid == 0) { int s = 0; for (int e = 0; e < 8; ++e) { pst[e] = s; s += (tot[e] + 255) & ~255; } pst[8] = s; }
        if (tid < 128) te[tid] = toke[ch * 128 + tid];
        __syncthreads();
        if (tid < 8) { const int e = tid; int slot = pst[e] + bef[e];
            for (int i = 0; i < 128; ++i) { const int w = te[i], t = ch * 128 + i;
                if ((w & 255) == e) { sltok[slot] = t; slg[slot] = tokg[t][0]; toks[2 * t] = slot; sl[2 * i] = slot; ++slot; }
                if ((w >> 8) == e) { sltok[slot] = t; slg[slot] = tokg[t][1]; toks[2 * t + 1] = slot; sl[2 * i + 1] = slot; ++slot; } }
            if (ch == 255) { const int end = pst[e + 1]; for (; slot < end; ++slot) { sltok[slot] = 0; slg[slot] = 0.f; } } }
        __syncthreads();
#if USE_FP8
        for (int i = wid; i < 128; i += 8) { const u32x4 v = *(const u32x4*)(H8 + (size_t)(ch * 128 + i) * D + lane * 16);
            *(u32x4*)(H8S + (size_t)sl[2 * i] * D + lane * 16) = v; *(u32x4*)(H8S + (size_t)sl[2 * i + 1] * D + lane * 16) = v; }
#endif
    }
}

__device__ __forceinline__ void rope4(float (&x)[8], int head_pair0, int pos, float scale) {
    const float row = (float)(pos >> 6), col = (float)(pos & 63);
#pragma unroll
    for (int e = 0; e < 4; ++e) { const int pp = head_pair0 + e; const float base = pp < 16 ? row : col; const int f = pp & 15;
        const float inv = exp2f(-(float)f * (13.287712379549449f / 16.0f));
        float sn, cs; sincosf(base * inv, &sn, &cs);
        const float x1 = x[2 * e], x2 = x[2 * e + 1]; x[2 * e] = (x1 * cs - x2 * sn) * scale; x[2 * e + 1] = (x1 * sn + x2 * cs) * scale; }
}
__device__ __forceinline__ void headnorm_store(const u32x4 w, bf16_t* ptr, const float* gain, int lane) {
    float x[8]; unpack8(w, x);
    float s = 0.f;
#pragma unroll
    for (int e = 0; e < 8; ++e) s += x[e] * x[e];
    s += __shfl_xor(s, 1); s += __shfl_xor(s, 2); s += __shfl_xor(s, 4);
    const float rstd = rsqrtf(s * (1.0f / 64.0f) + EPS);
    const f32x4 g0 = *(const f32x4*)(gain + (lane & 7) * 8), g1 = *(const f32x4*)(gain + (lane & 7) * 8 + 4);
#pragma unroll
    for (int e = 0; e < 4; ++e) { x[e] = x[e] * rstd * g0[e]; x[4 + e] = x[4 + e] * rstd * g1[e]; }
    *(u32x4*)(ptr + lane * 8) = pack8(x);
}
__device__ __forceinline__ void headnorm_inplace(bf16_t* ptr, const float* gain, int lane) { headnorm_store(*(const u32x4*)(ptr + lane * 8), ptr, gain, lane); }
__device__ __forceinline__ void btrans_tile(const bf16_t* __restrict__ src, int lds_, bf16_t* __restrict__ dst, int ldd, int dstrow0, int dstcol0, int mode, int pos0, LAS bf16_t* scr, int lane) {
#pragma unroll 2
    for (int it = 0; it < 8; ++it) { const int rr = it * 8 + (lane >> 3), ck = lane & 7;
        u32x4 w = *(const u32x4*)(src + (size_t)rr * lds_ + ck * 8);
        if (mode) { float x[8]; unpack8(w, x);
            if (mode == 2) rope4(x, ck * 4, pos0 + rr, 0.125f);
            else {
#pragma unroll
                for (int e = 0; e < 8; ++e) x[e] *= 0.125f; }
            w = pack8(x); }
        const int c0 = ck * 8;
        scr[(c0 + 0) * 72 + rr] = (bf16_t)(w.x & 0xffff); scr[(c0 + 1) * 72 + rr] = (bf16_t)(w.x >> 16);
        scr[(c0 + 2) * 72 + rr] = (bf16_t)(w.y & 0xffff); scr[(c0 + 3) * 72 + rr] = (bf16_t)(w.y >> 16);
        scr[(c0 + 4) * 72 + rr] = (bf16_t)(w.z & 0xffff); scr[(c0 + 5) * 72 + rr] = (bf16_t)(w.z >> 16);
        scr[(c0 + 6) * 72 + rr] = (bf16_t)(w.w & 0xffff); scr[(c0 + 7) * 72 + rr] = (bf16_t)(w.w >> 16); }
    LDS_WAIT();
#pragma unroll
    for (int it = 0; it < 8; ++it) { const int c = it * 8 + (lane >> 3), rc = (lane & 7) * 8;
        const u32x4 o = *(const LAS u32x4*)(scr + c * 72 + rc);
        *(u32x4*)(dst + (size_t)(dstrow0 + c) * ldd + dstcol0 + rc) = o; }
    LDS_WAIT();
}
__device__ __forceinline__ void phase3(const Params& p, LAS unsigned char* lds) {
    const int lane = otid() & 63, wid = otid() >> 6, gw = blockIdx.x * 8 + wid, NW = gridDim.x * 8;
    bf16_t* proj = (bf16_t*)(p.ws + WS_B + B_PROJ); bf16_t* projx = (bf16_t*)(p.ws + WS_B + B_PROJX);
    bf16_t* rkr = (bf16_t*)(p.ws + WS_B + B_RKR);
    const float* qg = p.in[9]; const float* kg = p.in[10];
    for (int row0 = gw * 4; row0 < T; row0 += NW * 4) {
        u32x4 wq[4], wk[4], wr_[4];
#pragma unroll
        for (int r = 0; r < 4; ++r) { const bf16_t* pr = proj + (size_t)(row0 + r) * INW; const int l5 = lane & 31;
            wq[r] = *(const u32x4*)(pr + C_NAQ + lane * 8); wk[r] = *(const u32x4*)(pr + C_NAK + lane * 8); wr_[r] = *(const u32x4*)(pr + (lane < 32 ? C_RQ : C_RK) + l5 * 8); }
#pragma unroll
        for (int r = 0; r < 4; ++r) { bf16_t* pr = proj + (size_t)(row0 + r) * INW; const int pos = (row0 + r) & (SEQ - 1), l5 = lane & 31;
            headnorm_store(wq[r], pr + C_NAQ, qg, lane); headnorm_store(wk[r], pr + C_NAK, kg, lane);
            float x[8]; unpack8(wr_[r], x);
            rope4(x, (l5 & 7) * 4, pos, lane < 32 ? 1.0f : 0.125f);
            bf16_t* dstp = lane < 32 ? pr + C_RQ + l5 * 8 : rkr + (size_t)(row0 + r) * 256 + l5 * 8;
            *(u32x4*)dstp = pack8(x); }
    }
    for (int row = gw; row < TX; row += NW) headnorm_inplace(projx + (size_t)row * KVW + X_NAK, kg, lane);
    LAS bf16_t* scr = (LAS bf16_t*)lds + wid * (64 * 72);
    bf16_t* navt = (bf16_t*)(p.ws + WS_B + B_NAVT); bf16_t* retvt = (bf16_t*)(p.ws + WS_B + B_RETVT); bf16_t* retkt = (bf16_t*)(p.ws + WS_B + B_RETKT);
    bf16_t* navxt = (bf16_t*)(p.ws + WS_B + B_NAVXT); bf16_t* retvxt = (bf16_t*)(p.ws + WS_B + B_RETVXT); bf16_t* retkxt = (bf16_t*)(p.ws + WS_B + B_RETKXT);
    constexpr int NT_L = 512 * 20, NT_X = 16 * 20;
    for (int it = gw; it < NT_L + NT_X; it += NW) {
        if (it < NT_L) { const int tt = it / 20, ct = it % 20, b = tt >> 7, n0 = (tt & 127) * 64; const bf16_t* srow = proj + (size_t)tt * 64 * INW;
            if (ct < 8) btrans_tile(srow + C_NAV + ct * 64, INW, navt, SEQ, b * 512 + ct * 64, n0, 0, 0, scr, lane);
            else if (ct < 16) btrans_tile(srow + C_RV + (ct - 8) * 64, INW, retvt, SEQ, b * 512 + (ct - 8) * 64, n0, 0, 0, scr, lane);
            else btrans_tile(srow + C_RK + (ct - 16) * 64, INW, retkt, SEQ, b * 256 + (ct - 16) * 64, n0, 2, n0, scr, lane);
        } else { const int q = it - NT_L, tt = q / 20, ct = q % 20, b = tt >> 2, l0 = (tt & 3) * 64; const bf16_t* srow = projx + (size_t)tt * 64 * KVW;
            if (ct < 8) btrans_tile(srow + X_NAV + ct * 64, KVW, navxt, CTXL, b * 512 + ct * 64, l0, 0, 0, scr, lane);
            else if (ct < 16) btrans_tile(srow + X_RV + (ct - 8) * 64, KVW, retvxt, CTXL, b * 512 + (ct - 8) * 64, l0, 0, 0, scr, lane);
            else btrans_tile(srow + X_RK + (ct - 16) * 64, KVW, retkxt, CTXL, b * 256 + (ct - 16) * 64, l0, 1, 0, scr, lane);
        }
    }
}

struct NaState { f32x4 o[4]; float l; };
struct NaK { u32x4 k[2][2][2]; };
struct NaV { u32x4 v[2][4]; };
struct NaPtrs { const bf16_t* ks0; const bf16_t* vs0; const bf16_t* kx0; const bf16_t* vx0; };
__device__ __forceinline__ void na_loadK(NaK& f, const NaPtrs& P, int ci, int fr, int fq) {
    const bool strip = ci < 4; const size_t kld = strip ? INW : KVW;
    const bf16_t* kb0 = strip ? P.ks0 + (size_t)ci * 128 * INW : P.kx0 + (size_t)(ci - 4) * 64 * KVW;
    const bf16_t* kb1 = kb0 + (strip ? (size_t)64 * INW : (size_t)32 * KVW);
    const int kkrow = 8 * (fr >> 2) + (fr & 3);
#pragma unroll
    for (int i = 0; i < 2; ++i)
#pragma unroll
        for (int t = 0; t < 2; ++t) { const bf16_t* kp = (i ? kb1 : kb0) + (size_t)(kkrow + 4 * t) * kld + fq * 8; f.k[i][t][0] = *(const u32x4*)kp; f.k[i][t][1] = *(const u32x4*)(kp + 32); }
}
__device__ __forceinline__ void na_loadV(NaV& f, const NaPtrs& P, int ci, int fr, int fq) {
    const bool strip = ci < 4; const size_t vld = strip ? SEQ : CTXL;
    const bf16_t* vb0 = strip ? P.vs0 + ci * 128 : P.vx0 + (ci - 4) * 64;
    const bf16_t* vb1 = vb0 + (strip ? 64 : 32);
#pragma unroll
    for (int i = 0; i < 2; ++i)
#pragma unroll
        for (int dt = 0; dt < 4; ++dt) f.v[i][dt] = *(const u32x4*)((i ? vb1 : vb0) + (size_t)(dt * 16 + fr) * vld + 8 * fq);
}
constexpr int NA_LK_PITCH = 144, NA_LV_PITCH = 528, NA_LV_OFF = 256 * NA_LK_PITCH, NA_RPB_OFF = NA_LV_OFF + 64 * NA_LV_PITCH;
__device__ __forceinline__ void na_loadK_x(NaK& f, const LAS unsigned char* lk, int cx, int fr, int fq) {
    const int kkrow = 8 * (fr >> 2) + (fr & 3);
#pragma unroll
    for (int i = 0; i < 2; ++i)
#pragma unroll
        for (int t = 0; t < 2; ++t) { const LAS unsigned char* kp = lk + (64 * cx + 32 * i + kkrow + 4 * t) * NA_LK_PITCH + fq * 16; f.k[i][t][0] = *(const LAS u32x4*)kp; f.k[i][t][1] = *(const LAS u32x4*)(kp + 64); }
}
__device__ __forceinline__ void na_loadV_x(NaV& f, const LAS unsigned char* lv, int cx, int fr, int fq) {
#pragma unroll
    for (int i = 0; i < 2; ++i)
#pragma unroll
        for (int dt = 0; dt < 4; ++dt) f.v[i][dt] = *(const LAS u32x4*)(lv + (dt * 16 + fr) * NA_LV_PITCH + (64 * cx + 32 * i + 8 * fq) * 2);
}
template <bool STRIP>
__device__ __forceinline__ void na_compute(NaState& st, const NaK& fk, const NaV& fv, const u32x4 (&qf)[2], const LAS float* brow0, const LAS float* brow1, int cb, int c0, int qc, int fq, float sref) {
    f32x4 s[2][2];
#pragma unroll
    for (int i = 0; i < 2; ++i)
#pragma unroll
        for (int t = 0; t < 2; ++t) { f32x4 a = mfma16(fk.k[i][t][0], qf[0], (f32x4){0.f, 0.f, 0.f, 0.f}); s[i][t] = mfma16(fk.k[i][t][1], qf[1], a); }
    float sum = 0.f; u32x4 pf[2];
#pragma unroll
    for (int i = 0; i < 2; ++i) { float e[8];
#pragma unroll
        for (int t = 0; t < 2; ++t)
#pragma unroll
            for (int j = 0; j < 4; ++j) { float v = s[i][t][j] * 0.125f - sref;
                if (STRIP) { const int kc = cb + 8 * fq + 4 * t + j; const bool valid = (unsigned)(kc - c0) < 16u; const int co = min(max(kc - qc + 15, 0), 30);
                    v = valid ? v + (i ? brow1 : brow0)[co] : -3.0e38f; }
                const float pe = __expf(v); e[t * 4 + j] = pe; sum += pe; }
        pf[i] = pack8(e); }
    st.l += sum;
#pragma unroll
    for (int i = 0; i < 2; ++i)
#pragma unroll
        for (int dt = 0; dt < 4; ++dt) st.o[dt] = mfma16(fv.v[i][dt], pf[i], st.o[dt]);
}
__device__ __forceinline__ void na_item(const Params& p, int b, int h, int r, int g, int lane, const LAS unsigned char* lds, float sref) {
    const int fr = lane & 15, fq = lane >> 4;
    const bf16_t* proj = (const bf16_t*)(p.ws + WS_B + B_PROJ); const bf16_t* navt = (const bf16_t*)(p.ws + WS_B + B_NAVT);
    const LAS float* rpb = (const LAS float*)(lds + NA_RPB_OFF) + h * (15 * 31);
    const LAS unsigned char* lk = lds; const LAS unsigned char* lv = lds + NA_LV_OFF;
    const int qc = 16 * g + fr, tokq = b * SEQ + r * 64 + qc;
    const int r0 = min(max(r - 4, 0), 120), cb = min(max(16 * g - 8, 0), 32), c0 = min(max(qc - 8, 0), 48);
    u32x4 qf[2];
#pragma unroll
    for (int ks = 0; ks < 2; ++ks) qf[ks] = *(const u32x4*)(proj + (size_t)tokq * INW + C_NAQ + h * 64 + ks * 32 + fq * 8);
    NaState st;
#pragma unroll
    for (int dt = 0; dt < 4; ++dt) st.o[dt] = (f32x4){0.f, 0.f, 0.f, 0.f};
    st.l = 0.f;
    NaPtrs P;
    P.ks0 = proj + (size_t)(b * SEQ + r0 * 64 + cb) * INW + C_NAK + h * 64;
    P.vs0 = navt + (size_t)(b * 512 + h * 64) * SEQ + r0 * 64 + cb;
    P.kx0 = nullptr; P.vx0 = nullptr;
    NaK ka, kb; NaV vv;
    na_loadK(ka, P, 0, fr, fq);
#pragma unroll 1
    for (int cp = 0; cp < 2; ++cp) { const int ci = 2 * cp;
        const LAS float* br0 = rpb + (r0 + 2 * ci - r + 7) * 31;
        na_loadV(vv, P, ci, fr, fq); na_loadK(kb, P, ci + 1, fr, fq);
        na_compute<true>(st, ka, vv, qf, br0, br0 + 31, cb, c0, qc, fq, sref);
        na_loadV(vv, P, ci + 1, fr, fq); if (cp == 0) na_loadK(ka, P, ci + 2, fr, fq); else na_loadK_x(ka, lk, 0, fr, fq);
        na_compute<true>(st, kb, vv, qf, br0 + 62, br0 + 93, cb, c0, qc, fq, sref); }
#pragma unroll 1
    for (int cx = 0; cx < 4; cx += 2) {
        na_loadV_x(vv, lv, cx, fr, fq); na_loadK_x(kb, lk, cx + 1, fr, fq);
        na_compute<false>(st, ka, vv, qf, rpb, rpb, 0, 0, 0, fq, sref);
        na_loadV_x(vv, lv, cx + 1, fr, fq); na_loadK_x(ka, lk, cx + 2 < 4 ? cx + 2 : 3, fr, fq);
        na_compute<false>(st, kb, vv, qf, rpb, rpb, 0, 0, 0, fq, sref); }
    float l1 = st.l;
    l1 += __shfl_xor(l1, 16); l1 += __shfl_xor(l1, 32);
    const float inv = 1.0f / l1;
    bf16_t* mix = (bf16_t*)(p.ws + WS_B + B_MIXIN) + (size_t)tokq * D + h * 64;
#pragma unroll
    for (int dt = 0; dt < 4; ++dt) { const f32x4 v = st.o[dt] * inv; *(u32x2*)(mix + dt * 16 + 4 * fq) = (u32x2){pk2(v[0], v[1]), pk2(v[2], v[3])}; }
}
__device__ __forceinline__ void na_range(const Params& p, int ulo, int uhi, LAS unsigned char* lds) {
    const int tid = otid(), lane = tid & 63, wid = tid >> 6;
    const bf16_t* projx = (const bf16_t*)(p.ws + WS_B + B_PROJX); const bf16_t* navxt = (const bf16_t*)(p.ws + WS_B + B_NAVXT);
    LAS float* rpb_l = (LAS float*)(lds + NA_RPB_OFF);
    for (int u = ulo + blockIdx.x; u < uhi; u += gridDim.x) { const int bh = u >> 3, b = bh >> 3, h = bh & 7, rbase = (u & 7) * 16;
        __syncthreads();
        for (int i = tid; i < 8 * 15 * 31; i += 512) rpb_l[i] = p.in[11][i];
        for (int i = tid; i < 2048; i += 512) { const int l = i >> 3, ck = i & 7;
            *(LAS u32x4*)(lds + l * NA_LK_PITCH + ck * 16) = *(const u32x4*)(projx + (size_t)(b * CTXL + l) * KVW + X_NAK + h * 64 + ck * 8); }
        for (int i = tid; i < 2048; i += 512) { const int d = i >> 5, ck = i & 31;
            *(LAS u32x4*)(lds + NA_LV_OFF + d * NA_LV_PITCH + ck * 16) = *(const u32x4*)(navxt + (size_t)(b * 512 + h * 64 + d) * CTXL + ck * 8); }
        __syncthreads();
        float gq = fabsf(p.in[9][lane]), gk = fabsf(p.in[10][lane]), bm = 0.f;
        for (int i = lane; i < 15 * 31; i += 64) bm = fmaxf(bm, fabsf(rpb_l[h * (15 * 31) + i]));
#pragma unroll
        for (int o = 1; o < 64; o <<= 1) { gq = fmaxf(gq, __shfl_xor(gq, o)); gk = fmaxf(gk, __shfl_xor(gk, o)); bm = fmaxf(bm, __shfl_xor(bm, o)); }
        const float sref = fminf(8.0f * 1.02f * gq * gk + bm, 40.0f);
        for (int it = wid; it < 64; it += 8) na_item(p, b, h, rbase + (it >> 2), it & 3, lane, lds, sref);
    }
}

__device__ __forceinline__ float log2_decay(float a) { return -log1pf(__expf(-a)) * 1.4426950408889634f; }
__device__ __forceinline__ void retU_item(const Params& p, int item, int lane) {
    const int w = item & 7, cc = (item >> 3) % NCC, bh = (item >> 3) / NCC, b = bh >> 2, h = bh & 3;
    const int fr = lane & 15, fq = lane >> 4;
    const float lgf = log2_decay(p.in[12][h]), lgb = log2_decay(p.in[13][h]);
    const bf16_t* vt; const bf16_t* kt; size_t ld; int n0;
    if (cc < 2) { vt = (const bf16_t*)(p.ws + WS_B + B_RETVXT); kt = (const bf16_t*)(p.ws + WS_B + B_RETKXT); ld = CTXL; n0 = cc * 128; }
    else { vt = (const bf16_t*)(p.ws + WS_B + B_RETVT); kt = (const bf16_t*)(p.ws + WS_B + B_RETKT); ld = SEQ; n0 = (cc - 2) * 128; }
    f32x4 af[4], ab[4];
#pragma unroll
    for (int nt = 0; nt < 4; ++nt) { af[nt] = (f32x4){0.f, 0.f, 0.f, 0.f}; ab[nt] = (f32x4){0.f, 0.f, 0.f, 0.f}; }
#pragma unroll
    for (int ks = 0; ks < 4; ++ks) {
        const u32x4 va = *(const u32x4*)(vt + (size_t)(b * 512 + h * 128 + 16 * w + fr) * ld + n0 + 32 * ks + 8 * fq);
        float wf[8], wb[8];
#pragma unroll
        for (int e = 0; e < 8; ++e) { const int j = 32 * ks + 8 * fq + e; wf[e] = exp2f((float)(127 - j) * lgf); wb[e] = exp2f((float)j * lgb); }
#pragma unroll
        for (int nt = 0; nt < 4; ++nt) { const u32x4 kw = *(const u32x4*)(kt + (size_t)(b * 256 + h * 64 + 16 * nt + fr) * ld + n0 + 32 * ks + 8 * fq);
            float x[8], y[8]; unpack8(kw, x);
#pragma unroll
            for (int e = 0; e < 8; ++e) { y[e] = x[e] * wb[e]; x[e] *= wf[e]; }
            af[nt] = mfma16(va, pack8(x), af[nt]); ab[nt] = mfma16(va, pack8(y), ab[nt]); }
    }
    float* U = (float*)(p.ws + WS_B + B_U);
    float* uf = U + ((size_t)(0 * 16 + bh) * NCC + cc) * 8192; float* ub = U + ((size_t)(1 * 16 + bh) * NCC + cc) * 8192;
#pragma unroll
    for (int nt = 0; nt < 4; ++nt)
#pragma unroll
        for (int j = 0; j < 4; ++j) { const int v = 16 * w + 4 * fq + j, d = 16 * nt + fr; uf[v * 64 + d] = af[nt][j]; ub[v * 64 + d] = ab[nt][j]; }
}
__device__ __forceinline__ void phase_retU(const Params& p) {
    const int lane = otid() & 63, gw = blockIdx.x * 8 + (otid() >> 6), NW = gridDim.x * 8;
    for (int it = gw; it < 16 * NCC * 8; it += NW) retU_item(p, it, lane);
}
__device__ __forceinline__ void phase_scan(const Params& p) {
    const float* U = (const float*)(p.ws + WS_B + B_U); bf16_t* S = (bf16_t*)(p.ws + WS_B + B_S);
    for (int i = blockIdx.x * 512 + otid(); i < 2 * 16 * 8192; i += gridDim.x * 512) {
        const int e = i & 8191, bh = (i >> 13) & 15, dir = i >> 17, h = bh & 3;
        const float G = exp2f(128.0f * log2_decay(dir ? p.in[13][h] : p.in[12][h]));
        const float* u = U + (size_t)(dir * 16 + bh) * NCC * 8192 + e; bf16_t* s = S + (size_t)(dir * 16 + bh) * NCHUNK * 8192 + e;
        if (dir == 0) { float st = u[0] * G + u[8192];
#pragma unroll 8
            for (int c = 0; c < NCHUNK; ++c) { s[(size_t)c * 8192] = f2bf(st); st = st * G + u[(size_t)(2 + c) * 8192]; }
        } else { float st = u[0] + G * u[8192];
#pragma unroll 8
            for (int c = NCHUNK - 1; c >= 0; --c) { s[(size_t)c * 8192] = f2bf(st); st = st * G + u[(size_t)(2 + c) * 8192]; } }
    }
}
constexpr int RO_KP = 144, RO_VP = 272, RO_SP = 144, RO_V_OFF = 128 * RO_KP, RO_S_OFF = RO_V_OFF + 128 * RO_VP;
__device__ __forceinline__ void retO_item(const Params& p, int bh, int c, int w, int lane, const LAS unsigned char* lds) {
    const int b = bh >> 2, h = bh & 3;
    const int fr = lane & 15, fq = lane >> 4;
    const float lgf = log2_decay(p.in[12][h]), lgb = log2_decay(p.in[13][h]);
    const bf16_t* proj = (const bf16_t*)(p.ws + WS_B + B_PROJ);
    const int tok0 = b * SEQ + c * 128, qi = 16 * w + fr, tokq = tok0 + qi;
    u32x4 qf[2];
#pragma unroll
    for (int ks = 0; ks < 2; ++ks) qf[ks] = *(const u32x4*)(proj + (size_t)tokq * INW + C_RQ + h * 64 + ks * 32 + fq * 8);
    const int kkrow = 8 * (fr >> 2) + (fr & 3);
    u32x4 pf[4];
#pragma unroll
    for (int kb = 0; kb < 4; ++kb) { float e[8];
#pragma unroll
        for (int t = 0; t < 2; ++t) { const LAS unsigned char* kp = lds + (32 * kb + kkrow + 4 * t) * RO_KP + fq * 16;
            const u32x4 k0 = *(const LAS u32x4*)kp, k1 = *(const LAS u32x4*)(kp + 64);
            f32x4 a = mfma16(k0, qf[0], (f32x4){0.f, 0.f, 0.f, 0.f}); a = mfma16(k1, qf[1], a);
#pragma unroll
            for (int j = 0; j < 4; ++j) { const int kj = 32 * kb + 8 * fq + 4 * t + j, df = qi - kj;
                const float dec = df > 0 ? exp2f((float)df * lgf) : (df < 0 ? exp2f((float)(-df) * lgb) : 2.0f);
                e[t * 4 + j] = a[j] * dec; } }
        pf[kb] = pack8(e); }
    f32x4 o[8];
#pragma unroll
    for (int vt = 0; vt < 8; ++vt) o[vt] = (f32x4){0.f, 0.f, 0.f, 0.f};
#pragma unroll
    for (int kb = 0; kb < 4; ++kb)
#pragma unroll
        for (int vt = 0; vt < 8; ++vt) { const u32x4 vf = *(const LAS u32x4*)(lds + RO_V_OFF + (vt * 16 + fr) * RO_VP + (32 * kb + 8 * fq) * 2);
            o[vt] = mfma16(vf, pf[kb], o[vt]); }
    const float xif = exp2f((float)(qi + 1) * lgf), xib = exp2f((float)(128 - qi) * lgb);
#pragma unroll
    for (int dir = 0; dir < 2; ++dir) { const float xi = dir ? xib : xif; const LAS unsigned char* sp = lds + RO_S_OFF + dir * 128 * RO_SP;
#pragma unroll
        for (int ks = 0; ks < 2; ++ks) { float x[8]; unpack8(qf[ks], x);
#pragma unroll
            for (int e = 0; e < 8; ++e) x[e] *= xi;
            const u32x4 qs = pack8(x);
#pragma unroll
            for (int vt = 0; vt < 8; ++vt) { const u32x4 sf = *(const LAS u32x4*)(sp + (vt * 16 + fr) * RO_SP + ks * 64 + fq * 16); o[vt] = mfma16(sf, qs, o[vt]); } } }
    float ss = 0.f;
#pragma unroll
    for (int vt = 0; vt < 8; ++vt)
#pragma unroll
        for (int j = 0; j < 4; ++j) ss += o[vt][j] * o[vt][j];
    ss += __shfl_xor(ss, 16); ss += __shfl_xor(ss, 32);
    const float rstd = rsqrtf(ss * (1.0f / 128.0f) + EPS);
    const bf16_t* rg = proj + (size_t)tokq * INW + C_RG + h * 128; bf16_t* mix = (bf16_t*)(p.ws + WS_B + B_MIXIN) + (size_t)tokq * D + 512 + h * 128;
#pragma unroll
    for (int vt = 0; vt < 8; ++vt) { const u32x2 gw2 = *(const u32x2*)(rg + vt * 16 + 4 * fq);
        const float g0 = silu_f(bflo(gw2.x)), g1 = silu_f(bfhi(gw2.x)), g2 = silu_f(bflo(gw2.y)), g3 = silu_f(bfhi(gw2.y));
        *(u32x2*)(mix + vt * 16 + 4 * fq) = (u32x2){pk2(o[vt][0] * rstd * g0, o[vt][1] * rstd * g1), pk2(o[vt][2] * rstd * g2, o[vt][3] * rstd * g3)}; }
}
__device__ __forceinline__ void phase_retO(const Params& p, LAS unsigned char* lds) {
    const int tid = otid(), lane = tid & 63, wid = tid >> 6;
    const bf16_t* rkr = (const bf16_t*)(p.ws + WS_B + B_RKR); const bf16_t* retvt = (const bf16_t*)(p.ws + WS_B + B_RETVT); const bf16_t* S = (const bf16_t*)(p.ws + WS_B + B_S);
    for (int u = blockIdx.x; u < 16 * 64; u += gridDim.x) { const int c = u & 63, bh = u >> 6, b = bh >> 2, h = bh & 3;
        __syncthreads();
        for (int i = tid; i < 1024; i += 512) { const int r = i >> 3, ck = i & 7;
            *(LAS u32x4*)(lds + r * RO_KP + ck * 16) = *(const u32x4*)(rkr + (size_t)(b * SEQ + c * 128 + r) * 256 + h * 64 + ck * 8); }
        for (int i = tid; i < 2048; i += 512) { const int r = i >> 4, ck = i & 15;
            *(LAS u32x4*)(lds + RO_V_OFF + r * RO_VP + ck * 16) = *(const u32x4*)(retvt + (size_t)(b * 512 + h * 128 + r) * SEQ + c * 128 + ck * 8); }
        for (int i = tid; i < 2048; i += 512) { const int dir = i >> 10, r = (i >> 3) & 127, ck = i & 7;
            *(LAS u32x4*)(lds + RO_S_OFF + (dir * 128 + r) * RO_SP + ck * 16) = *(const u32x4*)(S + ((size_t)(dir * 16 + bh) * NCHUNK + c) * 8192 + r * 64 + ck * 8); }
        __syncthreads();
        retO_item(p, bh, c, wid, lane, lds);
    }
}

__device__ __forceinline__ void phase_combine(const Params& p) {
    const int lane = otid() & 63, gw = blockIdx.x * 8 + (otid() >> 6), NW = gridDim.x * 8;
    const bf16_t* Y = (const bf16_t*)(p.ws + WS_B + B_Y); const int* toks = (const int*)(p.ws + WS_TOKS); const float* ada = (const float*)(p.ws + WS_ADA1);
    for (int r0 = gw * 4; r0 < T; r0 += NW * 4) { const int b = r0 >> 13; const float* gf = ada + b * 6144 + 5 * 1024;
        int s0[4], s1[4];
#pragma unroll
        for (int r = 0; r < 4; ++r) { s0[r] = toks[2 * (r0 + r)]; s1[r] = toks[2 * (r0 + r) + 1]; }
        f32x4 x[4][4]; u32x2 ya[4][4], yb[4][4];
#pragma unroll
        for (int r = 0; r < 4; ++r)
#pragma unroll
            for (int j = 0; j < 4; ++j) { const int c = 4 * lane + 256 * j; x[r][j] = *(const f32x4*)(p.out + (size_t)(r0 + r) * D + c);
                ya[r][j] = *(const u32x2*)(Y + (size_t)s0[r] * D + c); yb[r][j] = *(const u32x2*)(Y + (size_t)s1[r] * D + c); }
#pragma unroll
        for (int j = 0; j < 4; ++j) { const int c = 4 * lane + 256 * j; const f32x4 g = *(const f32x4*)(gf + c);
#pragma unroll
            for (int r = 0; r < 4; ++r) { const u32x2 a = ya[r][j], bb = yb[r][j];
                f32x4 y = (f32x4){bflo(a.x) + bflo(bb.x), bfhi(a.x) + bfhi(bb.x), bflo(a.y) + bflo(bb.y), bfhi(a.y) + bfhi(bb.y)};
                if (DBG_MASK & 16) y = (f32x4){0.f, 0.f, 0.f, 0.f};
                *(f32x4*)(p.out + (size_t)(r0 + r) * D + c) = x[r][j] + g * y; } } }
}

constexpr int NPHASE = 21;
#define XB_TMO      128
#define XB_XCNT(j)  (256  + 64 * (j))
#define XB_XSUB(j)  (1280 + 64 * (j))
#define XB_XGEN(j)  (2304 + 64 * (j))
#define XB_TOP      3328
#define XB_TOPGEN   3392
#define XCD_BAR_WORDS 3456
#define XB_SPIN_CAP (1u << 22)
__device__ __forceinline__ unsigned xb_ld(unsigned* p)              { return __hip_atomic_load(p, __ATOMIC_RELAXED, __HIP_MEMORY_SCOPE_AGENT); }
__device__ __forceinline__ unsigned xb_add(unsigned* p, unsigned v) { return __hip_atomic_fetch_add(p, v, __ATOMIC_RELAXED, __HIP_MEMORY_SCOPE_AGENT); }
__device__ __forceinline__ unsigned xb_xcc_id() { return (unsigned)__builtin_amdgcn_s_getreg((3 << 11) | 20) & 0xFu; }
#define XB_SPIN(cond, bar) do { unsigned _sp = 0; while (cond) { __builtin_amdgcn_s_sleep(1); \
    if ((++_sp & 255u) == 0u) { if (xb_ld(&(bar)[XB_TMO])) break; if (_sp > XB_SPIN_CAP) { atomicAdd(&(bar)[XB_TMO], 1u); break; } } } } while (0)
struct XcdBarrier { unsigned* bar; unsigned x; volatile LAS unsigned* st; };
__device__ __forceinline__ XcdBarrier xcd_barrier_post(unsigned* bar, volatile LAS unsigned* st) {
    XcdBarrier b; b.bar = bar; b.x = xb_xcc_id(); b.st = st;
    if (threadIdx.x == 0) (void)xb_add(&bar[XB_XCNT(b.x)], 1u);
    return b;
}
__device__ __forceinline__ void xcd_barrier_complete(unsigned* bar, unsigned x, unsigned& nloc, unsigned& nx) {
    const unsigned G = gridDim.x * gridDim.y * gridDim.z;
    unsigned sum, cnt, mine, sp = 0u;
    for (;;) {
        sum = 0u; cnt = 0u; mine = 0u;
#pragma unroll
        for (unsigned j = 0; j < 16; ++j) { const unsigned c = xb_ld(&bar[XB_XCNT(j)]); sum += c; cnt += (c > 0u) ? 1u : 0u; mine = (j == x) ? c : mine; }
        if (sum == G) break;
        __builtin_amdgcn_s_sleep(1);
        if ((++sp & 255u) == 0u) { if (xb_ld(&bar[XB_TMO])) break; if (sp > XB_SPIN_CAP) { atomicAdd(&bar[XB_TMO], 1u); break; } }
    }
    nloc = mine > 0u ? mine : 1u; nx = cnt > 0u ? cnt : 1u;
}
__device__ __forceinline__ void xcd_barrier(const XcdBarrier& b) {
    asm volatile("s_waitcnt vmcnt(0) lgkmcnt(0)" ::: "memory");
    __syncthreads();
    if (threadIdx.x == 0) {
        unsigned* bar = b.bar;
        __builtin_amdgcn_s_waitcnt(0);
        unsigned nloc = b.st[0], nx = b.st[1];
        if (nloc == 0u) { xcd_barrier_complete(bar, b.x, nloc, nx); b.st[0] = nloc; b.st[1] = nx; }
        const unsigned old = xb_add(&bar[XB_XSUB(b.x)], 1u);
        const unsigned gen = old / nloc;
        if (old + 1u == (gen + 1u) * nloc) {
            __builtin_amdgcn_fence(__ATOMIC_RELEASE, "agent");
            asm volatile("s_waitcnt vmcnt(0)" ::: "memory");
            const unsigned og = xb_add(&bar[XB_TOP], 1u);
            const unsigned tg = og / nx;
            if (og + 1u == (tg + 1u) * nx) xb_add(&bar[XB_TOPGEN], 1u);
            else XB_SPIN(xb_ld(&bar[XB_TOPGEN]) == tg, bar);
            __builtin_amdgcn_fence(__ATOMIC_ACQUIRE, "agent");
            xb_add(&bar[XB_XGEN(b.x)], 1u);
            asm volatile("s_waitcnt vmcnt(0)" ::: "memory");
        } else {
            XB_SPIN(xb_ld(&bar[XB_XGEN(b.x)]) == gen, bar);
            __builtin_amdgcn_fence(__ATOMIC_ACQUIRE, "agent");
            asm volatile("s_waitcnt vmcnt(0)" ::: "memory");
        }
    }
    __syncthreads();
}
__global__ void __launch_bounds__(512, 2) mega(Params p) {
    extern __shared__ __attribute__((aligned(16))) unsigned char shm[];
    LAS unsigned char* lds = (LAS unsigned char*)shm;
    const int G = gridDim.x, c = blockIdx.x;
    const float* ada0 = (const float*)(p.ws + WS_ADA0); const float* ada1 = (const float*)(p.ws + WS_ADA1);
    unsigned char* B = p.ws + WS_B;
    unsigned* bar = (unsigned*)(p.ws + WS_BAR);
    volatile LAS unsigned* xst = (volatile LAS unsigned*)(lds + LDS_GEMM + 256);
    if (threadIdx.x == 0) { xst[0] = 0u; xst[1] = 0u; }
    __syncthreads();
    XcdBarrier xb = xcd_barrier_post(bar, xst);
    constexpr size_t TS = (size_t)256 * D * 2;
#ifndef PHASE_MASK
#define PHASE_MASK 0x1FFFFF
#endif
#ifndef DUP_MASK
#define DUP_MASK 0
#endif
#define PH(k) for (int rep_ = 0; rep_ < 1 + ((DUP_MASK >> (k)) & 1); ++rep_) { if (((PHASE_MASK >> (k)) & 1) && p.ph_lo <= (k) && (k) < p.ph_hi)
#define SYNC(k) if (((k) + 1 < p.ph_hi || rep_ == 0 && ((DUP_MASK >> (k)) & 1)) && p.ph_lo <= (k)) { xcd_barrier(xb); } }
    if (p.ph_hi < 0) cg::this_grid().sync();
    PH(0) { phase0(p, lds); } SYNC(0)
#ifdef EXTRA_BAR
    for (int xi = 0; xi < EXTRA_BAR; ++xi) xcd_barrier(xb);
#endif
    PH(1) { phase_norm(p, p.in[0], p.in[4], ada0, 0, true); } SYNC(1)
    PH(2) { g8::InProjSched S{(const char*)(p.ws + WS_H), (const char*)(p.ws + WS_HX), (const char*)(p.ws + WS_WT_IN), G, c};
            g8::EpiStoreBf16 E{(bf16_t*)(B + B_PROJ), (bf16_t*)(B + B_PROJX), INW, KVW, 0, 1.0f, true};
            g8::gemm_phase<g8::EpiStoreBf16, g8::InProjSched, false>(lds, D * 2, D * 2, D * 2, S, E, nullptr, 0); } SYNC(2)
    PH(3) { phase3(p, lds); } SYNC(3)
    PH(4) { phase_retU(p); } SYNC(4)
    PH(5) { phase_scan(p); na_range(p, 0, 256, lds); } SYNC(5)
    PH(6) { phase_retO(p, lds); } SYNC(6)
    PH(7) { g8::DenseSched S{(const char*)(B + B_MIXIN), (const char*)(p.ws + WS_WT_OUT), 0, 0, TS, TS, 128, 4, 1, G, c};
            g8::EpiResid E{p.out, p.in[0], ada0 + 2 * 1024, false, 1.0f};
            g8::gemm_phase<g8::EpiResid, g8::DenseSched, false>(lds, D * 2, D * 2, D * 2, S, E, nullptr, 0); } SYNC(7)
    PH(8) { phase_norm(p, p.out, p.in[5], ada0, 3, false, USE_FP8_FFN != 0); } SYNC(8)
    PH(9) {
#if USE_FP8_FFN
            g8::DenseSched S{(const char*)(p.ws + WS_H), (const char*)(p.ws + WS_WT_GU), 0, 0, TS / 2, TS / 2, 128, 22, 1, G, c};
            g8::EpiSwiglu8 E{B + B_ACT, FFN, DESCALE8};
            g8::gemm_phase<g8::EpiSwiglu8, g8::DenseSched, false, true>(lds, D, D, D, S, E, nullptr, 0); } SYNC(9)
#else
            g8::DenseSched S{(const char*)(p.ws + WS_H), (const char*)(p.ws + WS_WT_GU), 0, 0, TS, TS, 128, 22, 1, G, c};
#if USE_FP8_FFN2
            g8::EpiSwiglu8 E{B + B_ACT, FFN, 1.0f};
            g8::gemm_phase<g8::EpiSwiglu8, g8::DenseSched, false>(lds, D * 2, D * 2, D * 2, S, E, nullptr, 0); } SYNC(9)
#else
            g8::EpiSwiglu E{(bf16_t*)(B + B_ACT), FFN};
            g8::gemm_phase<g8::EpiSwiglu, g8::DenseSched, false>(lds, D * 2, D * 2, D * 2, S, E, nullptr, 0); } SYNC(9)
#endif
#endif

    PH(10) {
#if USE_FP8_FFN || USE_FP8_FFN2
             g8::DenseSched S{(const char*)(B + B_ACT), (const char*)(p.ws + WS_WT_DOWN), 0, 0, (size_t)256 * FFN, (size_t)256 * FFN, 128, 4, 1, G, c};
             g8::EpiResid E{p.out, p.out, ada0 + 5 * 1024, (DBG_MASK & 4) != 0, DESCALE8};
             g8::gemm_phase<g8::EpiResid, g8::DenseSched, false, true>(lds, FFN, FFN, FFN, S, E, nullptr, 0); } SYNC(10)
#else
             g8::DenseSched S{(const char*)(B + B_ACT), (const char*)(p.ws + WS_WT_DOWN), 0, 0, (size_t)256 * FFN * 2, (size_t)256 * FFN * 2, 128, 4, 1, G, c};
             g8::EpiResid E{p.out, p.out, ada0 + 5 * 1024, (DBG_MASK & 4) != 0, 1.0f};
             g8::gemm_phase<g8::EpiResid, g8::DenseSched, false>(lds, FFN * 2, FFN * 2, FFN * 2, S, E, nullptr, 0); } SYNC(10)
#endif

    PH(11) { phase_norm(p, p.out, p.in[17], ada1, 0, false); } SYNC(11)
    PH(12) { g8::FourASched S{(const char*)(p.ws + WS_WC2), (const char*)(p.ws + WS_H), G, c};
             g8::EpiFA2 E{(bf16_t*)(B + B_ZT)};
             g8::gemm_phase<g8::EpiFA2, g8::FourASched, false>(lds, 256, 256, 64 * D * 2, S, E, nullptr, (size_t)D * 2); } SYNC(12)
    PH(13) { g8::DenseSched S{(const char*)(p.ws + WS_M1), (const char*)(B + B_ZT), 0, 0, 0, (size_t)256 * 256 * 2, 1, 1024, 1, G, c};
             g8::EpiFB1 E{(bf16_t*)(B + B_T2), (const float*)(p.ws + WS_TW)};
             g8::gemm_phase<g8::EpiFB1, g8::DenseSched, false>(lds, 512, 512, 512, S, E, nullptr, 0); } SYNC(13)
    PH(14) { g8::DenseSched S{(const char*)(p.ws + WS_M3), (const char*)(B + B_T2), 0, 0, 0, (size_t)256 * 512 * 2, 1, 512, 1, G, c};
             g8::EpiFB3 E{(bf16_t*)(B + B_FOUR), 1.0f / 1024.0f};
             g8::gemm_phase<g8::EpiFB3, g8::DenseSched, false>(lds, 1024, 1024, 1024, S, E, nullptr, 0); } SYNC(14)
    PH(15) { g8::DenseSched S{(const char*)(B + B_FOUR), (const char*)(p.ws + WS_WT_FOUR), 0, 0, TS, TS, 128, 4, 1, G, c};
             g8::EpiResid E{p.out, p.out, ada1 + 2 * 1024, (DBG_MASK & 8) != 0, 1.0f};
             g8::gemm_phase<g8::EpiResid, g8::DenseSched, false>(lds, D * 2, D * 2, D * 2, S, E, nullptr, 0); } SYNC(15)
    PH(16) { phase_norm_router(p, lds); } SYNC(16)
    PH(17) { phase_slots(p, lds); } SYNC(17)
    PH(18) { LAS int* tot = (LAS int*)(lds + LDS_GEMM); LAS int* bef = tot + 8; moe_totals(p, tot, bef, 0);
             int pe[8]; int s = 0;
#pragma unroll
             for (int e = 0; e < 8; ++e) { s += (tot[e] + 255) >> 8; pe[e] = s; }
#if USE_FP8
             g8::MoeSched S{(const char*)(B + B_H8S), (const char*)(p.ws + WS_WT_EGU), (size_t)2 * EDIM * D, D, D, pe[7], 28, G, c, pe[0], pe[1], pe[2], pe[3], pe[4], pe[5], pe[6], pe[7], false};
             g8::EpiSwiglu8 E{B + B_ACTE, EDIM, DESCALE8};
             g8::gemm_phase<g8::EpiSwiglu8, g8::MoeSched, false, true>(lds, D, D, D, S, E, nullptr, 0); } SYNC(18)
#else
             g8::MoeSched S{(const char*)(p.ws + WS_H), (const char*)(p.ws + WS_WT_EGU), (size_t)2 * EDIM * D * 2, D * 2, D * 2, pe[7], 28, G, c, pe[0], pe[1], pe[2], pe[3], pe[4], pe[5], pe[6], pe[7], true};
             g8::EpiSwiglu E{(bf16_t*)(B + B_ACTE), EDIM};
             g8::gemm_phase<g8::EpiSwiglu, g8::MoeSched, true>(lds, D * 2, D * 2, D * 2, S, E, (const int*)(p.ws + WS_SLTOK), 0); } SYNC(18)
#endif

    PH(19) { LAS int* tot = (LAS int*)(lds + LDS_GEMM); LAS int* bef = tot + 8; moe_totals(p, tot, bef, 0);
             int pe[8]; int s = 0;
#pragma unroll
             for (int e = 0; e < 8; ++e) { s += (tot[e] + 255) >> 8; pe[e] = s; }
#if USE_FP8
             g8::MoeSched S{(const char*)(B + B_ACTE), (const char*)(p.ws + WS_WT_EDOWN), (size_t)D * EDIM, EDIM, EDIM, pe[7], 4, G, c, pe[0], pe[1], pe[2], pe[3], pe[4], pe[5], pe[6], pe[7], false};
             g8::EpiMoeDown E{(bf16_t*)(B + B_Y), (const float*)(p.ws + WS_SLGATE)};
             g8::gemm_phase<g8::EpiMoeDown, g8::MoeSched, false, true>(lds, EDIM, EDIM, EDIM, S, E, nullptr, 0); } SYNC(19)
#else
             g8::MoeSched S{(const char*)(B + B_ACTE), (const char*)(p.ws + WS_WT_EDOWN), (size_t)D * EDIM * 2, EDIM * 2, EDIM * 2, pe[7], 4, G, c, pe[0], pe[1], pe[2], pe[3], pe[4], pe[5], pe[6], pe[7], false};
             g8::EpiMoeDown E{(bf16_t*)(B + B_Y), (const float*)(p.ws + WS_SLGATE)};
             g8::gemm_phase<g8::EpiMoeDown, g8::MoeSched, false>(lds, EDIM * 2, EDIM * 2, EDIM * 2, S, E, nullptr, 0); } SYNC(19)
#endif

    PH(20) { phase_combine(p); } }
#ifdef PROBE_PH
    if (p.ph_lo == 30) { const bf16_t* src = (const bf16_t*)(p.ws + (size_t)(PROBE_OFF));
        for (size_t i = (size_t)blockIdx.x * 512 + threadIdx.x; i < (size_t)T * D; i += (size_t)gridDim.x * 512) p.out[i] = i < (size_t)(PROBE_N) ? __uint_as_float(((unsigned)src[i]) << 16) : 0.f; }
#endif
#undef PH
#undef SYNC
}

extern "C" void kernel_launch(void* const* d_in, const int* in_sizes, int n_in, void* d_out, int out_size, void* d_ws, size_t ws_size, hipStream_t stream) {
    static int grid = 0;
    if (grid == 0) {
        if (n_in != 25 || out_size != T * D || ws_size < WS_END) { fprintf(stderr, "kernel_launch: unexpected shapes (n_in %d out %d ws %zu need %zu)\n", n_in, out_size, ws_size, (size_t)WS_END); grid = -1; return; }
        int dev = 0, cus = 0, per_cu = 0;
        hipGetDevice(&dev); hipDeviceGetAttribute(&cus, hipDeviceAttributeMultiprocessorCount, dev);
        if (hipFuncSetAttribute((const void*)mega, hipFuncAttributeMaxDynamicSharedMemorySize, LDS_TOTAL) != hipSuccess) { fprintf(stderr, "kernel_launch: hipFuncSetAttribute failed\n"); grid = -1; return; }
        if (hipOccupancyMaxActiveBlocksPerMultiprocessor(&per_cu, (const void*)mega, 512, LDS_TOTAL) != hipSuccess || per_cu < 1) { fprintf(stderr, "kernel_launch: occupancy query failed (%d)\n", per_cu); per_cu = 1; (void)hipGetLastError(); }
        grid = cus * per_cu; if (grid > 256) grid = 256;
    }
    if (grid < 0) return;
    Params p{};
    for (int i = 0; i < 25; ++i) p.in[i] = (const float*)d_in[i];
    p.out = (float*)d_out; p.ws = (unsigned char*)d_ws;
    (void)hipMemsetAsync((unsigned char*)d_ws + WS_BAR, 0, 16384, stream);
#if MK_SPLIT
#ifdef PROBE_PH
    for (int ph = 0; ph < PROBE_PH; ++ph) { p.ph_lo = ph; p.ph_hi = ph + 1; hipLaunchKernelGGL(mega, dim3(grid), dim3(512), LDS_TOTAL, stream, p); }
    p.ph_lo = 30; p.ph_hi = 31; hipLaunchKernelGGL(mega, dim3(grid), dim3(512), LDS_TOTAL, stream, p);
    return;
#endif
    for (int ph = 0; ph < NPHASE; ++ph) { p.ph_lo = ph; p.ph_hi = ph + 1; hipLaunchKernelGGL(mega, dim3(grid), dim3(512), LDS_TOTAL, stream, p); }
#else
    p.ph_lo = 0; p.ph_hi = NPHASE;
    void* args[] = {&p};
    hipError_t e = hipLaunchCooperativeKernel((const void*)mega, dim3(grid), dim3(512), args, LDS_TOTAL, stream);
    if (e != hipSuccess) fprintf(stderr, "cooperative launch failed: %s (grid %d)\n", hipGetErrorString(e), grid);
#endif
}
```

```cpp
#include <hip/hip_runtime.h>
#include <hip/hip_cooperative_groups.h>
#include <cstdio>
#include <cstdint>
namespace cg = cooperative_groups;

#ifndef MK_SPLIT
#define MK_SPLIT 0
#endif
#ifndef DBG_MASK
#define DBG_MASK 0
#endif

#define FP8_DIAG 0
#define USE_FP8 1
#define USE_FP8_FFN2 1
#define USE_FP8_FFN 0
#define LAS __attribute__((address_space(3)))
typedef unsigned short bf16_t;
typedef short bf16x8 __attribute__((ext_vector_type(8)));
typedef float f32x4 __attribute__((ext_vector_type(4)));
typedef float f32x2 __attribute__((ext_vector_type(2)));
typedef unsigned u32x4 __attribute__((ext_vector_type(4)));
typedef unsigned u32x2 __attribute__((ext_vector_type(2)));

constexpr int D = 1024, NBATCH = 4, SEQ = 8192, T = NBATCH * SEQ, CTXL = 256, TX = NBATCH * CTXL;
constexpr int INW = 3072, KVW = 1792;
constexpr int C_NAQ = 0, C_RQ = 512, C_RG = 768, C_NAK = 1280, C_NAV = 1792, C_RK = 2304, C_RV = 2560;
constexpr int X_NAK = 0, X_NAV = 512, X_RK = 1024, X_RV = 1280;
constexpr int FFN = 2816, NE = 8, EDIM = 3584;
constexpr int MOE_TILES = 264, NSLOTS = MOE_TILES * 256;
constexpr int NCHUNK = 64, NCC = 66;
constexpr float EPS = 1e-6f;

constexpr size_t AL(size_t x) { return (x + 255) & ~(size_t)255; }
constexpr size_t WS_WT_IN = 0;
constexpr size_t WS_WT_OUT = WS_WT_IN + (size_t)INW * D * 2;
constexpr size_t WS_WT_GU = WS_WT_OUT + (size_t)D * D * 2;
constexpr size_t WS_WT_DOWN = WS_WT_GU + (size_t)2 * FFN * D * 2;
constexpr size_t WS_WT_FOUR = WS_WT_DOWN + (size_t)D * FFN * 2;
constexpr size_t WS_WT_EGU = WS_WT_FOUR + (size_t)D * D * 2;
constexpr size_t WS_WT_EDOWN = WS_WT_EGU + (size_t)NE * 2 * EDIM * D * 2;
constexpr size_t WS_WC = WS_WT_EDOWN + (size_t)NE * D * EDIM * 2;
constexpr size_t WS_WC2 = WS_WC + (size_t)2048 * 1024 * 2;
constexpr size_t WS_M1 = WS_WC2 + (size_t)256 * 128 * 2;
constexpr size_t WS_M3 = WS_M1 + (size_t)256 * 256 * 2;
constexpr size_t WS_TW = WS_M3 + (size_t)256 * 512 * 2;
constexpr size_t WS_BAR = WS_TW + (size_t)128 * 64 * 8;
constexpr size_t WS_ADA0 = WS_BAR + 16384;
constexpr size_t WS_ADA1 = WS_ADA0 + AL(5 * 6144 * 4);
constexpr size_t WS_HIST = WS_ADA1 + AL(4 * 6144 * 4);
constexpr size_t WS_TOKE = WS_HIST + AL(256 * 8 * 4);
constexpr size_t WS_TOKG = WS_TOKE + AL((size_t)T * 4);
constexpr size_t WS_TOKS = WS_TOKG + AL((size_t)T * 8);
constexpr size_t WS_SLTOK = WS_TOKS + AL((size_t)T * 8);
constexpr size_t WS_SLGATE = WS_SLTOK + AL((size_t)NSLOTS * 4);
constexpr size_t WS_H = WS_SLGATE + AL((size_t)NSLOTS * 4);
constexpr size_t WS_HX = WS_H + (size_t)T * D * 2;
constexpr size_t WS_B = WS_HX + (size_t)TX * D * 2;
constexpr size_t B_PROJ = 0;
constexpr size_t B_ACT = 0;
constexpr size_t B_PROJX = B_PROJ + (size_t)T * INW * 2;
constexpr size_t B_MIXIN = B_PROJX + (size_t)TX * KVW * 2;
constexpr size_t B_U = B_MIXIN + (size_t)T * D * 2;
constexpr size_t B_S = B_U + (size_t)2 * 16 * NCC * 8192 * 4;
constexpr size_t B_NAVT = B_S + (size_t)2 * 16 * NCHUNK * 8192 * 2;
constexpr size_t B_RETVT = B_NAVT + (size_t)NBATCH * 512 * SEQ * 2;
constexpr size_t B_RETKT = B_RETVT + (size_t)NBATCH * 512 * SEQ * 2;
constexpr size_t B_RKR = B_RETKT + (size_t)NBATCH * 256 * SEQ * 2;
constexpr size_t B_NAVXT = B_RKR + (size_t)T * 256 * 2;
constexpr size_t B_RETVXT = B_NAVXT + (size_t)NBATCH * 512 * CTXL * 2;
constexpr size_t B_RETKXT = B_RETVXT + (size_t)NBATCH * 512 * CTXL * 2;
constexpr size_t B_L0_END = B_RETKXT + (size_t)NBATCH * 256 * CTXL * 2;
constexpr size_t B_ZT = 0;
constexpr size_t B_T2 = B_ZT + (size_t)NBATCH * 2048 * SEQ * 2;
constexpr size_t B_FOUR = B_T2 + (size_t)NBATCH * 2048 * SEQ * 2;
constexpr size_t B_F_END = B_FOUR + (size_t)T * D * 2;
constexpr size_t B_ACTE = 0;
constexpr size_t B_H8S = (size_t)256 << 20;
constexpr size_t B_Y = B_ACTE + (size_t)NSLOTS * EDIM * 2;
constexpr size_t B_M_END = B_Y + (size_t)NSLOTS * D * 2;
constexpr size_t BMAX1 = B_L0_END > B_F_END ? B_L0_END : B_F_END;
constexpr size_t WS_END = WS_B + (BMAX1 > B_M_END ? BMAX1 : B_M_END);

constexpr int LDS_GEMM = 131072, LDS_TOTAL = LDS_GEMM + 512;

struct Params {
    const float* in[25];
    float* out;
    unsigned char* ws;
    int ph_lo, ph_hi;
};

typedef __bf16 bf16x2_t __attribute__((ext_vector_type(2)));
__device__ __forceinline__ unsigned pk2(float lo, float hi) { const f32x2 v = {lo, hi}; const bf16x2_t r = __builtin_convertvector(v, bf16x2_t); return __builtin_bit_cast(unsigned, r); }
__device__ __forceinline__ float bflo(unsigned w) { return __uint_as_float(w << 16); }
__device__ __forceinline__ float bfhi(unsigned w) { return __uint_as_float(w & 0xffff0000u); }
__device__ __forceinline__ bf16_t f2bf(float f) { return (bf16_t)(pk2(f, 0.f) & 0xffffu); }
__device__ __forceinline__ float wave_sum(float v) {
#pragma unroll
    for (int o = 1; o < 64; o <<= 1) v += __shfl_xor(v, o);
    return v;
}
__device__ __forceinline__ float silu_f(float g) { return g * __builtin_amdgcn_rcpf(1.0f + __expf(-g)); }
__device__ __forceinline__ f32x4 mfma16(u32x4 a, u32x4 b, f32x4 c) {
    return __builtin_amdgcn_mfma_f32_16x16x32_bf16(__builtin_bit_cast(bf16x8, a), __builtin_bit_cast(bf16x8, b), c, 0, 0, 0);
}
__device__ __forceinline__ void lds_add(LAS int* p, int v) { __hip_atomic_fetch_add((int*)p, v, __ATOMIC_RELAXED, __HIP_MEMORY_SCOPE_WORKGROUP); }
__device__ __forceinline__ void unpack8(const u32x4 w, float (&x)[8]) {
    x[0] = bflo(w.x); x[1] = bfhi(w.x); x[2] = bflo(w.y); x[3] = bfhi(w.y); x[4] = bflo(w.z); x[5] = bfhi(w.z); x[6] = bflo(w.w); x[7] = bfhi(w.w);
}
__device__ __forceinline__ u32x4 pack8(const float (&x)[8]) { return (u32x4){pk2(x[0], x[1]), pk2(x[2], x[3]), pk2(x[4], x[5]), pk2(x[6], x[7])}; }
__device__ __forceinline__ int otid() { int t = threadIdx.x; asm volatile("" : "+v"(t)); return t; }
typedef int i32x8 __attribute__((ext_vector_type(8)));
typedef int u32x4i __attribute__((ext_vector_type(4)));
__device__ __forceinline__ float clamp448(float x) { return __builtin_amdgcn_fmed3f(x, -448.0f, 448.0f); }
__device__ __forceinline__ unsigned pk4_fp8(float a, float b, float c, float d) {
    int w = 0; w = __builtin_amdgcn_cvt_pk_fp8_f32(clamp448(a), clamp448(b), w, false); w = __builtin_amdgcn_cvt_pk_fp8_f32(clamp448(c), clamp448(d), w, true); return (unsigned)w; }
constexpr float S_W8 = 64.0f, S_A8 = 4.0f, DESCALE8 = 1.0f / (S_W8 * S_A8);
#define LDS_WAIT() asm volatile("s_waitcnt lgkmcnt(0)" ::: "memory")

namespace g8 {
constexpr int BM = 256, BK = 64, HALF = 128, HTB = HALF * BK * 2, NXCD = 8, WGM = 8;
__device__ __forceinline__ int lds_byte(int r, int c) { const int st = (r >> 4) * 2 + (c >> 5), rr = r & 15, cc = c & 31, ob = rr * 64 + cc * 2; return st * 1024 + (ob ^ (((ob >> 9) & 1) << 5)); }
__device__ __forceinline__ void stage_rc(int b, int& R, int& C) { const int st = b / 1024, sb = b % 1024, swz = sb ^ (((sb >> 9) & 1) << 5); R = (st >> 1) * 16 + swz / 64; C = (st & 1) * 32 + (swz % 64) / 2; }
__device__ __forceinline__ int perm32(int rho) { const int n = rho >> 4, i = rho & 15; return 8 * (i >> 2) + 4 * n + (i & 3); }

struct Unit { const char* A; const char* B; int pm, pn, z; };

__device__ __forceinline__ void remap(int w, int nM, int nN, int& pm, int& pn) {
    const int nwg = nM * nN; int wgid = w;
    { const int q = nwg / NXCD, r = nwg % NXCD, xcd = wgid % NXCD, off = wgid / NXCD; wgid = (xcd < r ? xcd * (q + 1) : r * (q + 1) + (xcd - r) * q) + off; }
    const int nig = WGM * nN, gid = wgid / nig, fm = gid * WGM, gsz = (nM - fm) < WGM ? (nM - fm) : WGM;
    pm = fm + ((wgid % nig) % gsz); pn = (wgid % nig) / gsz;
}

struct DenseSched {
    const char* A; const char* B; size_t azs, bzs, aps, bps; int nM, nN, nz, G, c;
    __device__ __forceinline__ bool next(int i, Unit& u) const {
        const long L = (long)i * G + c; const int per = nM * nN; if (L >= (long)per * nz) return false;
        const int z = (int)(L / per), w = (int)(L % per); int pm, pn; remap(w, nM, nN, pm, pn);
        u.pm = pm; u.pn = pn; u.z = z; u.A = A + z * azs + (size_t)pm * aps; u.B = B + z * bzs + (size_t)pn * bps; return true;
    }
};
struct InProjSched {
    const char* H; const char* HX; const char* W; int G, c;
    __device__ __forceinline__ bool next(int i, Unit& u) const {
        const long L = (long)i * G + c; const int n0 = 128 * 12;
        if (L < n0) { int pm, pn; remap((int)L, 128, 12, pm, pn); u.pm = pm; u.pn = pn; u.z = 0; u.A = H + (size_t)pm * 256 * D * 2; u.B = W + (size_t)pn * 256 * D * 2; return true; }
        const int w = (int)(L - n0); if (w >= 28) return false;
        u.pm = w / 7; u.pn = w % 7; u.z = 1; u.A = HX + (size_t)u.pm * 256 * D * 2; u.B = W + (size_t)(1280 + u.pn * 256) * D * 2; return true;
    }
};
struct FourASched {
    const char* A; const char* H; int G, c;
    __device__ __forceinline__ bool next(int i, Unit& u) const {
        const long L = (long)i * G + c; if (L >= 1024) return false;
        const int pn = (int)(L & 31), g = (int)((L >> 5) & 7), b = (int)(L >> 8);
        u.pm = 0; u.pn = pn; u.z = b * 8 + g; u.A = A; u.B = H + (size_t)b * SEQ * D * 2 + (size_t)pn * 2 * D * 2 + g * 256; return true;
    }
};
struct MoeSched {
    const char* A; const char* W; size_t wes; int lda, ldb, nM, nN, G, c; int pe0, pe1, pe2, pe3, pe4, pe5, pe6, pe7; bool gather;
    __device__ __forceinline__ bool next(int i, Unit& u) const {
        const long L = (long)i * G + c; if (L >= (long)nM * nN) return false;
        int pm, pn; remap((int)L, nM, nN, pm, pn);
        const int e = (pm >= pe0) + (pm >= pe1) + (pm >= pe2) + (pm >= pe3) + (pm >= pe4) + (pm >= pe5) + (pm >= pe6);
        u.pm = pm; u.pn = pn; u.z = e; u.A = gather ? A : A + (size_t)pm * 256 * lda; u.B = W + e * wes + (size_t)pn * 256 * ldb; return true;
    }
};

template <class Epi, class Sched, bool GATHER, bool FP8 = false>
__device__ __forceinline__ void gemm_phase(LAS unsigned char* lds, const int K_, const int lda, const int ldb, const Sched& S, const Epi& E, const int* __restrict__ rowidx, const size_t hstepB_) {
    int tid = threadIdx.x; asm volatile("" : "+v"(tid));
    const int wid = __builtin_amdgcn_readfirstlane(tid >> 6), lane = tid & 63, wr = wid >> 2, wc = wid & 3, fr = lane & 15, fq = lane >> 4;
    int K = K_; asm volatile("" : "+s"(K));
    const int nt = K / (BK * 2);
    int Rr[2], Cc[2]; unsigned voffB[2];
#pragma unroll
    for (int i = 0; i < 2; ++i) { int R, C; stage_rc(tid * 16 + i * 8192, R, C); const int Rb = Epi::PERM ? ((R & ~31) + perm32(R & 31)) : R;
        Rr[i] = R; Cc[i] = C; voffB[i] = (unsigned)(Rb * ldb + C * 2); }
    const size_t kstep = (size_t)(BK * 2);
    const size_t hstepB = hstepB_ ? hstepB_ : (size_t)HALF * ldb;
    const unsigned ldsw = (unsigned)wid * 1024u;
    const int aoff = lds_byte(wr * 64 + fr, fq * 8), boff = lds_byte(wc * 32 + fr, fq * 8);
#define G8_SA(b, h) (((b) * 2 + (h)) * HTB)
#define G8_SB(b, h) ((4 + (b) * 2 + (h)) * HTB)
#define G8_STAGE(bufoff, gbase, voff) do { _Pragma("unroll") for (int _i = 0; _i < 2; ++_i) \
        __builtin_amdgcn_global_load_lds((const unsigned*)((const char*)(gbase) + (voff)[_i]), (LAS unsigned*)(lds + (bufoff) + ldsw + _i * 8192), 16, 0, 0); } while (0)
#define G8_LDA(dst, b, h) do { _Pragma("unroll") for (int m = 0; m < 4; ++m) { const u32x4i l_ = *(const LAS u32x4i*)(lds + G8_SA(b, h) + aoff + m * 2048), h_ = *(const LAS u32x4i*)(lds + G8_SA(b, h) + aoff + m * 2048 + 1024); \
        dst[m] = __builtin_shufflevector(l_, h_, 0, 1, 2, 3, 4, 5, 6, 7); } } while (0)
#define G8_LDB(dst, b, h) do { _Pragma("unroll") for (int n = 0; n < 2; ++n) { const u32x4i l_ = *(const LAS u32x4i*)(lds + G8_SB(b, h) + boff + n * 2048), h_ = *(const LAS u32x4i*)(lds + G8_SB(b, h) + boff + n * 2048 + 1024); \
        dst[n] = __builtin_shufflevector(l_, h_, 0, 1, 2, 3, 4, 5, 6, 7); } } while (0)
#define G8_LO(v) __builtin_bit_cast(bf16x8, __builtin_shufflevector(v, v, 0, 1, 2, 3))
#define G8_HI(v) __builtin_bit_cast(bf16x8, __builtin_shufflevector(v, v, 4, 5, 6, 7))
#define G8_MMA(ai, bj, At, Bt) do { __builtin_amdgcn_s_setprio(1); _Pragma("unroll") for (int m = 0; m < 4; ++m) _Pragma("unroll") for (int n = 0; n < 2; ++n) { \
        if constexpr (FP8) { if (FP8_DIAG) { typedef long l4 __attribute__((ext_vector_type(4))); const l4 bb = __builtin_bit_cast(l4, Bt[n]), aa = __builtin_bit_cast(l4, At[m]); \
            _Pragma("unroll") for (int q = 0; q < 4; ++q) acc[ai][bj][m][n] = __builtin_amdgcn_mfma_f32_16x16x32_fp8_fp8(bb[q], aa[q], acc[ai][bj][m][n], 0, 0, 0); } \
          else asm volatile("v_mfma_f32_16x16x128_f8f6f4 %0, %1, %2, %0" : "+v"(acc[ai][bj][m][n]) : "v"(Bt[n]), "v"(At[m])); } \
        else { acc[ai][bj][m][n] = __builtin_amdgcn_mfma_f32_16x16x32_bf16(G8_LO(Bt[n]), G8_LO(At[m]), acc[ai][bj][m][n], 0, 0, 0); \
               acc[ai][bj][m][n] = __builtin_amdgcn_mfma_f32_16x16x32_bf16(G8_HI(Bt[n]), G8_HI(At[m]), acc[ai][bj][m][n], 0, 0, 0); } } \
        __builtin_amdgcn_s_setprio(0); } while (0)
#define G8_WAIT_V(n) asm volatile("s_waitcnt vmcnt(" #n ")" ::: "memory")
#define G8_WAIT_L(n) asm volatile("s_waitcnt lgkmcnt(" #n ")" ::: "memory")
#define G8_BAR __builtin_amdgcn_s_barrier()
#define G8_SCHED __builtin_amdgcn_sched_barrier(0)
    Unit cur, nxt; int ui = 0;
    if (!S.next(0, cur)) return;
    unsigned ca[2][2], na[2][2];
#pragma unroll
    for (int h = 0; h < 2; ++h)
#pragma unroll
        for (int i = 0; i < 2; ++i) {
            if constexpr (GATHER) ca[h][i] = (unsigned)rowidx[cur.pm * 256 + h * 128 + Rr[i]] * (unsigned)lda + (unsigned)(Cc[i] * 2);
            else ca[h][i] = (unsigned)((h * 128 + Rr[i]) * lda + Cc[i] * 2);
            na[h][i] = ca[h][i];
        }
    f32x4 acc[2][2][4][2];
#pragma unroll
    for (int a = 0; a < 2; ++a)
#pragma unroll
        for (int b = 0; b < 2; ++b)
#pragma unroll
            for (int m = 0; m < 4; ++m)
#pragma unroll
                for (int n = 0; n < 2; ++n) acc[a][b][m][n] = (f32x4){0.f, 0.f, 0.f, 0.f};
    i32x8 At[4], B0[2], B1[2];
    const char* cA = cur.A; const char* cB = cur.B;
    G8_STAGE(G8_SB(0, 0), cB, voffB); G8_STAGE(G8_SB(0, 1), cB + hstepB, voffB); G8_STAGE(G8_SA(0, 0), cA, ca[0]); G8_STAGE(G8_SA(0, 1), cA, ca[1]);
    if (wr == 1) G8_BAR;
    G8_WAIT_V(2); G8_BAR;
    G8_STAGE(G8_SB(1, 0), cB + kstep, voffB); G8_STAGE(G8_SA(1, 0), cA + kstep, ca[0]); G8_STAGE(G8_SB(1, 1), cB + hstepB + kstep, voffB);
    G8_WAIT_V(6); G8_BAR;
    for (;;) {
        const bool has_next = S.next(ui + 1, nxt);
        const char* nA = has_next ? nxt.A : cA; const char* nB = has_next ? nxt.B : cB;
        if constexpr (GATHER) {
            if (has_next) {
#pragma unroll
                for (int h = 0; h < 2; ++h)
#pragma unroll
                    for (int i = 0; i < 2; ++i) na[h][i] = (unsigned)rowidx[nxt.pm * 256 + h * 128 + Rr[i]] * (unsigned)lda + (unsigned)(Cc[i] * 2);
            }
        }
        for (int t = 0; t < nt; t += 2) {
            const bool last = (t == nt - 2);
            const char* a1 = cA + (size_t)(t + 1) * kstep;
            const char* a2 = last ? nA : cA + (size_t)(t + 2) * kstep; const char* b2 = last ? nB : cB + (size_t)(t + 2) * kstep;
            const char* a3 = a2 + kstep; const char* b3 = b2 + kstep;
            unsigned o2[2][2];
#pragma unroll
            for (int h = 0; h < 2; ++h)
#pragma unroll
                for (int i = 0; i < 2; ++i) { if constexpr (GATHER) o2[h][i] = last ? na[h][i] : ca[h][i]; else o2[h][i] = ca[h][i]; }
            G8_LDB(B0, 0, 0); G8_LDB(B1, 0, 1); G8_SCHED; G8_LDA(At, 0, 0); G8_STAGE(G8_SA(1, 1), a1, ca[1]);
            G8_WAIT_V(8); G8_WAIT_L(0); G8_BAR; G8_MMA(0, 0, At, B0); G8_MMA(0, 1, At, B1); G8_BAR; G8_SCHED;
            G8_LDA(At, 0, 1); G8_STAGE(G8_SB(0, 0), b2, voffB); G8_STAGE(G8_SB(0, 1), b2 + hstepB, voffB); G8_STAGE(G8_SA(0, 0), a2, o2[0]);
            G8_WAIT_V(8); G8_WAIT_L(0); G8_BAR; G8_MMA(1, 0, At, B0); G8_MMA(1, 1, At, B1); G8_BAR; G8_SCHED;
            G8_LDB(B0, 1, 0); G8_LDB(B1, 1, 1); G8_SCHED; G8_LDA(At, 1, 0); G8_STAGE(G8_SA(0, 1), a2, o2[1]);
            G8_WAIT_V(8); G8_WAIT_L(0); G8_BAR; G8_MMA(0, 0, At, B0); G8_MMA(0, 1, At, B1); G8_BAR; G8_SCHED;
            G8_LDA(At, 1, 1); G8_STAGE(G8_SB(1, 0), b3, voffB); G8_STAGE(G8_SB(1, 1), b3 + hstepB, voffB); G8_STAGE(G8_SA(1, 0), a3, o2[0]);
            G8_WAIT_V(8); G8_WAIT_L(0); G8_BAR; G8_MMA(1, 0, At, B0); G8_MMA(1, 1, At, B1); G8_BAR; G8_SCHED;
        }
        if (wr == 0) G8_BAR;
        E(acc, cur, wr, wc, fr, fq);
        if (!has_next) break;
#pragma unroll
        for (int a = 0; a < 2; ++a)
#pragma unroll
            for (int b = 0; b < 2; ++b)
#pragma unroll
                for (int m = 0; m < 4; ++m)
#pragma unroll
                    for (int n = 0; n < 2; ++n) acc[a][b][m][n] = (f32x4){0.f, 0.f, 0.f, 0.f};
        cur = nxt; cA = nA; cB = nB; ++ui;
        if (wr == 1) G8_BAR;
        if constexpr (GATHER) {
#pragma unroll
            for (int h = 0; h < 2; ++h)
#pragma unroll
                for (int i = 0; i < 2; ++i) ca[h][i] = na[h][i];
        }
    }
    G8_WAIT_V(0);
    G8_BAR;
#undef G8_SA
#undef G8_SB
#undef G8_STAGE
#undef G8_LDA
#undef G8_LDB
#undef G8_LO
#undef G8_HI
#undef G8_MMA
#undef G8_WAIT_V
#undef G8_WAIT_L
#undef G8_BAR
#undef G8_SCHED
}

struct EpiStoreBf16 {
    static constexpr bool PERM = true;
    bf16_t* O0; bf16_t* O1; int ldc0, ldc1; size_t zs; float scale; bool inproj;
    __device__ __forceinline__ void operator()(const f32x4 (&acc)[2][2][4][2], const Unit& u, int wr, int wc, int fr, int fq) const {
        bf16_t* base; int ldc;
        if (inproj) { base = u.z ? O1 : O0; ldc = u.z ? ldc1 : ldc0; } else { base = O0 + u.z * zs; ldc = ldc0; }
        const int row0 = u.pm * BM + wr * 64 + fr, col0 = u.pn * BM + wc * 32 + 8 * fq;
#pragma unroll
        for (int ai = 0; ai < 2; ++ai)
#pragma unroll
            for (int m = 0; m < 4; ++m) { bf16_t* rowp = base + (size_t)(row0 + ai * HALF + m * 16) * ldc + col0;
#pragma unroll
                for (int bj = 0; bj < 2; ++bj) { const f32x4 v0 = acc[ai][bj][m][0] * scale, v1 = acc[ai][bj][m][1] * scale;
                    u32x4 w; w.x = pk2(v0[0], v0[1]); w.y = pk2(v0[2], v0[3]); w.z = pk2(v1[0], v1[1]); w.w = pk2(v1[2], v1[3]);
                    *(u32x4*)(rowp + bj * HALF) = w; } }
    }
};
struct EpiResid {
    static constexpr bool PERM = false;
    float* out; const float* resid; const float* gate; bool zero; float ascale;
    __device__ __forceinline__ void operator()(const f32x4 (&acc)[2][2][4][2], const Unit& u, int wr, int wc, int fr, int fq) const {
        const int row0 = u.pm * BM + wr * 64 + fr, col0 = u.pn * BM + wc * 32 + 4 * fq;
        const float* gp = gate + (size_t)(row0 >> 13) * 6144 + col0;
        f32x4 gv[2][2];
#pragma unroll
        for (int bj = 0; bj < 2; ++bj)
#pragma unroll
            for (int n = 0; n < 2; ++n) { gv[bj][n] = *(const f32x4*)(gp + bj * HALF + n * 16) * ascale; if (zero) gv[bj][n] = (f32x4){0.f, 0.f, 0.f, 0.f}; }
#pragma unroll
        for (int ai = 0; ai < 2; ++ai)
#pragma unroll
            for (int m = 0; m < 4; ++m) { const size_t ro = (size_t)(row0 + ai * HALF + m * 16) * D + col0;
#pragma unroll
                for (int bj = 0; bj < 2; ++bj)
#pragma unroll
                    for (int n = 0; n < 2; ++n) { const f32x4 r = *(const f32x4*)(resid + ro + bj * HALF + n * 16);
                        *(f32x4*)(out + ro + bj * HALF + n * 16) = r + gv[bj][n] * acc[ai][bj][m][n]; } }
    }
};
struct EpiSwiglu {
    static constexpr bool PERM = true;
    bf16_t* O; int ldc;
    __device__ __forceinline__ void operator()(const f32x4 (&acc)[2][2][4][2], const Unit& u, int wr, int wc, int fr, int fq) const {
        const int row0 = u.pm * BM + wr * 64 + fr, col0 = u.pn * HALF + wc * 32 + 8 * fq;
#pragma unroll
        for (int ai = 0; ai < 2; ++ai)
#pragma unroll
            for (int m = 0; m < 4; ++m) { bf16_t* rowp = O + (size_t)(row0 + ai * HALF + m * 16) * ldc + col0;
                float v[8];
#pragma unroll
                for (int n = 0; n < 2; ++n)
#pragma unroll
                    for (int j = 0; j < 4; ++j) v[n * 4 + j] = silu_f(acc[ai][0][m][n][j]) * acc[ai][1][m][n][j];
                u32x4 w; w.x = pk2(v[0], v[1]); w.y = pk2(v[2], v[3]); w.z = pk2(v[4], v[5]); w.w = pk2(v[6], v[7]);
                *(u32x4*)rowp = w; }
    }
};
struct EpiSwiglu8 {
    static constexpr bool PERM = true;
    unsigned char* O; int ldc; float dsc;
    __device__ __forceinline__ void operator()(const f32x4 (&acc)[2][2][4][2], const Unit& u, int wr, int wc, int fr, int fq) const {
        const int row0 = u.pm * BM + wr * 64 + fr, col0 = u.pn * HALF + wc * 32 + 8 * fq;
#pragma unroll
        for (int ai = 0; ai < 2; ++ai)
#pragma unroll
            for (int m = 0; m < 4; ++m) { unsigned char* rowp = O + (size_t)(row0 + ai * HALF + m * 16) * ldc + col0;
                float v[8];
#pragma unroll
                for (int n = 0; n < 2; ++n)
#pragma unroll
                    for (int j = 0; j < 4; ++j) v[n * 4 + j] = silu_f(acc[ai][0][m][n][j] * dsc) * (acc[ai][1][m][n][j] * (dsc * S_A8));
                *(u32x2*)rowp = (u32x2){pk4_fp8(v[0], v[1], v[2], v[3]), pk4_fp8(v[4], v[5], v[6], v[7])}; }
    }
};
struct EpiMoeDown {
    static constexpr bool PERM = true;
    bf16_t* Y; const float* sg;
    __device__ __forceinline__ void operator()(const f32x4 (&acc)[2][2][4][2], const Unit& u, int wr, int wc, int fr, int fq) const {
        const int row0 = u.pm * BM + wr * 64 + fr, col0 = u.pn * BM + wc * 32 + 8 * fq;
#pragma unroll
        for (int ai = 0; ai < 2; ++ai)
#pragma unroll
            for (int m = 0; m < 4; ++m) { const int row = row0 + ai * HALF + m * 16; const float g = sg[row] * (USE_FP8 ? DESCALE8 : 1.0f); bf16_t* rowp = Y + (size_t)row * D + col0;
#pragma unroll
                for (int bj = 0; bj < 2; ++bj) { const f32x4 v0 = acc[ai][bj][m][0] * g, v1 = acc[ai][bj][m][1] * g;
                    u32x4 w; w.x = pk2(v0[0], v0[1]); w.y = pk2(v0[2], v0[3]); w.z = pk2(v1[0], v1[1]); w.w = pk2(v1[2], v1[3]);
                    *(u32x4*)(rowp + bj * HALF) = w; } }
    }
};
struct EpiFA {
    static constexpr bool PERM = true;
    bf16_t* O;
    __device__ __forceinline__ void operator()(const f32x4 (&acc)[2][2][4][2], const Unit& u, int wr, int wc, int fr, int fq) const {
        const int row0 = u.pm * BM + wr * 64 + fr, n1 = wc * 32 + 8 * fq;
#pragma unroll
        for (int ai = 0; ai < 2; ++ai)
#pragma unroll
            for (int m = 0; m < 4; ++m) { const int r = row0 + ai * HALF + m * 16, ch = r >> 1, part = r & 1;
#pragma unroll
                for (int bj = 0; bj < 2; ++bj) { const int n2 = 2 * u.pn + bj; const f32x4 v0 = acc[ai][bj][m][0], v1 = acc[ai][bj][m][1];
                    u32x4 w; w.x = pk2(v0[0], v0[1]); w.y = pk2(v0[2], v0[3]); w.z = pk2(v1[0], v1[1]); w.w = pk2(v1[2], v1[3]);
                    *(u32x4*)(O + ((size_t)(u.z * 1024 + ch) * 64 + n2) * 256 + part * 128 + n1) = w; } }
    }
};
struct EpiFA2 {
    static constexpr bool PERM = true;
    bf16_t* O;
    __device__ __forceinline__ void operator()(const f32x4 (&acc)[2][2][4][2], const Unit& u, int wr, int wc, int fr, int fq) const {
        const int row0 = wr * 64 + fr, n1 = wc * 32 + 8 * fq, b = u.z >> 3, g = u.z & 7;
#pragma unroll
        for (int ai = 0; ai < 2; ++ai)
#pragma unroll
            for (int m = 0; m < 4; ++m) { const int r = row0 + ai * HALF + m * 16, ch = g * 128 + (r >> 1), part = r & 1;
#pragma unroll
                for (int bj = 0; bj < 2; ++bj) { const int n2 = 2 * u.pn + bj; const f32x4 v0 = acc[ai][bj][m][0], v1 = acc[ai][bj][m][1];
                    u32x4 w; w.x = pk2(v0[0], v0[1]); w.y = pk2(v0[2], v0[3]); w.z = pk2(v1[0], v1[1]); w.w = pk2(v1[2], v1[3]);
                    *(u32x4*)(O + ((size_t)(b * 1024 + ch) * 64 + n2) * 256 + part * 128 + n1) = w; } }
    }
};
struct EpiFB1 {
    static constexpr bool PERM = true;
    bf16_t* O; const float* tw;
    __device__ __forceinline__ void operator()(const f32x4 (&acc)[2][2][4][2], const Unit& u, int wr, int wc, int fr, int fq) const {
        const int n20 = (wc & 1) * 32 + 8 * fq;
#pragma unroll
        for (int m = 0; m < 4; ++m) { const int k1 = wr * 64 + m * 16 + fr;
#pragma unroll
            for (int n = 0; n < 2; ++n) {
                const float* tp = tw + (size_t)(k1 * 64 + n20 + 4 * n) * 2;
                const f32x4 t0 = *(const f32x4*)tp, t1 = *(const f32x4*)(tp + 4);
#pragma unroll
                for (int bj = 0; bj < 2; ++bj) { const int chg = u.pn * 4 + bj * 2 + (wc >> 1), b = chg >> 10, ch = chg & 1023;
                    const f32x4 R = acc[0][bj][m][n], I = acc[1][bj][m][n];
                    const float r0 = R[0] * t0[0] - I[0] * t0[1], i0 = R[0] * t0[1] + I[0] * t0[0], r1 = R[1] * t0[2] - I[1] * t0[3], i1 = R[1] * t0[3] + I[1] * t0[2];
                    const float r2 = R[2] * t1[0] - I[2] * t1[1], i2 = R[2] * t1[1] + I[2] * t1[0], r3 = R[3] * t1[2] - I[3] * t1[3], i3 = R[3] * t1[3] + I[3] * t1[2];
                    bf16_t* op = O + ((((size_t)(b * 32 + (k1 >> 2)) * 1024 + ch) * 4 + (k1 & 3)) * 2) * 64 + n20 + 4 * n;
                    *(u32x2*)op = (u32x2){pk2(r0, r1), pk2(r2, r3)}; *(u32x2*)(op + 64) = (u32x2){pk2(i0, i1), pk2(i2, i3)}; }
                __builtin_amdgcn_sched_barrier(0); } }
    }
};
struct EpiFB3 {
    static constexpr bool PERM = true;
    bf16_t* O; float scale;
    __device__ __forceinline__ void operator()(const f32x4 (&acc)[2][2][4][2], const Unit& u, int wr, int wc, int fr, int fq) const {
#pragma unroll
        for (int ai = 0; ai < 2; ++ai)
#pragma unroll
            for (int m = 0; m < 4; ++m) { const int k1sub = 2 * ai + wr, k2 = m * 16 + fr;
#pragma unroll
                for (int bj = 0; bj < 2; ++bj) { const int n = u.pn * BM + bj * HALF + wc * 32 + 8 * fq, ch = n & 1023, k1q = (n >> 10) & 31, b = n >> 15;
                    const f32x4 v0 = acc[ai][bj][m][0] * scale, v1 = acc[ai][bj][m][1] * scale;
                    u32x4 w; w.x = pk2(v0[0], v0[1]); w.y = pk2(v0[2], v0[3]); w.z = pk2(v1[0], v1[1]); w.w = pk2(v1[2], v1[3]);
                    *(u32x4*)(O + (size_t)(b * SEQ + 4 * k1q + k1sub + 128 * k2) * D + ch) = w; } }
    }
};
}

__device__ __forceinline__ void wtrans_tile(const float* __restrict__ W, int N, int k0, int n0, bf16_t* __restrict__ WT, int K, int dstrow0, LAS bf16_t* scr, int lane) {
#pragma unroll 4
    for (int it = 0; it < 16; ++it) { const int kk = it * 4 + (lane >> 4), c4 = (lane & 15) * 4;
        const f32x4 v = *(const f32x4*)(W + (size_t)(k0 + kk) * N + n0 + c4);
        scr[(c4 + 0) * 72 + kk] = f2bf(v[0]); scr[(c4 + 1) * 72 + kk] = f2bf(v[1]); scr[(c4 + 2) * 72 + kk] = f2bf(v[2]); scr[(c4 + 3) * 72 + kk] = f2bf(v[3]); }
    LDS_WAIT();
#pragma unroll
    for (int it = 0; it < 8; ++it) { const int n = it * 8 + (lane >> 3), kc = (lane & 7) * 8;
        const u32x4 o = *(const LAS u32x4*)(scr + n * 72 + kc);
        *(u32x4*)(WT + (size_t)(dstrow0 + n) * K + k0 + kc) = o; }
    LDS_WAIT();
}
__device__ __forceinline__ void wtrans_tile8(const float* __restrict__ W, int N, int k0, int n0, unsigned char* __restrict__ WT, int K, int dstrow0, LAS unsigned char* scr, int lane) {
#pragma unroll 4
    for (int it = 0; it < 16; ++it) { const int kk = it * 4 + (lane >> 4), c4 = (lane & 15) * 4;
        const f32x4 v = *(const f32x4*)(W + (size_t)(k0 + kk) * N + n0 + c4) * S_W8;
        const unsigned w = pk4_fp8(v[0], v[1], v[2], v[3]);
        scr[(c4 + 0) * 80 + kk] = (unsigned char)(w & 0xff); scr[(c4 + 1) * 80 + kk] = (unsigned char)((w >> 8) & 0xff); scr[(c4 + 2) * 80 + kk] = (unsigned char)((w >> 16) & 0xff); scr[(c4 + 3) * 80 + kk] = (unsigned char)(w >> 24); }
    LDS_WAIT();
#pragma unroll
    for (int it = 0; it < 4; ++it) { const int n = it * 16 + (lane >> 2), kc = (lane & 3) * 16;
        const u32x4 o = *(const LAS u32x4*)(scr + n * 80 + kc);
        *(u32x4*)(WT + (size_t)(dstrow0 + n) * K + k0 + kc) = o; }
    LDS_WAIT();
}
__device__ __forceinline__ int gu_row(int n, int F) { const int part = n >= F, f = n - part * F; return (f >> 7) * 256 + part * 128 + (f & 127); }

__device__ __forceinline__ void phase0(const Params& p, LAS unsigned char* lds) {
    const int tid = otid(), lane = tid & 63, wid = tid >> 6, G = gridDim.x;
    {
        LAS float* sc = (LAS float*)lds;
        LAS float* red = sc + 5 * 1024;
        for (int item = blockIdx.x; item < 192; item += G) {
            const int layer = item / 96, cchunk = item % 96;
            const float* W = p.in[layer ? 19 : 6]; const float* bias = p.in[layer ? 20 : 7];
            __syncthreads();
            for (int i = tid; i < 5 * 1024; i += 512) { const int v = i >> 10, k = i & 1023; const float c = (v < 4) ? p.in[1][v * 1024 + k] : p.in[3][k]; sc[i] = c / (1.0f + __expf(-c)); }
            __syncthreads();
            const int col = cchunk * 64 + (tid & 63), kg = tid >> 6;
            float a0 = 0.f, a1 = 0.f, a2 = 0.f, a3 = 0.f, a4 = 0.f;
#pragma unroll 8
            for (int k = kg * 128; k < kg * 128 + 128; ++k) { const float w = W[(size_t)k * 6144 + col];
                a0 += sc[k] * w; a1 += sc[1024 + k] * w; a2 += sc[2048 + k] * w; a3 += sc[3072 + k] * w; a4 += sc[4096 + k] * w; }
            red[(kg * 5 + 0) * 64 + (tid & 63)] = a0; red[(kg * 5 + 1) * 64 + (tid & 63)] = a1; red[(kg * 5 + 2) * 64 + (tid & 63)] = a2;
            red[(kg * 5 + 3) * 64 + (tid & 63)] = a3; red[(kg * 5 + 4) * 64 + (tid & 63)] = a4;
            __syncthreads();
            if (tid < 320) { const int v = tid >> 6, cl = tid & 63; float s = 0.f;
#pragma unroll
                for (int g = 0; g < 8; ++g) s += red[(g * 5 + v) * 64 + cl];
                s += bias[cchunk * 64 + cl];
                if (layer == 0) ((float*)(p.ws + WS_ADA0))[v * 6144 + cchunk * 64 + cl] = s;
                else if (v < 4) ((float*)(p.ws + WS_ADA1))[v * 6144 + cchunk * 64 + cl] = s; }
        }
        __syncthreads();
    }
    {
        bf16_t* WC = (bf16_t*)(p.ws + WS_WC);
        for (int i = blockIdx.x * 512 + tid; i < 2048 * 128; i += G * 512) { const int row = i >> 7, c8 = (i & 127) * 8; const int ch = row >> 1, part = row & 1, g = ch >> 7, m = ch & 127;
            unsigned w[4];
#pragma unroll
            for (int e = 0; e < 4; ++e) { float v[2];
#pragma unroll
                for (int q = 0; q < 2; ++q) { const int c = c8 + e * 2 + q; float sv, cv; sincospif((float)(((c & 127) * m) & 127) * (1.0f / 64.0f), &sv, &cv); v[q] = ((c >> 7) == g) ? (part ? sv : cv) : 0.f; }
                w[e] = pk2(v[0], v[1]); }
            *(u32x4*)(WC + (size_t)row * 1024 + c8) = (u32x4){w[0], w[1], w[2], w[3]}; }
    }
    {
        bf16_t* WC2 = (bf16_t*)(p.ws + WS_WC2);
        for (int i = blockIdx.x * 512 + tid; i < 256 * 128; i += G * 512) { const int r = i >> 7, c = i & 127, m = r >> 1, part = r & 1;
            float sv, cv; sincospif((float)((c * m) & 127) * (1.0f / 64.0f), &sv, &cv); WC2[i] = f2bf(part ? sv : cv); }
    }
    {
        bf16_t* M1 = (bf16_t*)(p.ws + WS_M1); bf16_t* M3 = (bf16_t*)(p.ws + WS_M3); float* TW = (float*)(p.ws + WS_TW);
        for (int i = blockIdx.x * 512 + tid; i < 256 * 256 + 256 * 512 + 128 * 64; i += G * 512) {
            if (i < 256 * 256) { const int r = i >> 8, kk = i & 255, k1 = r & 127, im = r >> 7, part = kk >> 7, n1 = kk & 127;
                float sv, cv; sincospif((float)((n1 * k1) & 127) * (1.0f / 64.0f), &sv, &cv);
                const float v = im == 0 ? (part == 0 ? cv : -sv) : (part == 0 ? sv : cv); M1[i] = f2bf(v);
            } else if (i < 256 * 256 + 256 * 512) { const int q = i - 256 * 256, r = q >> 9, kk = q & 511, k1s = r >> 6, k2 = r & 63, k1s2 = kk >> 7, part = (kk >> 6) & 1, n2 = kk & 63;
                float sv, cv; sincospif((float)((n2 * k2) & 63) * (1.0f / 32.0f), &sv, &cv);
                M3[q] = f2bf(k1s == k1s2 ? (part == 0 ? cv : -sv) : 0.f);
            } else { const int q = i - 256 * 256 - 256 * 512, k1 = q >> 6, n2 = q & 63;
                float sv, cv; sincospif((float)(n2 * k1) * (1.0f / 4096.0f), &sv, &cv); TW[2 * q] = cv; TW[2 * q + 1] = sv; }
        }
    }
    {
        LAS bf16_t* scr = (LAS bf16_t*)lds + wid * (64 * 72);
        constexpr int T_IN = 16 * 48, T_OUT = 16 * 16, T_GU = 16 * 88, T_DN = 44 * 16, T_FO = 16 * 16, T_EGU = 16 * 112, T_EDN = 56 * 16;
        constexpr int TOTAL = T_IN + T_OUT + T_GU + T_DN + T_FO + NE * T_EGU + NE * T_EDN;
        constexpr int NG = (TOTAL + 7) / 8;
        const int nb = blockIdx.x; const bool bal = (G == 256), spare = bal && nb >= 192;
        for (int rr = 0;; ++rr) {
            int grp; if (bal) { if (spare && rr < 4) grp = (nb - 192) * 4 + rr; else grp = 256 + (rr - (spare ? 4 : 0)) * 256 + nb; } else grp = rr * G + nb;
            if (grp >= NG) break;
            const int it = grp * 8 + wid; if (it >= TOTAL) continue;
            int r = it;
            if (r < T_IN) { const int kb = r / 48, nb = r % 48; wtrans_tile(p.in[8], INW, kb * 64, nb * 64, (bf16_t*)(p.ws + WS_WT_IN), D, nb * 64, scr, lane); continue; } r -= T_IN;
            if (r < T_OUT) { const int kb = r / 16, nb = r % 16; wtrans_tile(p.in[14], D, kb * 64, nb * 64, (bf16_t*)(p.ws + WS_WT_OUT), D, nb * 64, scr, lane); continue; } r -= T_OUT;
#if USE_FP8_FFN
            if (r < T_GU) { const int kb = r / 88, nb = r % 88; wtrans_tile8(p.in[15], 2 * FFN, kb * 64, nb * 64, p.ws + WS_WT_GU, D, gu_row(nb * 64, FFN), (LAS unsigned char*)scr, lane); continue; } r -= T_GU;
#else
            if (r < T_GU) { const int kb = r / 88, nb = r % 88; wtrans_tile(p.in[15], 2 * FFN, kb * 64, nb * 64, (bf16_t*)(p.ws + WS_WT_GU), D, gu_row(nb * 64, FFN), scr, lane); continue; } r -= T_GU;
#endif
#if USE_FP8_FFN || USE_FP8_FFN2
            if (r < T_DN) { const int kb = r / 16, nb = r % 16; wtrans_tile8(p.in[16], D, kb * 64, nb * 64, p.ws + WS_WT_DOWN, FFN, nb * 64, (LAS unsigned char*)scr, lane); continue; } r -= T_DN;
#else
            if (r < T_DN) { const int kb = r / 16, nb = r % 16; wtrans_tile(p.in[16], D, kb * 64, nb * 64, (bf16_t*)(p.ws + WS_WT_DOWN), FFN, nb * 64, scr, lane); continue; } r -= T_DN;
#endif
            if (r < T_FO) { const int kb = r / 16, nb = r % 16; wtrans_tile(p.in[21], D, kb * 64, nb * 64, (bf16_t*)(p.ws + WS_WT_FOUR), D, nb * 64, scr, lane); continue; } r -= T_FO;
            if (r < NE * T_EGU) { const int e = r / T_EGU, q = r % T_EGU, kb = q / 112, nb = q % 112;
#if USE_FP8
                wtrans_tile8(p.in[23] + (size_t)e * D * 2 * EDIM, 2 * EDIM, kb * 64, nb * 64, p.ws + WS_WT_EGU + (size_t)e * 2 * EDIM * D, D, gu_row(nb * 64, EDIM), (LAS unsigned char*)scr, lane); continue; } r -= NE * T_EGU;
#else
                wtrans_tile(p.in[23] + (size_t)e * D * 2 * EDIM, 2 * EDIM, kb * 64, nb * 64, (bf16_t*)(p.ws + WS_WT_EGU) + (size_t)e * 2 * EDIM * D, D, gu_row(nb * 64, EDIM), scr, lane); continue; } r -= NE * T_EGU;
#endif
            { const int e = r / T_EDN, q = r % T_EDN, kb = q / 16, nb = q % 16;
#if USE_FP8
                wtrans_tile8(p.in[24] + (size_t)e * EDIM * D, D, kb * 64, nb * 64, p.ws + WS_WT_EDOWN + (size_t)e * D * EDIM, EDIM, nb * 64, (LAS unsigned char*)scr, lane); }
#else
                wtrans_tile(p.in[24] + (size_t)e * EDIM * D, D, kb * 64, nb * 64, (bf16_t*)(p.ws + WS_WT_EDOWN) + (size_t)e * D * EDIM, EDIM, nb * 64, scr, lane); }
#endif
        }
    }
}

__device__ __forceinline__ void norm_row(const float* __restrict__ xr, const float* __restrict__ gain, const float* __restrict__ sh, const float* __restrict__ sc, bf16_t* __restrict__ orow, int lane, f32x4 (&hv)[4], bool f8 = false) {
    f32x4 v[4]; float s = 0.f;
#pragma unroll
    for (int j = 0; j < 4; ++j) { v[j] = *(const f32x4*)(xr + 4 * lane + 256 * j); s += (v[j][0] * v[j][0] + v[j][1] * v[j][1]) + (v[j][2] * v[j][2] + v[j][3] * v[j][3]); }
    const float rstd = rsqrtf(wave_sum(s) * (1.0f / D) + EPS);
#pragma unroll
    for (int j = 0; j < 4; ++j) { const f32x4 g = *(const f32x4*)(gain + 4 * lane + 256 * j), a = *(const f32x4*)(sh + 4 * lane + 256 * j), b = *(const f32x4*)(sc + 4 * lane + 256 * j);
        f32x4 h;
#pragma unroll
        for (int e = 0; e < 4; ++e) h[e] = (v[j][e] * rstd * g[e]) * (1.0f + b[e]) + a[e];
        hv[j] = h;
        if (f8) *(unsigned*)((unsigned char*)orow + 4 * lane + 256 * j) = pk4_fp8(h[0] * S_A8, h[1] * S_A8, h[2] * S_A8, h[3] * S_A8);
        else *(u32x2*)(orow + 4 * lane + 256 * j) = (u32x2){pk2(h[0], h[1]), pk2(h[2], h[3])}; }
}
template <int NR, bool ROUTER>
__device__ __forceinline__ void norm_rows4(const float* __restrict__ x0, const float* __restrict__ gain, const float* __restrict__ sh, const float* __restrict__ sc,
                                           unsigned char* __restrict__ o0, int opitch, bool f8, int lane, const LAS float* wr, float (&lg)[NR][8]) {
    f32x4 v[NR][4]; float rstd[NR];
#pragma unroll
    for (int r = 0; r < NR; ++r)
#pragma unroll
        for (int j = 0; j < 4; ++j) v[r][j] = *(const f32x4*)(x0 + (size_t)r * D + 4 * lane + 256 * j);
#pragma unroll
    for (int r = 0; r < NR; ++r) { float s = 0.f;
#pragma unroll
        for (int j = 0; j < 4; ++j) s += (v[r][j][0] * v[r][j][0] + v[r][j][1] * v[r][j][1]) + (v[r][j][2] * v[r][j][2] + v[r][j][3] * v[r][j][3]);
        rstd[r] = rsqrtf(wave_sum(s) * (1.0f / D) + EPS); }
    if (ROUTER) {
#pragma unroll
        for (int r = 0; r < NR; ++r)
#pragma unroll
            for (int e = 0; e < 8; ++e) lg[r][e] = 0.f; }
#pragma unroll
    for (int j = 0; j < 4; ++j) { const int c = 4 * lane + 256 * j;
        const f32x4 g = *(const f32x4*)(gain + c), a = *(const f32x4*)(sh + c), b = *(const f32x4*)(sc + c);
        f32x4 h[NR];
#pragma unroll
        for (int r = 0; r < NR; ++r) {
#pragma unroll
            for (int e = 0; e < 4; ++e) h[r][e] = (v[r][j][e] * rstd[r] * g[e]) * (1.0f + b[e]) + a[e];
            if (f8) *(unsigned*)(o0 + (size_t)r * opitch + c) = pk4_fp8(h[r][0] * S_A8, h[r][1] * S_A8, h[r][2] * S_A8, h[r][3] * S_A8);
            else *(u32x2*)(o0 + (size_t)r * opitch + 2 * c) = (u32x2){pk2(h[r][0], h[r][1]), pk2(h[r][2], h[r][3])}; }
        if (ROUTER) {
#pragma unroll
            for (int q = 0; q < 4; ++q) { const f32x4 w0 = *(const LAS f32x4*)(wr + (c + q) * 8), w1 = *(const LAS f32x4*)(wr + (c + q) * 8 + 4);
#pragma unroll
                for (int r = 0; r < NR; ++r) { const float hh = h[r][q];
                    lg[r][0] += hh * w0[0]; lg[r][1] += hh * w0[1]; lg[r][2] += hh * w0[2]; lg[r][3] += hh * w0[3]; lg[r][4] += hh * w1[0]; lg[r][5] += hh * w1[1]; lg[r][6] += hh * w1[2]; lg[r][7] += hh * w1[3]; } } } }
}
__device__ __forceinline__ void phase_norm(const Params& p, const float* X, const float* gain, const float* ada, int chunk_shift, bool with_ctx, bool f8 = false) {
    const int lane = otid() & 63, gw = blockIdx.x * 8 + (otid() >> 6), NW = gridDim.x * 8;
    unsigned char* H = p.ws + WS_H; const int opitch = f8 ? D : 2 * D;
    float lg[8][8];
    for (int r0 = gw * 8; r0 < T; r0 += NW * 8) { const int b = r0 >> 13;
        norm_rows4<8, false>(X + (size_t)r0 * D, gain, ada + b * 6144 + chunk_shift * 1024, ada + b * 6144 + (chunk_shift + 1) * 1024, H + (size_t)r0 * opitch, opitch, f8, lane, nullptr, lg); }
    if (with_ctx) { unsigned char* HX = p.ws + WS_HX;
        for (int r0 = gw * 8; r0 < TX; r0 += NW * 8) norm_rows4<8, false>(p.in[2] + (size_t)r0 * D, gain, ada + 4 * 6144, ada + 4 * 6144 + 1024, HX + (size_t)r0 * 2 * D, 2 * D, false, lane, nullptr, lg); }
}
__device__ __forceinline__ void phase_norm_router(const Params& p, LAS unsigned char* lds) {
    const int tid = otid(), lane = tid & 63, wid = tid >> 6;
    LAS float* wr = (LAS float*)lds;
    LAS int* hist = (LAS int*)(lds + 32768);
    for (int i = tid; i < 8192; i += 512) wr[i] = p.in[22][i];
    const float* X = p.out; const float* gain = p.in[18]; const float* ada = (const float*)(p.ws + WS_ADA1);
    unsigned char* H = p.ws + WS_H; const int opitch = USE_FP8 ? D : 2 * D;
    int* toke = (int*)(p.ws + WS_TOKE); f32x2* tokg = (f32x2*)(p.ws + WS_TOKG); int* histg = (int*)(p.ws + WS_HIST);
    for (int ch = blockIdx.x; ch < 256; ch += gridDim.x) {
        __syncthreads();
        if (tid < 8) hist[tid] = 0;
        __syncthreads();
        for (int rr = wid * 2; rr < 128; rr += 16) { const int row0 = ch * 128 + rr, b = row0 >> 13;
            float lg[2][8];
            norm_rows4<2, true>(X + (size_t)row0 * D, gain, ada + b * 6144 + 3 * 1024, ada + b * 6144 + 4 * 1024, H + (size_t)row0 * opitch, opitch, USE_FP8 != 0, lane, wr, lg);
#pragma unroll
            for (int r = 0; r < 2; ++r) {
#pragma unroll
                for (int e = 0; e < 8; ++e) lg[r][e] = wave_sum(lg[r][e]);
                int e0 = 0; float l0 = lg[r][0];
#pragma unroll
                for (int e = 1; e < 8; ++e) if (lg[r][e] > l0) { l0 = lg[r][e]; e0 = e; }
                int e1 = -1; float l1 = -3.0e38f;
#pragma unroll
                for (int e = 0; e < 8; ++e) if (e != e0 && lg[r][e] > l1) { l1 = lg[r][e]; e1 = e; }
                if (lane == 0) { const float ex = __expf(l1 - l0); const float g0 = 1.0f / (1.0f + ex);
                    toke[row0 + r] = e0 | (e1 << 8); tokg[row0 + r] = (f32x2){g0, ex * g0};
                    lds_add(&hist[e0], 1); lds_add(&hist[e1], 1); } }
        }
        __syncthreads();
        if (tid < 8) histg[ch * 8 + tid] = hist[tid];
    }
}

__device__ __forceinline__ void moe_totals(const Params& p, LAS int* tot  , LAS int* bef  , int ch) {
    const int tid = otid(); const int* histg = (const int*)(p.ws + WS_HIST);
    __syncthreads();
    if (tid < 8) { tot[tid] = 0; bef[tid] = 0; }
    __syncthreads();
    for (int i = tid; i < 2048; i += 512) { const int v = histg[i]; lds_add(&tot[i & 7], v); if ((i >> 3) < ch) lds_add(&bef[i & 7], v); }
    __syncthreads();
}
__device__ __forceinline__ void phase_slots(const Params& p, LAS unsigned char* lds) {
    const int tid = otid(), lane = tid & 63, wid = tid >> 6;
    LAS int* tot = (LAS int*)lds; LAS int* bef = tot + 8; LAS int* pst = bef + 8; LAS int* te = pst + 16; LAS int* sl = te + 128;
    const int* toke = (const int*)(p.ws + WS_TOKE); const f32x2* tokg = (const f32x2*)(p.ws + WS_TOKG);
    int* toks = (int*)(p.ws + WS_TOKS); int* sltok = (int*)(p.ws + WS_SLTOK); float* slg = (float*)(p.ws + WS_SLGATE);
    const unsigned char* H8 = p.ws + WS_H; unsigned char* H8S = p.ws + WS_B + B_H8S;
    for (int ch = blockIdx.x; ch < 256; ch += gridDim.x) {
        moe_totals(p, tot, bef, ch);
        if (tid == 0) { int s = 0; for (int e = 0; e < 8; ++e) { pst[e] = s; s += (tot[e] + 255) & ~255; if (ch == 0) ((int*)(p.ws + WS_BAR))[3500 + e] = s >> 8; } pst[8] = s; }
        if (tid < 128) te[tid] = toke[ch * 128 + tid];
        __syncthreads();
        if (tid < 8) { const int e = tid; int slot = pst[e] + bef[e];
            for (int i = 0; i < 128; ++i) { const int w = te[i], t = ch * 128 + i;
                if ((w & 255) == e) { sltok[slot] = t; slg[slot] = tokg[t][0]; toks[2 * t] = slot; sl[2 * i] = slot; ++slot; }
                if ((w >> 8) == e) { sltok[slot] = t; slg[slot] = tokg[t][1]; toks[2 * t + 1] = slot; sl[2 * i + 1] = slot; ++slot; } }
            if (ch == 255) { const int end = pst[e + 1]; for (; slot < end; ++slot) { sltok[slot] = 0; slg[slot] = 0.f; } } }
        __syncthreads();
#if USE_FP8
        for (int i = wid; i < 128; i += 8) { const u32x4 v = *(const u32x4*)(H8 + (size_t)(ch * 128 + i) * D + lane * 16);
            *(u32x4*)(H8S + (size_t)sl[2 * i] * D + lane * 16) = v; *(u32x4*)(H8S + (size_t)sl[2 * i + 1] * D + lane * 16) = v; }
#endif
    }
}

__device__ __forceinline__ void rope4(float (&x)[8], int head_pair0, int pos, float scale) {
    const float row = (float)(pos >> 6), col = (float)(pos & 63);
#pragma unroll
    for (int e = 0; e < 4; ++e) { const int pp = head_pair0 + e; const float base = pp < 16 ? row : col; const int f = pp & 15;
        const float inv = exp2f(-(float)f * (13.287712379549449f / 16.0f));
        float sn, cs; sincosf(base * inv, &sn, &cs);
        const float x1 = x[2 * e], x2 = x[2 * e + 1]; x[2 * e] = (x1 * cs - x2 * sn) * scale; x[2 * e + 1] = (x1 * sn + x2 * cs) * scale; }
}
__device__ __forceinline__ void headnorm_store(const u32x4 w, bf16_t* ptr, const float* gain, int lane) {
    float x[8]; unpack8(w, x);
    float s = 0.f;
#pragma unroll
    for (int e = 0; e < 8; ++e) s += x[e] * x[e];
    s += __shfl_xor(s, 1); s += __shfl_xor(s, 2); s += __shfl_xor(s, 4);
    const float rstd = rsqrtf(s * (1.0f / 64.0f) + EPS);
    const f32x4 g0 = *(const f32x4*)(gain + (lane & 7) * 8), g1 = *(const f32x4*)(gain + (lane & 7) * 8 + 4);
#pragma unroll
    for (int e = 0; e < 4; ++e) { x[e] = x[e] * rstd * g0[e]; x[4 + e] = x[4 + e] * rstd * g1[e]; }
    *(u32x4*)(ptr + lane * 8) = pack8(x);
}
__device__ __forceinline__ void headnorm_inplace(bf16_t* ptr, const float* gain, int lane) { headnorm_store(*(const u32x4*)(ptr + lane * 8), ptr, gain, lane); }
__device__ __forceinline__ void btrans_tile(const bf16_t* __restrict__ src, int lds_, bf16_t* __restrict__ dst, int ldd, int dstrow0, int dstcol0, int mode, int pos0, LAS bf16_t* scr, int lane) {
#pragma unroll 2
    for (int it = 0; it < 8; ++it) { const int rr = it * 8 + (lane >> 3), ck = lane & 7;
        u32x4 w = *(const u32x4*)(src + (size_t)rr * lds_ + ck * 8);
        if (mode) { float x[8]; unpack8(w, x);
            if (mode == 2) rope4(x, ck * 4, pos0 + rr, 0.125f);
            else {
#pragma unroll
                for (int e = 0; e < 8; ++e) x[e] *= 0.125f; }
            w = pack8(x); }
        const int c0 = ck * 8;
        scr[(c0 + 0) * 72 + rr] = (bf16_t)(w.x & 0xffff); scr[(c0 + 1) * 72 + rr] = (bf16_t)(w.x >> 16);
        scr[(c0 + 2) * 72 + rr] = (bf16_t)(w.y & 0xffff); scr[(c0 + 3) * 72 + rr] = (bf16_t)(w.y >> 16);
        scr[(c0 + 4) * 72 + rr] = (bf16_t)(w.z & 0xffff); scr[(c0 + 5) * 72 + rr] = (bf16_t)(w.z >> 16);
        scr[(c0 + 6) * 72 + rr] = (bf16_t)(w.w & 0xffff); scr[(c0 + 7) * 72 + rr] = (bf16_t)(w.w >> 16); }
    LDS_WAIT();
#pragma unroll
    for (int it = 0; it < 8; ++it) { const int c = it * 8 + (lane >> 3), rc = (lane & 7) * 8;
        const u32x4 o = *(const LAS u32x4*)(scr + c * 72 + rc);
        *(u32x4*)(dst + (size_t)(dstrow0 + c) * ldd + dstcol0 + rc) = o; }
    LDS_WAIT();
}
__device__ __forceinline__ void phase3(const Params& p, LAS unsigned char* lds) {
    const int lane = otid() & 63, wid = otid() >> 6, gw = blockIdx.x * 8 + wid, NW = gridDim.x * 8;
    bf16_t* proj = (bf16_t*)(p.ws + WS_B + B_PROJ); bf16_t* projx = (bf16_t*)(p.ws + WS_B + B_PROJX);
    bf16_t* rkr = (bf16_t*)(p.ws + WS_B + B_RKR);
    const float* qg = p.in[9]; const float* kg = p.in[10];
    for (int row0 = gw * 4; row0 < T; row0 += NW * 4) {
        u32x4 wq[4], wk[4], wr_[4];
#pragma unroll
        for (int r = 0; r < 4; ++r) { const bf16_t* pr = proj + (size_t)(row0 + r) * INW; const int l5 = lane & 31;
            wq[r] = *(const u32x4*)(pr + C_NAQ + lane * 8); wk[r] = *(const u32x4*)(pr + C_NAK + lane * 8); wr_[r] = *(const u32x4*)(pr + (lane < 32 ? C_RQ : C_RK) + l5 * 8); }
#pragma unroll
        for (int r = 0; r < 4; ++r) { bf16_t* pr = proj + (size_t)(row0 + r) * INW; const int pos = (row0 + r) & (SEQ - 1), l5 = lane & 31;
            headnorm_store(wq[r], pr + C_NAQ, qg, lane); headnorm_store(wk[r], pr + C_NAK, kg, lane);
            float x[8]; unpack8(wr_[r], x);
            rope4(x, (l5 & 7) * 4, pos, lane < 32 ? 1.0f : 0.125f);
            bf16_t* dstp = lane < 32 ? pr + C_RQ + l5 * 8 : rkr + (size_t)(row0 + r) * 256 + l5 * 8;
            *(u32x4*)dstp = pack8(x); }
    }
    for (int row = gw; row < TX; row += NW) headnorm_inplace(projx + (size_t)row * KVW + X_NAK, kg, lane);
    LAS bf16_t* scr = (LAS bf16_t*)lds + wid * (64 * 72);
    bf16_t* navt = (bf16_t*)(p.ws + WS_B + B_NAVT); bf16_t* retvt = (bf16_t*)(p.ws + WS_B + B_RETVT); bf16_t* retkt = (bf16_t*)(p.ws + WS_B + B_RETKT);
    bf16_t* navxt = (bf16_t*)(p.ws + WS_B + B_NAVXT); bf16_t* retvxt = (bf16_t*)(p.ws + WS_B + B_RETVXT); bf16_t* retkxt = (bf16_t*)(p.ws + WS_B + B_RETKXT);
    constexpr int NT_L = 512 * 20, NT_X = 16 * 20;
    for (int it = gw; it < NT_L + NT_X; it += NW) {
        if (it < NT_L) { const int tt = it / 20, ct = it % 20, b = tt >> 7, n0 = (tt & 127) * 64; const bf16_t* srow = proj + (size_t)tt * 64 * INW;
            if (ct < 8) btrans_tile(srow + C_NAV + ct * 64, INW, navt, SEQ, b * 512 + ct * 64, n0, 0, 0, scr, lane);
            else if (ct < 16) btrans_tile(srow + C_RV + (ct - 8) * 64, INW, retvt, SEQ, b * 512 + (ct - 8) * 64, n0, 0, 0, scr, lane);
            else btrans_tile(srow + C_RK + (ct - 16) * 64, INW, retkt, SEQ, b * 256 + (ct - 16) * 64, n0, 2, n0, scr, lane);
        } else { const int q = it - NT_L, tt = q / 20, ct = q % 20, b = tt >> 2, l0 = (tt & 3) * 64; const bf16_t* srow = projx + (size_t)tt * 64 * KVW;
            if (ct < 8) btrans_tile(srow + X_NAV + ct * 64, KVW, navxt, CTXL, b * 512 + ct * 64, l0, 0, 0, scr, lane);
            else if (ct < 16) btrans_tile(srow + X_RV + (ct - 8) * 64, KVW, retvxt, CTXL, b * 512 + (ct - 8) * 64, l0, 0, 0, scr, lane);
            else btrans_tile(srow + X_RK + (ct - 16) * 64, KVW, retkxt, CTXL, b * 256 + (ct - 16) * 64, l0, 1, 0, scr, lane);
        }
    }
}

struct NaState { f32x4 o[4]; float l; };
struct NaK { u32x4 k[2][2][2]; };
struct NaV { u32x4 v[2][4]; };
struct NaPtrs { const bf16_t* ks0; const bf16_t* vs0; const bf16_t* kx0; const bf16_t* vx0; };
__device__ __forceinline__ void na_loadK(NaK& f, const NaPtrs& P, int ci, int fr, int fq) {
    const bool strip = ci < 4; const size_t kld = strip ? INW : KVW;
    const bf16_t* kb0 = strip ? P.ks0 + (size_t)ci * 128 * INW : P.kx0 + (size_t)(ci - 4) * 64 * KVW;
    const bf16_t* kb1 = kb0 + (strip ? (size_t)64 * INW : (size_t)32 * KVW);
    const int kkrow = 8 * (fr >> 2) + (fr & 3);
#pragma unroll
    for (int i = 0; i < 2; ++i)
#pragma unroll
        for (int t = 0; t < 2; ++t) { const bf16_t* kp = (i ? kb1 : kb0) + (size_t)(kkrow + 4 * t) * kld + fq * 8; f.k[i][t][0] = *(const u32x4*)kp; f.k[i][t][1] = *(const u32x4*)(kp + 32); }
}
__device__ __forceinline__ void na_loadV(NaV& f, const NaPtrs& P, int ci, int fr, int fq) {
    const bool strip = ci < 4; const size_t vld = strip ? SEQ : CTXL;
    const bf16_t* vb0 = strip ? P.vs0 + ci * 128 : P.vx0 + (ci - 4) * 64;
    const bf16_t* vb1 = vb0 + (strip ? 64 : 32);
#pragma unroll
    for (int i = 0; i < 2; ++i)
#pragma unroll
        for (int dt = 0; dt < 4; ++dt) f.v[i][dt] = *(const u32x4*)((i ? vb1 : vb0) + (size_t)(dt * 16 + fr) * vld + 8 * fq);
}
constexpr int NA_LK_PITCH = 144, NA_LV_PITCH = 528, NA_LV_OFF = 256 * NA_LK_PITCH, NA_RPB_OFF = NA_LV_OFF + 64 * NA_LV_PITCH;
__device__ __forceinline__ void na_loadK_x(NaK& f, const LAS unsigned char* lk, int cx, int fr, int fq) {
    const int kkrow = 8 * (fr >> 2) + (fr & 3);
#pragma unroll
    for (int i = 0; i < 2; ++i)
#pragma unroll
        for (int t = 0; t < 2; ++t) { const LAS unsigned char* kp = lk + (64 * cx + 32 * i + kkrow + 4 * t) * NA_LK_PITCH + fq * 16; f.k[i][t][0] = *(const LAS u32x4*)kp; f.k[i][t][1] = *(const LAS u32x4*)(kp + 64); }
}
__device__ __forceinline__ void na_loadV_x(NaV& f, const LAS unsigned char* lv, int cx, int fr, int fq) {
#pragma unroll
    for (int i = 0; i < 2; ++i)
#pragma unroll
        for (int dt = 0; dt < 4; ++dt) f.v[i][dt] = *(const LAS u32x4*)(lv + (dt * 16 + fr) * NA_LV_PITCH + (64 * cx + 32 * i + 8 * fq) * 2);
}
template <bool STRIP>
__device__ __forceinline__ void na_compute(NaState& st, const NaK& fk, const NaV& fv, const u32x4 (&qf)[2], const LAS float* brow0, const LAS float* brow1, int cb, int c0, int qc, int fq, float sref) {
    f32x4 s[2][2];
#pragma unroll
    for (int i = 0; i < 2; ++i)
#pragma unroll
        for (int t = 0; t < 2; ++t) { f32x4 a = mfma16(fk.k[i][t][0], qf[0], (f32x4){0.f, 0.f, 0.f, 0.f}); s[i][t] = mfma16(fk.k[i][t][1], qf[1], a); }
    float sum = 0.f; u32x4 pf[2];
#pragma unroll
    for (int i = 0; i < 2; ++i) { float e[8];
#pragma unroll
        for (int t = 0; t < 2; ++t)
#pragma unroll
            for (int j = 0; j < 4; ++j) { float v = s[i][t][j] * 0.125f - sref;
                if (STRIP) { const int kc = cb + 8 * fq + 4 * t + j; const bool valid = (unsigned)(kc - c0) < 16u; const int co = min(max(kc - qc + 15, 0), 30);
                    v = valid ? v + (i ? brow1 : brow0)[co] : -3.0e38f; }
                const float pe = __expf(v); e[t * 4 + j] = pe; sum += pe; }
        pf[i] = pack8(e); }
    st.l += sum;
#pragma unroll
    for (int i = 0; i < 2; ++i)
#pragma unroll
        for (int dt = 0; dt < 4; ++dt) st.o[dt] = mfma16(fv.v[i][dt], pf[i], st.o[dt]);
}
__device__ __forceinline__ void na_item(const Params& p, int b, int h, int r, int g, int lane, const LAS unsigned char* lds, float sref) {
    const int fr = lane & 15, fq = lane >> 4;
    const bf16_t* proj = (const bf16_t*)(p.ws + WS_B + B_PROJ); const bf16_t* navt = (const bf16_t*)(p.ws + WS_B + B_NAVT);
    const LAS float* rpb = (const LAS float*)(lds + NA_RPB_OFF) + h * (15 * 31);
    const LAS unsigned char* lk = lds; const LAS unsigned char* lv = lds + NA_LV_OFF;
    const int qc = 16 * g + fr, tokq = b * SEQ + r * 64 + qc;
    const int r0 = min(max(r - 4, 0), 120), cb = min(max(16 * g - 8, 0), 32), c0 = min(max(qc - 8, 0), 48);
    u32x4 qf[2];
#pragma unroll
    for (int ks = 0; ks < 2; ++ks) qf[ks] = *(const u32x4*)(proj + (size_t)tokq * INW + C_NAQ + h * 64 + ks * 32 + fq * 8);
    NaState st;
#pragma unroll
    for (int dt = 0; dt < 4; ++dt) st.o[dt] = (f32x4){0.f, 0.f, 0.f, 0.f};
    st.l = 0.f;
    NaPtrs P;
    P.ks0 = proj + (size_t)(b * SEQ + r0 * 64 + cb) * INW + C_NAK + h * 64;
    P.vs0 = navt + (size_t)(b * 512 + h * 64) * SEQ + r0 * 64 + cb;
    P.kx0 = nullptr; P.vx0 = nullptr;
    NaK ka, kb; NaV vv;
    na_loadK(ka, P, 0, fr, fq);
#pragma unroll 1
    for (int cp = 0; cp < 2; ++cp) { const int ci = 2 * cp;
        const LAS float* br0 = rpb + (r0 + 2 * ci - r + 7) * 31;
        na_loadV(vv, P, ci, fr, fq); na_loadK(kb, P, ci + 1, fr, fq);
        na_compute<true>(st, ka, vv, qf, br0, br0 + 31, cb, c0, qc, fq, sref);
        na_loadV(vv, P, ci + 1, fr, fq); if (cp == 0) na_loadK(ka, P, ci + 2, fr, fq); else na_loadK_x(ka, lk, 0, fr, fq);
        na_compute<true>(st, kb, vv, qf, br0 + 62, br0 + 93, cb, c0, qc, fq, sref); }
#pragma unroll 1
    for (int cx = 0; cx < 4; cx += 2) {
        na_loadV_x(vv, lv, cx, fr, fq); na_loadK_x(kb, lk, cx + 1, fr, fq);
        na_compute<false>(st, ka, vv, qf, rpb, rpb, 0, 0, 0, fq, sref);
        na_loadV_x(vv, lv, cx + 1, fr, fq); na_loadK_x(ka, lk, cx + 2 < 4 ? cx + 2 : 3, fr, fq);
        na_compute<false>(st, kb, vv, qf, rpb, rpb, 0, 0, 0, fq, sref); }
    float l1 = st.l;
    l1 += __shfl_xor(l1, 16); l1 += __shfl_xor(l1, 32);
    const float inv = 1.0f / l1;
    bf16_t* mix = (bf16_t*)(p.ws + WS_B + B_MIXIN) + (size_t)tokq * D + h * 64;
#pragma unroll
    for (int dt = 0; dt < 4; ++dt) { const f32x4 v = st.o[dt] * inv; *(u32x2*)(mix + dt * 16 + 4 * fq) = (u32x2){pk2(v[0], v[1]), pk2(v[2], v[3])}; }
}
__device__ __forceinline__ void na_range(const Params& p, int ulo, int uhi, LAS unsigned char* lds) {
    const int tid = otid(), lane = tid & 63, wid = tid >> 6;
    const bf16_t* projx = (const bf16_t*)(p.ws + WS_B + B_PROJX); const bf16_t* navxt = (const bf16_t*)(p.ws + WS_B + B_NAVXT);
    LAS float* rpb_l = (LAS float*)(lds + NA_RPB_OFF);
    for (int u = ulo + blockIdx.x; u < uhi; u += gridDim.x) { const int bh = u >> 3, b = bh >> 3, h = bh & 7, rbase = (u & 7) * 16;
        __syncthreads();
        for (int i = tid; i < 8 * 15 * 31; i += 512) rpb_l[i] = p.in[11][i];
        for (int i = tid; i < 2048; i += 512) { const int l = i >> 3, ck = i & 7;
            *(LAS u32x4*)(lds + l * NA_LK_PITCH + ck * 16) = *(const u32x4*)(projx + (size_t)(b * CTXL + l) * KVW + X_NAK + h * 64 + ck * 8); }
        for (int i = tid; i < 2048; i += 512) { const int d = i >> 5, ck = i & 31;
            *(LAS u32x4*)(lds + NA_LV_OFF + d * NA_LV_PITCH + ck * 16) = *(const u32x4*)(navxt + (size_t)(b * 512 + h * 64 + d) * CTXL + ck * 8); }
        __syncthreads();
        float gq = fabsf(p.in[9][lane]), gk = fabsf(p.in[10][lane]), bm = 0.f;
        for (int i = lane; i < 15 * 31; i += 64) bm = fmaxf(bm, fabsf(rpb_l[h * (15 * 31) + i]));
#pragma unroll
        for (int o = 1; o < 64; o <<= 1) { gq = fmaxf(gq, __shfl_xor(gq, o)); gk = fmaxf(gk, __shfl_xor(gk, o)); bm = fmaxf(bm, __shfl_xor(bm, o)); }
        const float sref = fminf(8.0f * 1.02f * gq * gk + bm, 40.0f);
        for (int it = wid; it < 64; it += 8) na_item(p, b, h, rbase + (it >> 2), it & 3, lane, lds, sref);
    }
}

__device__ __forceinline__ float log2_decay(float a) { return -log1pf(__expf(-a)) * 1.4426950408889634f; }
__device__ __forceinline__ void retU_item(const Params& p, int item, int lane) {
    const int w = item & 7, cc = (item >> 3) % NCC, bh = (item >> 3) / NCC, b = bh >> 2, h = bh & 3;
    const int fr = lane & 15, fq = lane >> 4;
    const float lgf = log2_decay(p.in[12][h]), lgb = log2_decay(p.in[13][h]);
    const bf16_t* vt; const bf16_t* kt; size_t ld; int n0;
    if (cc < 2) { vt = (const bf16_t*)(p.ws + WS_B + B_RETVXT); kt = (const bf16_t*)(p.ws + WS_B + B_RETKXT); ld = CTXL; n0 = cc * 128; }
    else { vt = (const bf16_t*)(p.ws + WS_B + B_RETVT); kt = (const bf16_t*)(p.ws + WS_B + B_RETKT); ld = SEQ; n0 = (cc - 2) * 128; }
    f32x4 af[4], ab[4];
#pragma unroll
    for (int nt = 0; nt < 4; ++nt) { af[nt] = (f32x4){0.f, 0.f, 0.f, 0.f}; ab[nt] = (f32x4){0.f, 0.f, 0.f, 0.f}; }
#pragma unroll
    for (int ks = 0; ks < 4; ++ks) {
        const u32x4 va = *(const u32x4*)(vt + (size_t)(b * 512 + h * 128 + 16 * w + fr) * ld + n0 + 32 * ks + 8 * fq);
        float wf[8], wb[8];
#pragma unroll
        for (int e = 0; e < 8; ++e) { const int j = 32 * ks + 8 * fq + e; wf[e] = exp2f((float)(127 - j) * lgf); wb[e] = exp2f((float)j * lgb); }
#pragma unroll
        for (int nt = 0; nt < 4; ++nt) { const u32x4 kw = *(const u32x4*)(kt + (size_t)(b * 256 + h * 64 + 16 * nt + fr) * ld + n0 + 32 * ks + 8 * fq);
            float x[8], y[8]; unpack8(kw, x);
#pragma unroll
            for (int e = 0; e < 8; ++e) { y[e] = x[e] * wb[e]; x[e] *= wf[e]; }
            af[nt] = mfma16(va, pack8(x), af[nt]); ab[nt] = mfma16(va, pack8(y), ab[nt]); }
    }
    float* U = (float*)(p.ws + WS_B + B_U);
    float* uf = U + ((size_t)(0 * 16 + bh) * NCC + cc) * 8192; float* ub = U + ((size_t)(1 * 16 + bh) * NCC + cc) * 8192;
#pragma unroll
    for (int nt = 0; nt < 4; ++nt)
#pragma unroll
        for (int j = 0; j < 4; ++j) { const int v = 16 * w + 4 * fq + j, d = 16 * nt + fr; uf[v * 64 + d] = af[nt][j]; ub[v * 64 + d] = ab[nt][j]; }
}
__device__ __forceinline__ void phase_retU(const Params& p) {
    const int lane = otid() & 63, gw = blockIdx.x * 8 + (otid() >> 6), NW = gridDim.x * 8;
    for (int it = gw; it < 16 * NCC * 8; it += NW) retU_item(p, it, lane);
}
__device__ __forceinline__ void phase_scan(const Params& p) {
    const float* U = (const float*)(p.ws + WS_B + B_U); bf16_t* S = (bf16_t*)(p.ws + WS_B + B_S);
    for (int i = blockIdx.x * 512 + otid(); i < 2 * 16 * 8192; i += gridDim.x * 512) {
        const int e = i & 8191, bh = (i >> 13) & 15, dir = i >> 17, h = bh & 3;
        const float G = exp2f(128.0f * log2_decay(dir ? p.in[13][h] : p.in[12][h]));
        const float* u = U + (size_t)(dir * 16 + bh) * NCC * 8192 + e; bf16_t* s = S + (size_t)(dir * 16 + bh) * NCHUNK * 8192 + e;
        if (dir == 0) { float st = u[0] * G + u[8192];
#pragma unroll 8
            for (int c = 0; c < NCHUNK; ++c) { s[(size_t)c * 8192] = f2bf(st); st = st * G + u[(size_t)(2 + c) * 8192]; }
        } else { float st = u[0] + G * u[8192];
#pragma unroll 8
            for (int c = NCHUNK - 1; c >= 0; --c) { s[(size_t)c * 8192] = f2bf(st); st = st * G + u[(size_t)(2 + c) * 8192]; } }
    }
}
constexpr int RO_KP = 144, RO_VP = 272, RO_SP = 144, RO_V_OFF = 128 * RO_KP, RO_S_OFF = RO_V_OFF + 128 * RO_VP;
__device__ __forceinline__ void retO_item(const Params& p, int bh, int c, int w, int lane, const LAS unsigned char* lds) {
    const int b = bh >> 2, h = bh & 3;
    const int fr = lane & 15, fq = lane >> 4;
    const float lgf = log2_decay(p.in[12][h]), lgb = log2_decay(p.in[13][h]);
    const bf16_t* proj = (const bf16_t*)(p.ws + WS_B + B_PROJ);
    const int tok0 = b * SEQ + c * 128, qi = 16 * w + fr, tokq = tok0 + qi;
    u32x4 qf[2];
#pragma unroll
    for (int ks = 0; ks < 2; ++ks) qf[ks] = *(const u32x4*)(proj + (size_t)tokq * INW + C_RQ + h * 64 + ks * 32 + fq * 8);
    const int kkrow = 8 * (fr >> 2) + (fr & 3);
    u32x4 pf[4];
#pragma unroll
    for (int kb = 0; kb < 4; ++kb) { float e[8];
#pragma unroll
        for (int t = 0; t < 2; ++t) { const LAS unsigned char* kp = lds + (32 * kb + kkrow + 4 * t) * RO_KP + fq * 16;
            const u32x4 k0 = *(const LAS u32x4*)kp, k1 = *(const LAS u32x4*)(kp + 64);
            f32x4 a = mfma16(k0, qf[0], (f32x4){0.f, 0.f, 0.f, 0.f}); a = mfma16(k1, qf[1], a);
#pragma unroll
            for (int j = 0; j < 4; ++j) { const int kj = 32 * kb + 8 * fq + 4 * t + j, df = qi - kj;
                const float dec = df > 0 ? exp2f((float)df * lgf) : (df < 0 ? exp2f((float)(-df) * lgb) : 2.0f);
                e[t * 4 + j] = a[j] * dec; } }
        pf[kb] = pack8(e); }
    f32x4 o[8];
#pragma unroll
    for (int vt = 0; vt < 8; ++vt) o[vt] = (f32x4){0.f, 0.f, 0.f, 0.f};
#pragma unroll
    for (int kb = 0; kb < 4; ++kb)
#pragma unroll
        for (int vt = 0; vt < 8; ++vt) { const u32x4 vf = *(const LAS u32x4*)(lds + RO_V_OFF + (vt * 16 + fr) * RO_VP + (32 * kb + 8 * fq) * 2);
            o[vt] = mfma16(vf, pf[kb], o[vt]); }
    const float xif = exp2f((float)(qi + 1) * lgf), xib = exp2f((float)(128 - qi) * lgb);
#pragma unroll
    for (int dir = 0; dir < 2; ++dir) { const float xi = dir ? xib : xif; const LAS unsigned char* sp = lds + RO_S_OFF + dir * 128 * RO_SP;
#pragma unroll
        for (int ks = 0; ks < 2; ++ks) { float x[8]; unpack8(qf[ks], x);
#pragma unroll
            for (int e = 0; e < 8; ++e) x[e] *= xi;
            const u32x4 qs = pack8(x);
#pragma unroll
            for (int vt = 0; vt < 8; ++vt) { const u32x4 sf = *(const LAS u32x4*)(sp + (vt * 16 + fr) * RO_SP + ks * 64 + fq * 16); o[vt] = mfma16(sf, qs, o[vt]); } } }
    float ss = 0.f;
#pragma unroll
    for (int vt = 0; vt < 8; ++vt)
#pragma unroll
        for (int j = 0; j < 4; ++j) ss += o[vt][j] * o[vt][j];
    ss += __shfl_xor(ss, 16); ss += __shfl_xor(ss, 32);
    const float rstd = rsqrtf(ss * (1.0f / 128.0f) + EPS);
    const bf16_t* rg = proj + (size_t)tokq * INW + C_RG + h * 128; bf16_t* mix = (bf16_t*)(p.ws + WS_B + B_MIXIN) + (size_t)tokq * D + 512 + h * 128;
#pragma unroll
    for (int vt = 0; vt < 8; ++vt) { const u32x2 gw2 = *(const u32x2*)(rg + vt * 16 + 4 * fq);
        const float g0 = silu_f(bflo(gw2.x)), g1 = silu_f(bfhi(gw2.x)), g2 = silu_f(bflo(gw2.y)), g3 = silu_f(bfhi(gw2.y));
        *(u32x2*)(mix + vt * 16 + 4 * fq) = (u32x2){pk2(o[vt][0] * rstd * g0, o[vt][1] * rstd * g1), pk2(o[vt][2] * rstd * g2, o[vt][3] * rstd * g3)}; }
}
__device__ __forceinline__ void phase_retO(const Params& p, LAS unsigned char* lds) {
    const int tid = otid(), lane = tid & 63, wid = tid >> 6;
    const bf16_t* rkr = (const bf16_t*)(p.ws + WS_B + B_RKR); const bf16_t* retvt = (const bf16_t*)(p.ws + WS_B + B_RETVT); const bf16_t* S = (const bf16_t*)(p.ws + WS_B + B_S);
    for (int u = blockIdx.x; u < 16 * 64; u += gridDim.x) { const int c = u & 63, bh = u >> 6, b = bh >> 2, h = bh & 3;
        __syncthreads();
        for (int i = tid; i < 1024; i += 512) { const int r = i >> 3, ck = i & 7;
            *(LAS u32x4*)(lds + r * RO_KP + ck * 16) = *(const u32x4*)(rkr + (size_t)(b * SEQ + c * 128 + r) * 256 + h * 64 + ck * 8); }
        for (int i = tid; i < 2048; i += 512) { const int r = i >> 4, ck = i & 15;
            *(LAS u32x4*)(lds + RO_V_OFF + r * RO_VP + ck * 16) = *(const u32x4*)(retvt + (size_t)(b * 512 + h * 128 + r) * SEQ + c * 128 + ck * 8); }
        for (int i = tid; i < 2048; i += 512) { const int dir = i >> 10, r = (i >> 3) & 127, ck = i & 7;
            *(LAS u32x4*)(lds + RO_S_OFF + (dir * 128 + r) * RO_SP + ck * 16) = *(const u32x4*)(S + ((size_t)(dir * 16 + bh) * NCHUNK + c) * 8192 + r * 64 + ck * 8); }
        __syncthreads();
        retO_item(p, bh, c, wid, lane, lds);
    }
}

__device__ __forceinline__ void phase_combine(const Params& p) {
    const int lane = otid() & 63, gw = blockIdx.x * 8 + (otid() >> 6), NW = gridDim.x * 8;
    const bf16_t* Y = (const bf16_t*)(p.ws + WS_B + B_Y); const int* toks = (const int*)(p.ws + WS_TOKS); const float* ada = (const float*)(p.ws + WS_ADA1);
    for (int r0 = gw * 4; r0 < T; r0 += NW * 4) { const int b = r0 >> 13; const float* gf = ada + b * 6144 + 5 * 1024;
        int s0[4], s1[4];
#pragma unroll
        for (int r = 0; r < 4; ++r) { s0[r] = toks[2 * (r0 + r)]; s1[r] = toks[2 * (r0 + r) + 1]; }
        f32x4 x[4][4]; u32x2 ya[4][4], yb[4][4];
#pragma unroll
        for (int r = 0; r < 4; ++r)
#pragma unroll
            for (int j = 0; j < 4; ++j) { const int c = 4 * lane + 256 * j; x[r][j] = *(const f32x4*)(p.out + (size_t)(r0 + r) * D + c);
                ya[r][j] = *(const u32x2*)(Y + (size_t)s0[r] * D + c); yb[r][j] = *(const u32x2*)(Y + (size_t)s1[r] * D + c); }
#pragma unroll
        for (int j = 0; j < 4; ++j) { const int c = 4 * lane + 256 * j; const f32x4 g = *(const f32x4*)(gf + c);
#pragma unroll
            for (int r = 0; r < 4; ++r) { const u32x2 a = ya[r][j], bb = yb[r][j];
                f32x4 y = (f32x4){bflo(a.x) + bflo(bb.x), bfhi(a.x) + bfhi(bb.x), bflo(a.y) + bflo(bb.y), bfhi(a.y) + bfhi(bb.y)};
                if (DBG_MASK & 16) y = (f32x4){0.f, 0.f, 0.f, 0.f};
                *(f32x4*)(p.out + (size_t)(r0 + r) * D + c) = x[r][j] + g * y; } } }
}

constexpr int NPHASE = 21;
#define XB_TMO      128
#define XB_XCNT(j)  (256  + 64 * (j))
#define XB_XSUB(j)  (1280 + 64 * (j))
#define XB_XGEN(j)  (2304 + 64 * (j))
#define XB_TOP      3328
#define XB_TOPGEN   3392
#define XCD_BAR_WORDS 3456
#define XB_SPIN_CAP (1u << 22)
__device__ __forceinline__ unsigned xb_ld(unsigned* p)              { return __hip_atomic_load(p, __ATOMIC_RELAXED, __HIP_MEMORY_SCOPE_AGENT); }
__device__ __forceinline__ unsigned xb_add(unsigned* p, unsigned v) { return __hip_atomic_fetch_add(p, v, __ATOMIC_RELAXED, __HIP_MEMORY_SCOPE_AGENT); }
__device__ __forceinline__ unsigned xb_xcc_id() { return (unsigned)__builtin_amdgcn_s_getreg((3 << 11) | 20) & 0xFu; }
#define XB_SPIN(cond, bar) do { unsigned _sp = 0; while (cond) { __builtin_amdgcn_s_sleep(1); \
    if ((++_sp & 255u) == 0u) { if (xb_ld(&(bar)[XB_TMO])) break; if (_sp > XB_SPIN_CAP) { atomicAdd(&(bar)[XB_TMO], 1u); break; } } } } while (0)
struct XcdBarrier { unsigned* bar; unsigned x; volatile LAS unsigned* st; };
__device__ __forceinline__ XcdBarrier xcd_barrier_post(unsigned* bar, volatile LAS unsigned* st) {
    XcdBarrier b; b.bar = bar; b.x = xb_xcc_id(); b.st = st;
    if (threadIdx.x == 0) (void)xb_add(&bar[XB_XCNT(b.x)], 1u);
    return b;
}
__device__ __forceinline__ void xcd_barrier_complete(unsigned* bar, unsigned x, unsigned& nloc, unsigned& nx) {
    const unsigned G = gridDim.x * gridDim.y * gridDim.z;
    unsigned sum, cnt, mine, sp = 0u;
    for (;;) {
        sum = 0u; cnt = 0u; mine = 0u;
#pragma unroll
        for (unsigned j = 0; j < 16; ++j) { const unsigned c = xb_ld(&bar[XB_XCNT(j)]); sum += c; cnt += (c > 0u) ? 1u : 0u; mine = (j == x) ? c : mine; }
        if (sum == G) break;
        __builtin_amdgcn_s_sleep(1);
        if ((++sp & 255u) == 0u) { if (xb_ld(&bar[XB_TMO])) break; if (sp > XB_SPIN_CAP) { atomicAdd(&bar[XB_TMO], 1u); break; } }
    }
    nloc = mine > 0u ? mine : 1u; nx = cnt > 0u ? cnt : 1u;
}
__device__ __forceinline__ void xcd_barrier(const XcdBarrier& b) {
    asm volatile("s_waitcnt vmcnt(0) lgkmcnt(0)" ::: "memory");
    __syncthreads();
    if (threadIdx.x == 0) {
        unsigned* bar = b.bar;
        __builtin_amdgcn_s_waitcnt(0);
        unsigned nloc = b.st[0], nx = b.st[1];
        if (nloc == 0u) { xcd_barrier_complete(bar, b.x, nloc, nx); b.st[0] = nloc; b.st[1] = nx; }
        const unsigned old = xb_add(&bar[XB_XSUB(b.x)], 1u);
        const unsigned gen = old / nloc;
        if (old + 1u == (gen + 1u) * nloc) {
            __builtin_amdgcn_fence(__ATOMIC_RELEASE, "agent");
            asm volatile("s_waitcnt vmcnt(0)" ::: "memory");
            const unsigned og = xb_add(&bar[XB_TOP], 1u);
            const unsigned tg = og / nx;
            if (og + 1u == (tg + 1u) * nx) xb_add(&bar[XB_TOPGEN], 1u);
            else XB_SPIN(xb_ld(&bar[XB_TOPGEN]) == tg, bar);
            __builtin_amdgcn_fence(__ATOMIC_ACQUIRE, "agent");
            xb_add(&bar[XB_XGEN(b.x)], 1u);
            asm volatile("s_waitcnt vmcnt(0)" ::: "memory");
        } else {
            XB_SPIN(xb_ld(&bar[XB_XGEN(b.x)]) == gen, bar);
            __builtin_amdgcn_fence(__ATOMIC_ACQUIRE, "agent");
            asm volatile("s_waitcnt vmcnt(0)" ::: "memory");
        }
    }
    __syncthreads();
}
__global__ void __launch_bounds__(512, 2) mega(Params p) {
    extern __shared__ __attribute__((aligned(16))) unsigned char shm[];
    LAS unsigned char* lds = (LAS unsigned char*)shm;
    const int G = gridDim.x, c = blockIdx.x;
    const float* ada0 = (const float*)(p.ws + WS_ADA0); const float* ada1 = (const float*)(p.ws + WS_ADA1);
    unsigned char* B = p.ws + WS_B;
    unsigned* bar = (unsigned*)(p.ws + WS_BAR);
    volatile LAS unsigned* xst = (volatile LAS unsigned*)(lds + LDS_GEMM + 256);
    if (threadIdx.x == 0) { xst[0] = 0u; xst[1] = 0u; }
    __syncthreads();
    XcdBarrier xb = xcd_barrier_post(bar, xst);
    constexpr size_t TS = (size_t)256 * D * 2;
#ifndef PHASE_MASK
#define PHASE_MASK 0x1FFFFF
#endif
#ifndef DUP_MASK
#define DUP_MASK 0
#endif
#define PH(k) for (int rep_ = 0; rep_ < 1 + ((DUP_MASK >> (k)) & 1); ++rep_) { if (((PHASE_MASK >> (k)) & 1) && p.ph_lo <= (k) && (k) < p.ph_hi)
#define SYNC(k) if (((k) + 1 < p.ph_hi || rep_ == 0 && ((DUP_MASK >> (k)) & 1)) && p.ph_lo <= (k)) { xcd_barrier(xb); } }
    if (p.ph_hi < 0) cg::this_grid().sync();
    PH(0) { phase0(p, lds); } SYNC(0)
#ifdef EXTRA_BAR
    for (int xi = 0; xi < EXTRA_BAR; ++xi) xcd_barrier(xb);
#endif
    PH(1) { phase_norm(p, p.in[0], p.in[4], ada0, 0, true); } SYNC(1)
    PH(2) { g8::InProjSched S{(const char*)(p.ws + WS_H), (const char*)(p.ws + WS_HX), (const char*)(p.ws + WS_WT_IN), G, c};
            g8::EpiStoreBf16 E{(bf16_t*)(B + B_PROJ), (bf16_t*)(B + B_PROJX), INW, KVW, 0, 1.0f, true};
            g8::gemm_phase<g8::EpiStoreBf16, g8::InProjSched, false>(lds, D * 2, D * 2, D * 2, S, E, nullptr, 0); } SYNC(2)
    PH(3) { phase3(p, lds); } SYNC(3)
    PH(4) { phase_retU(p); } SYNC(4)
    PH(5) { phase_scan(p); na_range(p, 0, 256, lds); } SYNC(5)
    PH(6) { phase_retO(p, lds); } SYNC(6)
    PH(7) { g8::DenseSched S{(const char*)(B + B_MIXIN), (const char*)(p.ws + WS_WT_OUT), 0, 0, TS, TS, 128, 4, 1, G, c};
            g8::EpiResid E{p.out, p.in[0], ada0 + 2 * 1024, false, 1.0f};
            g8::gemm_phase<g8::EpiResid, g8::DenseSched, false>(lds, D * 2, D * 2, D * 2, S, E, nullptr, 0); } SYNC(7)
    PH(8) { phase_norm(p, p.out, p.in[5], ada0, 3, false, USE_FP8_FFN != 0); } SYNC(8)
    PH(9) {
#if USE_FP8_FFN
            g8::DenseSched S{(const char*)(p.ws + WS_H), (const char*)(p.ws + WS_WT_GU), 0, 0, TS / 2, TS / 2, 128, 22, 1, G, c};
            g8::EpiSwiglu8 E{B + B_ACT, FFN, DESCALE8};
            g8::gemm_phase<g8::EpiSwiglu8, g8::DenseSched, false, true>(lds, D, D, D, S, E, nullptr, 0); } SYNC(9)
#else
            g8::DenseSched S{(const char*)(p.ws + WS_H), (const char*)(p.ws + WS_WT_GU), 0, 0, TS, TS, 128, 22, 1, G, c};
#if USE_FP8_FFN2
            g8::EpiSwiglu8 E{B + B_ACT, FFN, 1.0f};
            g8::gemm_phase<g8::EpiSwiglu8, g8::DenseSched, false>(lds, D * 2, D * 2, D * 2, S, E, nullptr, 0); } SYNC(9)
#else
            g8::EpiSwiglu E{(bf16_t*)(B + B_ACT), FFN};
            g8::gemm_phase<g8::EpiSwiglu, g8::DenseSched, false>(lds, D * 2, D * 2, D * 2, S, E, nullptr, 0); } SYNC(9)
#endif
#endif

    PH(10) {
#if USE_FP8_FFN || USE_FP8_FFN2
             g8::DenseSched S{(const char*)(B + B_ACT), (const char*)(p.ws + WS_WT_DOWN), 0, 0, (size_t)256 * FFN, (size_t)256 * FFN, 128, 4, 1, G, c};
             g8::EpiResid E{p.out, p.out, ada0 + 5 * 1024, (DBG_MASK & 4) != 0, DESCALE8};
             g8::gemm_phase<g8::EpiResid, g8::DenseSched, false, true>(lds, FFN, FFN, FFN, S, E, nullptr, 0); } SYNC(10)
#else
             g8::DenseSched S{(const char*)(B + B_ACT), (const char*)(p.ws + WS_WT_DOWN), 0, 0, (size_t)256 * FFN * 2, (size_t)256 * FFN * 2, 128, 4, 1, G, c};
             g8::EpiResid E{p.out, p.out, ada0 + 5 * 1024, (DBG_MASK & 4) != 0, 1.0f};
             g8::gemm_phase<g8::EpiResid, g8::DenseSched, false>(lds, FFN * 2, FFN * 2, FFN * 2, S, E, nullptr, 0); } SYNC(10)
#endif

    PH(11) { phase_norm(p, p.out, p.in[17], ada1, 0, false); } SYNC(11)
    PH(12) { g8::FourASched S{(const char*)(p.ws + WS_WC2), (const char*)(p.ws + WS_H), G, c};
             g8::EpiFA2 E{(bf16_t*)(B + B_ZT)};
             g8::gemm_phase<g8::EpiFA2, g8::FourASched, false>(lds, 256, 256, 64 * D * 2, S, E, nullptr, (size_t)D * 2); } SYNC(12)
    PH(13) { g8::DenseSched S{(const char*)(p.ws + WS_M1), (const char*)(B + B_ZT), 0, 0, 0, (size_t)256 * 256 * 2, 1, 1024, 1, G, c};
             g8::EpiFB1 E{(bf16_t*)(B + B_T2), (const float*)(p.ws + WS_TW)};
             g8::gemm_phase<g8::EpiFB1, g8::DenseSched, false>(lds, 512, 512, 512, S, E, nullptr, 0); } SYNC(13)
    PH(14) { g8::DenseSched S{(const char*)(p.ws + WS_M3), (const char*)(B + B_T2), 0, 0, 0, (size_t)256 * 512 * 2, 1, 512, 1, G, c};
             g8::EpiFB3 E{(bf16_t*)(B + B_FOUR), 1.0f / 1024.0f};
             g8::gemm_phase<g8::EpiFB3, g8::DenseSched, false>(lds, 1024, 1024, 1024, S, E, nullptr, 0); } SYNC(14)
    PH(15) { g8::DenseSched S{(const char*)(B + B_FOUR), (const char*)(p.ws + WS_WT_FOUR), 0, 0, TS, TS, 128, 4, 1, G, c};
             g8::EpiResid E{p.out, p.out, ada1 + 2 * 1024, (DBG_MASK & 8) != 0, 1.0f};
             g8::gemm_phase<g8::EpiResid, g8::DenseSched, false>(lds, D * 2, D * 2, D * 2, S, E, nullptr, 0); } SYNC(15)
    PH(16) { phase_norm_router(p, lds); } SYNC(16)
    PH(17) { phase_slots(p, lds); } SYNC(17)
    PH(18) { int pe[8];
#pragma unroll
             for (int e = 0; e < 8; ++e) pe[e] = ((const int*)(p.ws + WS_BAR))[3500 + e];
#if USE_FP8
             g8::MoeSched S{(const char*)(B + B_H8S), (const char*)(p.ws + WS_WT_EGU), (size_t)2 * EDIM * D, D, D, pe[7], 28, G, c, pe[0], pe[1], pe[2], pe[3], pe[4], pe[5], pe[6], pe[7], false};
             g8::EpiSwiglu8 E{B + B_ACTE, EDIM, DESCALE8};
             g8::gemm_phase<g8::EpiSwiglu8, g8::MoeSched, false, true>(lds, D, D, D, S, E, nullptr, 0); } SYNC(18)
#else
             g8::MoeSched S{(const char*)(p.ws + WS_H), (const char*)(p.ws + WS_WT_EGU), (size_t)2 * EDIM * D * 2, D * 2, D * 2, pe[7], 28, G, c, pe[0], pe[1], pe[2], pe[3], pe[4], pe[5], pe[6], pe[7], true};
             g8::EpiSwiglu E{(bf16_t*)(B + B_ACTE), EDIM};
             g8::gemm_phase<g8::EpiSwiglu, g8::MoeSched, true>(lds, D * 2, D * 2, D * 2, S, E, (const int*)(p.ws + WS_SLTOK), 0); } SYNC(18)
#endif

    PH(19) { int pe[8];
#pragma unroll
             for (int e = 0; e < 8; ++e) pe[e] = ((const int*)(p.ws + WS_BAR))[3500 + e];
#if USE_FP8
             g8::MoeSched S{(const char*)(B + B_ACTE), (const char*)(p.ws + WS_WT_EDOWN), (size_t)D * EDIM, EDIM, EDIM, pe[7], 4, G, c, pe[0], pe[1], pe[2], pe[3], pe[4], pe[5], pe[6], pe[7], false};
             g8::EpiMoeDown E{(bf16_t*)(B + B_Y), (const float*)(p.ws + WS_SLGATE)};
             g8::gemm_phase<g8::EpiMoeDown, g8::MoeSched, false, true>(lds, EDIM, EDIM, EDIM, S, E, nullptr, 0); } SYNC(19)
#else
             g8::MoeSched S{(const char*)(B + B_ACTE), (const char*)(p.ws + WS_WT_EDOWN), (size_t)D * EDIM * 2, EDIM * 2, EDIM * 2, pe[7], 4, G, c, pe[0], pe[1], pe[2], pe[3], pe[4], pe[5], pe[6], pe[7], false};
             g8::EpiMoeDown E{(bf16_t*)(B + B_Y), (const float*)(p.ws + WS_SLGATE)};
             g8::gemm_phase<g8::EpiMoeDown, g8::MoeSched, false>(lds, EDIM * 2, EDIM * 2, EDIM * 2, S, E, nullptr, 0); } SYNC(19)
#endif

    PH(20) { phase_combine(p); } }
#ifdef PROBE_PH
    if (p.ph_lo == 30) { const bf16_t* src = (const bf16_t*)(p.ws + (size_t)(PROBE_OFF));
        for (size_t i = (size_t)blockIdx.x * 512 + threadIdx.x; i < (size_t)T * D; i += (size_t)gridDim.x * 512) p.out[i] = i < (size_t)(PROBE_N) ? __uint_as_float(((unsigned)src[i]) << 16) : 0.f; }
#endif
#undef PH
#undef SYNC
}

extern "C" void kernel_launch(void* const* d_in, const int* in_sizes, int n_in, void* d_out, int out_size, void* d_ws, size_t ws_size, hipStream_t stream) {
    static int grid = 0;
    if (grid == 0) {
        if (n_in != 25 || out_size != T * D || ws_size < WS_END) { fprintf(stderr, "kernel_launch: unexpected shapes (n_in %d out %d ws %zu need %zu)\n", n_in, out_size, ws_size, (size_t)WS_END); grid = -1; return; }
        int dev = 0, cus = 0, per_cu = 0;
        hipGetDevice(&dev); hipDeviceGetAttribute(&cus, hipDeviceAttributeMultiprocessorCount, dev);
        if (hipFuncSetAttribute((const void*)mega, hipFuncAttributeMaxDynamicSharedMemorySize, LDS_TOTAL) != hipSuccess) { fprintf(stderr, "kernel_launch: hipFuncSetAttribute failed\n"); grid = -1; return; }
        if (hipOccupancyMaxActiveBlocksPerMultiprocessor(&per_cu, (const void*)mega, 512, LDS_TOTAL) != hipSuccess || per_cu < 1) { fprintf(stderr, "kernel_launch: occupancy query failed (%d)\n", per_cu); per_cu = 1; (void)hipGetLastError(); }
        grid = cus * per_cu; if (grid > 256) grid = 256;
    }
    if (grid < 0) return;
    Params p{};
    for (int i = 0; i < 25; ++i) p.in[i] = (const float*)d_in[i];
    p.out = (float*)d_out; p.ws = (unsigned char*)d_ws;
    (void)hipMemsetAsync((unsigned char*)d_ws + WS_BAR, 0, 16384, stream);
#if MK_SPLIT
#ifdef PROBE_PH
    for (int ph = 0; ph < PROBE_PH; ++ph) { p.ph_lo = ph; p.ph_hi = ph + 1; hipLaunchKernelGGL(mega, dim3(grid), dim3(512), LDS_TOTAL, stream, p); }
    p.ph_lo = 30; p.ph_hi = 31; hipLaunchKernelGGL(mega, dim3(grid), dim3(512), LDS_TOTAL, stream, p);
    return;
#endif
    for (int ph = 0; ph < NPHASE; ++ph) { p.ph_lo = ph; p.ph_hi = ph + 1; hipLaunchKernelGGL(mega, dim3(grid), dim3(512), LDS_TOTAL, stream, p); }
#else
    p.ph_lo = 0; p.ph_hi = NPHASE;
    void* args[] = {&p};
    hipError_t e = hipLaunchCooperativeKernel((const void*)mega, dim3(grid), dim3(512), args, LDS_TOTAL, stream);
    if (e != hipSuccess) fprintf(stderr, "cooperative launch failed: %s (grid %d)\n", hipGetErrorString(e), grid);
#endif
}
```

```cpp
#include <hip/hip_runtime.h>
#include <hip/hip_cooperative_groups.h>
#include <cstdio>
#include <cstdint>
namespace cg = cooperative_groups;

#ifndef MK_SPLIT
#define MK_SPLIT 0
#endif
#ifndef DBG_MASK
#define DBG_MASK 0
#endif

#define FP8_DIAG 0
#define USE_FP8 1
#define USE_FP8_FFN2 1
#define USE_FP8_FFN 0
#define LAS __attribute__((address_space(3)))
typedef unsigned short bf16_t;
typedef short bf16x8 __attribute__((ext_vector_type(8)));
typedef float f32x4 __attribute__((ext_vector_type(4)));
typedef float f32x2 __attribute__((ext_vector_type(2)));
typedef unsigned u32x4 __attribute__((ext_vector_type(4)));
typedef unsigned u32x2 __attribute__((ext_vector_type(2)));

constexpr int D = 1024, NBATCH = 4, SEQ = 8192, T = NBATCH * SEQ, CTXL = 256, TX = NBATCH * CTXL;
constexpr int INW = 3072, KVW = 1792;
constexpr int C_NAQ = 0, C_RQ = 512, C_RG = 768, C_NAK = 1280, C_NAV = 1792, C_RK = 2304, C_RV = 2560;
constexpr int X_NAK = 0, X_NAV = 512, X_RK = 1024, X_RV = 1280;
constexpr int FFN = 2816, NE = 8, EDIM = 3584;
constexpr int MOE_TILES = 264, NSLOTS = MOE_TILES * 256;
constexpr int NCHUNK = 64, NCC = 66;
constexpr float EPS = 1e-6f;

constexpr size_t AL(size_t x) { return (x + 255) & ~(size_t)255; }
constexpr size_t WS_WT_IN = 0;
constexpr size_t WS_WT_OUT = WS_WT_IN + (size_t)INW * D * 2;
constexpr size_t WS_WT_GU = WS_WT_OUT + (size_t)D * D * 2;
constexpr size_t WS_WT_DOWN = WS_WT_GU + (size_t)2 * FFN * D * 2;
constexpr size_t WS_WT_FOUR = WS_WT_DOWN + (size_t)D * FFN * 2;
constexpr size_t WS_WT_EGU = WS_WT_FOUR + (size_t)D * D * 2;
constexpr size_t WS_WT_EDOWN = WS_WT_EGU + (size_t)NE * 2 * EDIM * D * 2;
constexpr size_t WS_WC = WS_WT_EDOWN + (size_t)NE * D * EDIM * 2;
constexpr size_t WS_WC2 = WS_WC + (size_t)2048 * 1024 * 2;
constexpr size_t WS_M1 = WS_WC2 + (size_t)256 * 128 * 2;
constexpr size_t WS_M3 = WS_M1 + (size_t)256 * 256 * 2;
constexpr size_t WS_TW = WS_M3 + (size_t)256 * 512 * 2;
constexpr size_t WS_BAR = WS_TW + (size_t)128 * 64 * 8;
constexpr size_t WS_ADA0 = WS_BAR + 16384;
constexpr size_t WS_ADA1 = WS_ADA0 + AL(5 * 6144 * 4);
constexpr size_t WS_HIST = WS_ADA1 + AL(4 * 6144 * 4);
constexpr size_t WS_TOKE = WS_HIST + AL(256 * 8 * 4);
constexpr size_t WS_TOKG = WS_TOKE + AL((size_t)T * 4);
constexpr size_t WS_TOKS = WS_TOKG + AL((size_t)T * 8);
constexpr size_t WS_SLTOK = WS_TOKS + AL((size_t)T * 8);
constexpr size_t WS_SLGATE = WS_SLTOK + AL((size_t)NSLOTS * 4);
constexpr size_t WS_H = WS_SLGATE + AL((size_t)NSLOTS * 4);
constexpr size_t WS_HX = WS_H + (size_t)T * D * 2;
constexpr size_t WS_B = WS_HX + (size_t)TX * D * 2;
constexpr size_t B_PROJ = 0;
constexpr size_t B_ACT = 0;
constexpr size_t B_PROJX = B_PROJ + (size_t)T * INW * 2;
constexpr size_t B_MIXIN = B_PROJX + (size_t)TX * KVW * 2;
constexpr size_t B_U = B_MIXIN + (size_t)T * D * 2;
constexpr size_t B_S = B_U + (size_t)2 * 16 * NCC * 8192 * 4;
constexpr size_t B_NAVT = B_S + (size_t)2 * 16 * NCHUNK * 8192 * 2;
constexpr size_t B_RETVT = B_NAVT + (size_t)NBATCH * 512 * SEQ * 2;
constexpr size_t B_RETKT = B_RETVT + (size_t)NBATCH * 512 * SEQ * 2;
constexpr size_t B_RKR = B_RETKT + (size_t)NBATCH * 256 * SEQ * 2;
constexpr size_t B_NAVXT = B_RKR + (size_t)T * 256 * 2;
constexpr size_t B_RETVXT = B_NAVXT + (size_t)NBATCH * 512 * CTXL * 2;
constexpr size_t B_RETKXT = B_RETVXT + (size_t)NBATCH * 512 * CTXL * 2;
constexpr size_t B_L0_END = B_RETKXT + (size_t)NBATCH * 256 * CTXL * 2;
constexpr size_t B_ZT = 0;
constexpr size_t B_T2 = B_ZT + (size_t)NBATCH * 2048 * SEQ * 2;
constexpr size_t B_FOUR = B_T2 + (size_t)NBATCH * 2048 * SEQ * 2;
constexpr size_t B_F_END = B_FOUR + (size_t)T * D * 2;
constexpr size_t B_ACTE = 0;
constexpr size_t B_H8S = (size_t)256 << 20;
constexpr size_t B_Y = B_ACTE + (size_t)NSLOTS * EDIM * 2;
constexpr size_t B_M_END = B_Y + (size_t)NSLOTS * D * 2;
constexpr size_t BMAX1 = B_L0_END > B_F_END ? B_L0_END : B_F_END;
constexpr size_t WS_END = WS_B + (BMAX1 > B_M_END ? BMAX1 : B_M_END);

constexpr int LDS_GEMM = 131072, LDS_TOTAL = LDS_GEMM + 512;

struct Params {
    const float* in[25];
    float* out;
    unsigned char* ws;
    int ph_lo, ph_hi;
};

typedef __bf16 bf16x2_t __attribute__((ext_vector_type(2)));
__device__ __forceinline__ unsigned pk2(float lo, float hi) { const f32x2 v = {lo, hi}; const bf16x2_t r = __builtin_convertvector(v, bf16x2_t); return __builtin_bit_cast(unsigned, r); }
__device__ __forceinline__ float bflo(unsigned w) { return __uint_as_float(w << 16); }
__device__ __forceinline__ float bfhi(unsigned w) { return __uint_as_float(w & 0xffff0000u); }
__device__ __forceinline__ bf16_t f2bf(float f) { return (bf16_t)(pk2(f, 0.f) & 0xffffu); }
__device__ __forceinline__ float wave_sum(float v) {
#pragma unroll
    for (int o = 1; o < 64; o <<= 1) v += __shfl_xor(v, o);
    return v;
}
__device__ __forceinline__ float silu_f(float g) { return g * __builtin_amdgcn_rcpf(1.0f + __expf(-g)); }
__device__ __forceinline__ f32x4 mfma16(u32x4 a, u32x4 b, f32x4 c) {
    return __builtin_amdgcn_mfma_f32_16x16x32_bf16(__builtin_bit_cast(bf16x8, a), __builtin_bit_cast(bf16x8, b), c, 0, 0, 0);
}
__device__ __forceinline__ void lds_add(LAS int* p, int v) { __hip_atomic_fetch_add((int*)p, v, __ATOMIC_RELAXED, __HIP_MEMORY_SCOPE_WORKGROUP); }
__device__ __forceinline__ void unpack8(const u32x4 w, float (&x)[8]) {
    x[0] = bflo(w.x); x[1] = bfhi(w.x); x[2] = bflo(w.y); x[3] = bfhi(w.y); x[4] = bflo(w.z); x[5] = bfhi(w.z); x[6] = bflo(w.w); x[7] = bfhi(w.w);
}
__device__ __forceinline__ u32x4 pack8(const float (&x)[8]) { return (u32x4){pk2(x[0], x[1]), pk2(x[2], x[3]), pk2(x[4], x[5]), pk2(x[6], x[7])}; }
__device__ __forceinline__ int otid() { int t = threadIdx.x; asm volatile("" : "+v"(t)); return t; }
typedef int i32x8 __attribute__((ext_vector_type(8)));
typedef int u32x4i __attribute__((ext_vector_type(4)));
__device__ __forceinline__ float clamp448(float x) { return __builtin_amdgcn_fmed3f(x, -448.0f, 448.0f); }
__device__ __forceinline__ unsigned pk4_fp8(float a, float b, float c, float d) {
    int w = 0; w = __builtin_amdgcn_cvt_pk_fp8_f32(clamp448(a), clamp448(b), w, false); w = __builtin_amdgcn_cvt_pk_fp8_f32(clamp448(c), clamp448(d), w, true); return (unsigned)w; }
constexpr float S_W8 = 64.0f, S_A8 = 4.0f, DESCALE8 = 1.0f / (S_W8 * S_A8);
#define LDS_WAIT() asm volatile("s_waitcnt lgkmcnt(0)" ::: "memory")

namespace g8 {
constexpr int BM = 256, BK = 64, HALF = 128, HTB = HALF * BK * 2, NXCD = 8, WGM = 8;
__device__ __forceinline__ int lds_byte(int r, int c) { const int st = (r >> 4) * 2 + (c >> 5), rr = r & 15, cc = c & 31, ob = rr * 64 + cc * 2; return st * 1024 + (ob ^ (((ob >> 9) & 1) << 5)); }
__device__ __forceinline__ void stage_rc(int b, int& R, int& C) { const int st = b / 1024, sb = b % 1024, swz = sb ^ (((sb >> 9) & 1) << 5); R = (st >> 1) * 16 + swz / 64; C = (st & 1) * 32 + (swz % 64) / 2; }
__device__ __forceinline__ int perm32(int rho) { const int n = rho >> 4, i = rho & 15; return 8 * (i >> 2) + 4 * n + (i & 3); }

struct Unit { const char* A; const char* B; int pm, pn, z; };

__device__ __forceinline__ void remap(int w, int nM, int nN, int& pm, int& pn) {
    const int nwg = nM * nN; int wgid = w;
    { const int q = nwg / NXCD, r = nwg % NXCD, xcd = wgid % NXCD, off = wgid / NXCD; wgid = (xcd < r ? xcd * (q + 1) : r * (q + 1) + (xcd - r) * q) + off; }
    const int nig = WGM * nN, gid = wgid / nig, fm = gid * WGM, gsz = (nM - fm) < WGM ? (nM - fm) : WGM;
    pm = fm + ((wgid % nig) % gsz); pn = (wgid % nig) / gsz;
}

struct DenseSched {
    const char* A; const char* B; size_t azs, bzs, aps, bps; int nM, nN, nz, G, c;
    __device__ __forceinline__ bool next(int i, Unit& u) const {
        const long L = (long)i * G + c; const int per = nM * nN; if (L >= (long)per * nz) return false;
        const int z = (int)(L / per), w = (int)(L % per); int pm, pn; remap(w, nM, nN, pm, pn);
        u.pm = pm; u.pn = pn; u.z = z; u.A = A + z * azs + (size_t)pm * aps; u.B = B + z * bzs + (size_t)pn * bps; return true;
    }
};
struct InProjSched {
    const char* H; const char* HX; const char* W; int G, c;
    __device__ __forceinline__ bool next(int i, Unit& u) const {
        const long L = (long)i * G + c; const int n0 = 128 * 12;
        if (L < n0) { int pm, pn; remap((int)L, 128, 12, pm, pn); u.pm = pm; u.pn = pn; u.z = 0; u.A = H + (size_t)pm * 256 * D * 2; u.B = W + (size_t)pn * 256 * D * 2; return true; }
        const int w = (int)(L - n0); if (w >= 28) return false;
        u.pm = w / 7; u.pn = w % 7; u.z = 1; u.A = HX + (size_t)u.pm * 256 * D * 2; u.B = W + (size_t)(1280 + u.pn * 256) * D * 2; return true;
    }
};
struct FourASched {
    const char* A; const char* H; int G, c;
    __device__ __forceinline__ bool next(int i, Unit& u) const {
        const long L = (long)i * G + c; if (L >= 1024) return false;
        const int pn = (int)(L & 31), g = (int)((L >> 5) & 7), b = (int)(L >> 8);
        u.pm = 0; u.pn = pn; u.z = b * 8 + g; u.A = A; u.B = H + (size_t)b * SEQ * D * 2 + (size_t)pn * 2 * D * 2 + g * 256; return true;
    }
};
struct MoeSched {
    const char* A; const char* W; size_t wes; int lda, ldb, nM, nN, G, c; int pe0, pe1, pe2, pe3, pe4, pe5, pe6, pe7; bool gather;
    __device__ __forceinline__ bool next(int i, Unit& u) const {
        const long L = (long)i * G + c; if (L >= (long)nM * nN) return false;
        int pm, pn; remap((int)L, nM, nN, pm, pn);
        const int e = (pm >= pe0) + (pm >= pe1) + (pm >= pe2) + (pm >= pe3) + (pm >= pe4) + (pm >= pe5) + (pm >= pe6);
        u.pm = pm; u.pn = pn; u.z = e; u.A = gather ? A : A + (size_t)pm * 256 * lda; u.B = W + e * wes + (size_t)pn * 256 * ldb; return true;
    }
};

template <class Epi, class Sched, bool GATHER, bool FP8 = false>
__device__ __forceinline__ void gemm_phase(LAS unsigned char* lds, const int K_, const int lda, const int ldb, const Sched& S, const Epi& E, const int* __restrict__ rowidx, const size_t hstepB_) {
    int tid = threadIdx.x; asm volatile("" : "+v"(tid));
    const int wid = __builtin_amdgcn_readfirstlane(tid >> 6), lane = tid & 63, wr = wid >> 2, wc = wid & 3, fr = lane & 15, fq = lane >> 4;
    int K = K_; asm volatile("" : "+s"(K));
    const int nt = K / (BK * 2);
    int Rr[2], Cc[2]; unsigned voffB[2];
#pragma unroll
    for (int i = 0; i < 2; ++i) { int R, C; stage_rc(tid * 16 + i * 8192, R, C); const int Rb = Epi::PERM ? ((R & ~31) + perm32(R & 31)) : R;
        Rr[i] = R; Cc[i] = C; voffB[i] = (unsigned)(Rb * ldb + C * 2); }
    const size_t kstep = (size_t)(BK * 2);
    const size_t hstepB = hstepB_ ? hstepB_ : (size_t)HALF * ldb;
    const unsigned ldsw = (unsigned)wid * 1024u;
    const int aoff = lds_byte(wr * 64 + fr, fq * 8), boff = lds_byte(wc * 32 + fr, fq * 8);
#define G8_SA(b, h) (((b) * 2 + (h)) * HTB)
#define G8_SB(b, h) ((4 + (b) * 2 + (h)) * HTB)
#define G8_STAGE(bufoff, gbase, voff) do { _Pragma("unroll") for (int _i = 0; _i < 2; ++_i) \
        __builtin_amdgcn_global_load_lds((const unsigned*)((const char*)(gbase) + (voff)[_i]), (LAS unsigned*)(lds + (bufoff) + ldsw + _i * 8192), 16, 0, 0); } while (0)
#define G8_LDA(dst, b, h) do { _Pragma("unroll") for (int m = 0; m < 4; ++m) { const u32x4i l_ = *(const LAS u32x4i*)(lds + G8_SA(b, h) + aoff + m * 2048), h_ = *(const LAS u32x4i*)(lds + G8_SA(b, h) + aoff + m * 2048 + 1024); \
        dst[m] = __builtin_shufflevector(l_, h_, 0, 1, 2, 3, 4, 5, 6, 7); } } while (0)
#define G8_LDB(dst, b, h) do { _Pragma("unroll") for (int n = 0; n < 2; ++n) { const u32x4i l_ = *(const LAS u32x4i*)(lds + G8_SB(b, h) + boff + n * 2048), h_ = *(const LAS u32x4i*)(lds + G8_SB(b, h) + boff + n * 2048 + 1024); \
        dst[n] = __builtin_shufflevector(l_, h_, 0, 1, 2, 3, 4, 5, 6, 7); } } while (0)
#define G8_LO(v) __builtin_bit_cast(bf16x8, __builtin_shufflevector(v, v, 0, 1, 2, 3))
#define G8_HI(v) __builtin_bit_cast(bf16x8, __builtin_shufflevector(v, v, 4, 5, 6, 7))
#define G8_MMA(ai, bj, At, Bt) do { __builtin_amdgcn_s_setprio(1); _Pragma("unroll") for (int m = 0; m < 4; ++m) _Pragma("unroll") for (int n = 0; n < 2; ++n) { \
        if constexpr (FP8) { if (FP8_DIAG) { typedef long l4 __attribute__((ext_vector_type(4))); const l4 bb = __builtin_bit_cast(l4, Bt[n]), aa = __builtin_bit_cast(l4, At[m]); \
            _Pragma("unroll") for (int q = 0; q < 4; ++q) acc[ai][bj][m][n] = __builtin_amdgcn_mfma_f32_16x16x32_fp8_fp8(bb[q], aa[q], acc[ai][bj][m][n], 0, 0, 0); } \
          else asm volatile("v_mfma_f32_16x16x128_f8f6f4 %0, %1, %2, %0" : "+v"(acc[ai][bj][m][n]) : "v"(Bt[n]), "v"(At[m])); } \
        else { acc[ai][bj][m][n] = __builtin_amdgcn_mfma_f32_16x16x32_bf16(G8_LO(Bt[n]), G8_LO(At[m]), acc[ai][bj][m][n], 0, 0, 0); \
               acc[ai][bj][m][n] = __builtin_amdgcn_mfma_f32_16x16x32_bf16(G8_HI(Bt[n]), G8_HI(At[m]), acc[ai][bj][m][n], 0, 0, 0); } } \
        __builtin_amdgcn_s_setprio(0); } while (0)
#define G8_WAIT_V(n) asm volatile("s_waitcnt vmcnt(" #n ")" ::: "memory")
#define G8_WAIT_L(n) asm volatile("s_waitcnt lgkmcnt(" #n ")" ::: "memory")
#define G8_BAR __builtin_amdgcn_s_barrier()
#define G8_SCHED __builtin_amdgcn_sched_barrier(0)
    Unit cur, nxt; int ui = 0;
    if (!S.next(0, cur)) return;
    unsigned ca[2][2], na[2][2];
#pragma unroll
    for (int h = 0; h < 2; ++h)
#pragma unroll
        for (int i = 0; i < 2; ++i) {
            if constexpr (GATHER) ca[h][i] = (unsigned)rowidx[cur.pm * 256 + h * 128 + Rr[i]] * (unsigned)lda + (unsigned)(Cc[i] * 2);
            else ca[h][i] = (unsigned)((h * 128 + Rr[i]) * lda + Cc[i] * 2);
            na[h][i] = ca[h][i];
        }
    f32x4 acc[2][2][4][2];
#pragma unroll
    for (int a = 0; a < 2; ++a)
#pragma unroll
        for (int b = 0; b < 2; ++b)
#pragma unroll
            for (int m = 0; m < 4; ++m)
#pragma unroll
                for (int n = 0; n < 2; ++n) acc[a][b][m][n] = (f32x4){0.f, 0.f, 0.f, 0.f};
    i32x8 At[4], B0[2], B1[2];
    const char* cA = cur.A; const char* cB = cur.B;
    G8_STAGE(G8_SB(0, 0), cB, voffB); G8_STAGE(G8_SB(0, 1), cB + hstepB, voffB); G8_STAGE(G8_SA(0, 0), cA, ca[0]); G8_STAGE(G8_SA(0, 1), cA, ca[1]);
    if (wr == 1) G8_BAR;
    G8_WAIT_V(2); G8_BAR;
    G8_STAGE(G8_SB(1, 0), cB + kstep, voffB); G8_STAGE(G8_SA(1, 0), cA + kstep, ca[0]); G8_STAGE(G8_SB(1, 1), cB + hstepB + kstep, voffB);
    G8_WAIT_V(6); G8_BAR;
    for (;;) {
        const bool has_next = S.next(ui + 1, nxt);
        const char* nA = has_next ? nxt.A : cA; const char* nB = has_next ? nxt.B : cB;
        if constexpr (GATHER) {
            if (has_next) {
#pragma unroll
                for (int h = 0; h < 2; ++h)
#pragma unroll
                    for (int i = 0; i < 2; ++i) na[h][i] = (unsigned)rowidx[nxt.pm * 256 + h * 128 + Rr[i]] * (unsigned)lda + (unsigned)(Cc[i] * 2);
            }
        }
        for (int t = 0; t < nt; t += 2) {
            const bool last = (t == nt - 2);
            const char* a1 = cA + (size_t)(t + 1) * kstep;
            const char* a2 = last ? nA : cA + (size_t)(t + 2) * kstep; const char* b2 = last ? nB : cB + (size_t)(t + 2) * kstep;
            const char* a3 = a2 + kstep; const char* b3 = b2 + kstep;
            unsigned o2[2][2];
#pragma unroll
            for (int h = 0; h < 2; ++h)
#pragma unroll
                for (int i = 0; i < 2; ++i) { if constexpr (GATHER) o2[h][i] = last ? na[h][i] : ca[h][i]; else o2[h][i] = ca[h][i]; }
            G8_LDB(B0, 0, 0); G8_LDB(B1, 0, 1); G8_SCHED; G8_LDA(At, 0, 0); G8_STAGE(G8_SA(1, 1), a1, ca[1]);
            G8_WAIT_V(8); G8_WAIT_L(0); G8_BAR; G8_MMA(0, 0, At, B0); G8_MMA(0, 1, At, B1); G8_BAR; G8_SCHED;
            G8_LDA(At, 0, 1); G8_STAGE(G8_SB(0, 0), b2, voffB); G8_STAGE(G8_SB(0, 1), b2 + hstepB, voffB); G8_STAGE(G8_SA(0, 0), a2, o2[0]);
            G8_WAIT_V(8); G8_WAIT_L(0); G8_BAR; G8_MMA(1, 0, At, B0); G8_MMA(1, 1, At, B1); G8_BAR; G8_SCHED;
            G8_LDB(B0, 1, 0); G8_LDB(B1, 1, 1); G8_SCHED; G8_LDA(At, 1, 0); G8_STAGE(G8_SA(0, 1), a2, o2[1]);
            G8_WAIT_V(8); G8_WAIT_L(0); G8_BAR; G8_MMA(0, 0, At, B0); G8_MMA(0, 1, At, B1); G8_BAR; G8_SCHED;
            G8_LDA(At, 1, 1); G8_STAGE(G8_SB(1, 0), b3, voffB); G8_STAGE(G8_SB(1, 1), b3 + hstepB, voffB); G8_STAGE(G8_SA(1, 0), a3, o2[0]);
            G8_WAIT_V(8); G8_WAIT_L(0); G8_BAR; G8_MMA(1, 0, At, B0); G8_MMA(1, 1, At, B1); G8_BAR; G8_SCHED;
        }
        if (wr == 0) G8_BAR;
        E(acc, cur, wr, wc, fr, fq);
        if (!has_next) break;
#pragma unroll
        for (int a = 0; a < 2; ++a)
#pragma unroll
            for (int b = 0; b < 2; ++b)
#pragma unroll
                for (int m = 0; m < 4; ++m)
#pragma unroll
                    for (int n = 0; n < 2; ++n) acc[a][b][m][n] = (f32x4){0.f, 0.f, 0.f, 0.f};
        cur = nxt; cA = nA; cB = nB; ++ui;
        if (wr == 1) G8_BAR;
        if constexpr (GATHER) {
#pragma unroll
            for (int h = 0; h < 2; ++h)
#pragma unroll
                for (int i = 0; i < 2; ++i) ca[h][i] = na[h][i];
        }
    }
    G8_WAIT_V(0);
    G8_BAR;
#undef G8_SA
#undef G8_SB
#undef G8_STAGE
#undef G8_LDA
#undef G8_LDB
#undef G8_LO
#undef G8_HI
#undef G8_MMA
#undef G8_WAIT_V
#undef G8_WAIT_L
#undef G8_BAR
#undef G8_SCHED
}

struct EpiStoreBf16 {
    static constexpr bool PERM = true;
    bf16_t* O0; bf16_t* O1; int ldc0, ldc1; size_t zs; float scale; bool inproj;
    __device__ __forceinline__ void operator()(const f32x4 (&acc)[2][2][4][2], const Unit& u, int wr, int wc, int fr, int fq) const {
        bf16_t* base; int ldc;
        if (inproj) { base = u.z ? O1 : O0; ldc = u.z ? ldc1 : ldc0; } else { base = O0 + u.z * zs; ldc = ldc0; }
        const int row0 = u.pm * BM + wr * 64 + fr, col0 = u.pn * BM + wc * 32 + 8 * fq;
#pragma unroll
        for (int ai = 0; ai < 2; ++ai)
#pragma unroll
            for (int m = 0; m < 4; ++m) { bf16_t* rowp = base + (size_t)(row0 + ai * HALF + m * 16) * ldc + col0;
#pragma unroll
                for (int bj = 0; bj < 2; ++bj) { const f32x4 v0 = acc[ai][bj][m][0] * scale, v1 = acc[ai][bj][m][1] * scale;
                    u32x4 w; w.x = pk2(v0[0], v0[1]); w.y = pk2(v0[2], v0[3]); w.z = pk2(v1[0], v1[1]); w.w = pk2(v1[2], v1[3]);
                    *(u32x4*)(rowp + bj * HALF) = w; } }
    }
};
struct EpiResid {
    static constexpr bool PERM = false;
    float* out; const float* resid; const float* gate; bool zero; float ascale;
    __device__ __forceinline__ void operator()(const f32x4 (&acc)[2][2][4][2], const Unit& u, int wr, int wc, int fr, int fq) const {
        const int row0 = u.pm * BM + wr * 64 + fr, col0 = u.pn * BM + wc * 32 + 4 * fq;
        const float* gp = gate + (size_t)(row0 >> 13) * 6144 + col0;
        f32x4 gv[2][2];
#pragma unroll
        for (int bj = 0; bj < 2; ++bj)
#pragma unroll
            for (int n = 0; n < 2; ++n) { gv[bj][n] = *(const f32x4*)(gp + bj * HALF + n * 16) * ascale; if (zero) gv[bj][n] = (f32x4){0.f, 0.f, 0.f, 0.f}; }
#pragma unroll
        for (int ai = 0; ai < 2; ++ai)
#pragma unroll
            for (int m = 0; m < 4; ++m) { const size_t ro = (size_t)(row0 + ai * HALF + m * 16) * D + col0;
#pragma unroll
                for (int bj = 0; bj < 2; ++bj)
#pragma unroll
                    for (int n = 0; n < 2; ++n) { const f32x4 r = *(const f32x4*)(resid + ro + bj * HALF + n * 16);
                        *(f32x4*)(out + ro + bj * HALF + n * 16) = r + gv[bj][n] * acc[ai][bj][m][n]; } }
    }
};
struct EpiSwiglu {
    static constexpr bool PERM = true;
    bf16_t* O; int ldc;
    __device__ __forceinline__ void operator()(const f32x4 (&acc)[2][2][4][2], const Unit& u, int wr, int wc, int fr, int fq) const {
        const int row0 = u.pm * BM + wr * 64 + fr, col0 = u.pn * HALF + wc * 32 + 8 * fq;
#pragma unroll
        for (int ai = 0; ai < 2; ++ai)
#pragma unroll
            for (int m = 0; m < 4; ++m) { bf16_t* rowp = O + (size_t)(row0 + ai * HALF + m * 16) * ldc + col0;
                float v[8];
#pragma unroll
                for (int n = 0; n < 2; ++n)
#pragma unroll
                    for (int j = 0; j < 4; ++j) v[n * 4 + j] = silu_f(acc[ai][0][m][n][j]) * acc[ai][1][m][n][j];
                u32x4 w; w.x = pk2(v[0], v[1]); w.y = pk2(v[2], v[3]); w.z = pk2(v[4], v[5]); w.w = pk2(v[6], v[7]);
                *(u32x4*)rowp = w; }
    }
};
struct EpiSwiglu8 {
    static constexpr bool PERM = true;
    unsigned char* O; int ldc; float dsc;
    __device__ __forceinline__ void operator()(const f32x4 (&acc)[2][2][4][2], const Unit& u, int wr, int wc, int fr, int fq) const {
        const int row0 = u.pm * BM + wr * 64 + fr, col0 = u.pn * HALF + wc * 32 + 8 * fq;
#pragma unroll
        for (int ai = 0; ai < 2; ++ai)
#pragma unroll
            for (int m = 0; m < 4; ++m) { unsigned char* rowp = O + (size_t)(row0 + ai * HALF + m * 16) * ldc + col0;
                float v[8];
#pragma unroll
                for (int n = 0; n < 2; ++n)
#pragma unroll
                    for (int j = 0; j < 4; ++j) v[n * 4 + j] = silu_f(acc[ai][0][m][n][j] * dsc) * (acc[ai][1][m][n][j] * (dsc * S_A8));
                *(u32x2*)rowp = (u32x2){pk4_fp8(v[0], v[1], v[2], v[3]), pk4_fp8(v[4], v[5], v[6], v[7])}; }
    }
};
struct EpiMoeDown {
    static constexpr bool PERM = true;
    bf16_t* Y; const float* sg;
    __device__ __forceinline__ void operator()(const f32x4 (&acc)[2][2][4][2], const Unit& u, int wr, int wc, int fr, int fq) const {
        const int row0 = u.pm * BM + wr * 64 + fr, col0 = u.pn * BM + wc * 32 + 8 * fq;
#pragma unroll
        for (int ai = 0; ai < 2; ++ai)
#pragma unroll
            for (int m = 0; m < 4; ++m) { const int row = row0 + ai * HALF + m * 16; const float g = sg[row] * (USE_FP8 ? DESCALE8 : 1.0f); bf16_t* rowp = Y + (size_t)row * D + col0;
#pragma unroll
                for (int bj = 0; bj < 2; ++bj) { const f32x4 v0 = acc[ai][bj][m][0] * g, v1 = acc[ai][bj][m][1] * g;
                    u32x4 w; w.x = pk2(v0[0], v0[1]); w.y = pk2(v0[2], v0[3]); w.z = pk2(v1[0], v1[1]); w.w = pk2(v1[2], v1[3]);
                    *(u32x4*)(rowp + bj * HALF) = w; } }
    }
};
struct EpiFA {
    static constexpr bool PERM = true;
    bf16_t* O;
    __device__ __forceinline__ void operator()(const f32x4 (&acc)[2][2][4][2], const Unit& u, int wr, int wc, int fr, int fq) const {
        const int row0 = u.pm * BM + wr * 64 + fr, n1 = wc * 32 + 8 * fq;
#pragma unroll
        for (int ai = 0; ai < 2; ++ai)
#pragma unroll
            for (int m = 0; m < 4; ++m) { const int r = row0 + ai * HALF + m * 16, ch = r >> 1, part = r & 1;
#pragma unroll
                for (int bj = 0; bj < 2; ++bj) { const int n2 = 2 * u.pn + bj; const f32x4 v0 = acc[ai][bj][m][0], v1 = acc[ai][bj][m][1];
                    u32x4 w; w.x = pk2(v0[0], v0[1]); w.y = pk2(v0[2], v0[3]); w.z = pk2(v1[0], v1[1]); w.w = pk2(v1[2], v1[3]);
                    *(u32x4*)(O + ((size_t)(u.z * 1024 + ch) * 64 + n2) * 256 + part * 128 + n1) = w; } }
    }
};
struct EpiFA2 {
    static constexpr bool PERM = true;
    bf16_t* O;
    __device__ __forceinline__ void operator()(const f32x4 (&acc)[2][2][4][2], const Unit& u, int wr, int wc, int fr, int fq) const {
        const int row0 = wr * 64 + fr, n1 = wc * 32 + 8 * fq, b = u.z >> 3, g = u.z & 7;
#pragma unroll
        for (int ai = 0; ai < 2; ++ai)
#pragma unroll
            for (int m = 0; m < 4; ++m) { const int r = row0 + ai * HALF + m * 16, ch = g * 128 + (r >> 1), part = r & 1;
#pragma unroll
                for (int bj = 0; bj < 2; ++bj) { const int n2 = 2 * u.pn + bj; const f32x4 v0 = acc[ai][bj][m][0], v1 = acc[ai][bj][m][1];
                    u32x4 w; w.x = pk2(v0[0], v0[1]); w.y = pk2(v0[2], v0[3]); w.z = pk2(v1[0], v1[1]); w.w = pk2(v1[2], v1[3]);
                    *(u32x4*)(O + ((size_t)(b * 1024 + ch) * 64 + n2) * 256 + part * 128 + n1) = w; } }
    }
};
struct EpiFB1 {
    static constexpr bool PERM = true;
    bf16_t* O; const float* tw;
    __device__ __forceinline__ void operator()(const f32x4 (&acc)[2][2][4][2], const Unit& u, int wr, int wc, int fr, int fq) const {
        const int n20 = (wc & 1) * 32 + 8 * fq;
#pragma unroll
        for (int m = 0; m < 4; ++m) { const int k1 = wr * 64 + m * 16 + fr;
#pragma unroll
            for (int n = 0; n < 2; ++n) {
                const float* tp = tw + (size_t)(k1 * 64 + n20 + 4 * n) * 2;
                const f32x4 t0 = *(const f32x4*)tp, t1 = *(const f32x4*)(tp + 4);
#pragma unroll
                for (int bj = 0; bj < 2; ++bj) { const int chg = u.pn * 4 + bj * 2 + (wc >> 1), b = chg >> 10, ch = chg & 1023;
                    const f32x4 R = acc[0][bj][m][n], I = acc[1][bj][m][n];
                    const float r0 = R[0] * t0[0] - I[0] * t0[1], i0 = R[0] * t0[1] + I[0] * t0[0], r1 = R[1] * t0[2] - I[1] * t0[3], i1 = R[1] * t0[3] + I[1] * t0[2];
                    const float r2 = R[2] * t1[0] - I[2] * t1[1], i2 = R[2] * t1[1] + I[2] * t1[0], r3 = R[3] * t1[2] - I[3] * t1[3], i3 = R[3] * t1[3] + I[3] * t1[2];
                    bf16_t* op = O + ((((size_t)(b * 32 + (k1 >> 2)) * 1024 + ch) * 4 + (k1 & 3)) * 2) * 64 + n20 + 4 * n;
                    *(u32x2*)op = (u32x2){pk2(r0, r1), pk2(r2, r3)}; *(u32x2*)(op + 64) = (u32x2){pk2(i0, i1), pk2(i2, i3)}; }
                __builtin_amdgcn_sched_barrier(0); } }
    }
};
struct EpiFB3 {
    static constexpr bool PERM = true;
    bf16_t* O; float scale;
    __device__ __forceinline__ void operator()(const f32x4 (&acc)[2][2][4][2], const Unit& u, int wr, int wc, int fr, int fq) const {
#pragma unroll
        for (int ai = 0; ai < 2; ++ai)
#pragma unroll
            for (int m = 0; m < 4; ++m) { const int k1sub = 2 * ai + wr, k2 = m * 16 + fr;
#pragma unroll
                for (int bj = 0; bj < 2; ++bj) { const int n = u.pn * BM + bj * HALF + wc * 32 + 8 * fq, ch = n & 1023, k1q = (n >> 10) & 31, b = n >> 15;
                    const f32x4 v0 = acc[ai][bj][m][0] * scale, v1 = acc[ai][bj][m][1] * scale;
                    u32x4 w; w.x = pk2(v0[0], v0[1]); w.y = pk2(v0[2], v0[3]); w.z = pk2(v1[0], v1[1]); w.w = pk2(v1[2], v1[3]);
                    *(u32x4*)(O + (size_t)(b * SEQ + 4 * k1q + k1sub + 128 * k2) * D + ch) = w; } }
    }
};
}

__device__ __forceinline__ void wtrans_tile(const float* __restrict__ W, int N, int k0, int n0, bf16_t* __restrict__ WT, int K, int dstrow0, LAS bf16_t* scr, int lane) {
#pragma unroll 4
    for (int it = 0; it < 16; ++it) { const int kk = it * 4 + (lane >> 4), c4 = (lane & 15) * 4;
        const f32x4 v = *(const f32x4*)(W + (size_t)(k0 + kk) * N + n0 + c4);
        scr[(c4 + 0) * 72 + kk] = f2bf(v[0]); scr[(c4 + 1) * 72 + kk] = f2bf(v[1]); scr[(c4 + 2) * 72 + kk] = f2bf(v[2]); scr[(c4 + 3) * 72 + kk] = f2bf(v[3]); }
    LDS_WAIT();
#pragma unroll
    for (int it = 0; it < 8; ++it) { const int n = it * 8 + (lane >> 3), kc = (lane & 7) * 8;
        const u32x4 o = *(const LAS u32x4*)(scr + n * 72 + kc);
        *(u32x4*)(WT + (size_t)(dstrow0 + n) * K + k0 + kc) = o; }
    LDS_WAIT();
}
__device__ __forceinline__ void wtrans_tile8(const float* __restrict__ W, int N, int k0, int n0, unsigned char* __restrict__ WT, int K, int dstrow0, LAS unsigned char* scr, int lane) {
#pragma unroll 4
    for (int it = 0; it < 16; ++it) { const int kk = it * 4 + (lane >> 4), c4 = (lane & 15) * 4;
        const f32x4 v = *(const f32x4*)(W + (size_t)(k0 + kk) * N + n0 + c4) * S_W8;
        const unsigned w = pk4_fp8(v[0], v[1], v[2], v[3]);
        scr[(c4 + 0) * 80 + kk] = (unsigned char)(w & 0xff); scr[(c4 + 1) * 80 + kk] = (unsigned char)((w >> 8) & 0xff); scr[(c4 + 2) * 80 + kk] = (unsigned char)((w >> 16) & 0xff); scr[(c4 + 3) * 80 + kk] = (unsigned char)(w >> 24); }
    LDS_WAIT();
#pragma unroll
    for (int it = 0; it < 4; ++it) { const int n = it * 16 + (lane >> 2), kc = (lane & 3) * 16;
        const u32x4 o = *(const LAS u32x4*)(scr + n * 80 + kc);
        *(u32x4*)(WT + (size_t)(dstrow0 + n) * K + k0 + kc) = o; }
    LDS_WAIT();
}
__device__ __forceinline__ int gu_row(int n, int F) { const int part = n >= F, f = n - part * F; return (f >> 7) * 256 + part * 128 + (f & 127); }

__device__ __forceinline__ void phase0(const Params& p, LAS unsigned char* lds) {
    const int tid = otid(), lane = tid & 63, wid = tid >> 6, G = gridDim.x;
    {
        LAS float* sc = (LAS float*)lds;
        LAS float* red = sc + 5 * 1024;
        for (int item = blockIdx.x; item < 192; item += G) {
            const int layer = item / 96, cchunk = item % 96;
            const float* W = p.in[layer ? 19 : 6]; const float* bias = p.in[layer ? 20 : 7];
            __syncthreads();
            for (int i = tid; i < 5 * 1024; i += 512) { const int v = i >> 10, k = i & 1023; const float c = (v < 4) ? p.in[1][v * 1024 + k] : p.in[3][k]; sc[i] = c / (1.0f + __expf(-c)); }
            __syncthreads();
            const int col = cchunk * 64 + (tid & 63), kg = tid >> 6;
            float a0 = 0.f, a1 = 0.f, a2 = 0.f, a3 = 0.f, a4 = 0.f;
#pragma unroll 8
            for (int k = kg * 128; k < kg * 128 + 128; ++k) { const float w = W[(size_t)k * 6144 + col];
                a0 += sc[k] * w; a1 += sc[1024 + k] * w; a2 += sc[2048 + k] * w; a3 += sc[3072 + k] * w; a4 += sc[4096 + k] * w; }
            red[(kg * 5 + 0) * 64 + (tid & 63)] = a0; red[(kg * 5 + 1) * 64 + (tid & 63)] = a1; red[(kg * 5 + 2) * 64 + (tid & 63)] = a2;
            red[(kg * 5 + 3) * 64 + (tid & 63)] = a3; red[(kg * 5 + 4) * 64 + (tid & 63)] = a4;
            __syncthreads();
            if (tid < 320) { const int v = tid >> 6, cl = tid & 63; float s = 0.f;
#pragma unroll
                for (int g = 0; g < 8; ++g) s += red[(g * 5 + v) * 64 + cl];
                s += bias[cchunk * 64 + cl];
                if (layer == 0) ((float*)(p.ws + WS_ADA0))[v * 6144 + cchunk * 64 + cl] = s;
                else if (v < 4) ((float*)(p.ws + WS_ADA1))[v * 6144 + cchunk * 64 + cl] = s; }
        }
        __syncthreads();
    }
    {
        bf16_t* WC2 = (bf16_t*)(p.ws + WS_WC2);
        for (int i = blockIdx.x * 512 + tid; i < 256 * 128; i += G * 512) { const int r = i >> 7, c = i & 127, m = r >> 1, part = r & 1;
            float sv, cv; sincospif((float)((c * m) & 127) * (1.0f / 64.0f), &sv, &cv); WC2[i] = f2bf(part ? sv : cv); }
    }
    {
        bf16_t* M1 = (bf16_t*)(p.ws + WS_M1); bf16_t* M3 = (bf16_t*)(p.ws + WS_M3); float* TW = (float*)(p.ws + WS_TW);
        for (int i = blockIdx.x * 512 + tid; i < 256 * 256 + 256 * 512 + 128 * 64; i += G * 512) {
            if (i < 256 * 256) { const int r = i >> 8, kk = i & 255, k1 = r & 127, im = r >> 7, part = kk >> 7, n1 = kk & 127;
                float sv, cv; sincospif((float)((n1 * k1) & 127) * (1.0f / 64.0f), &sv, &cv);
                const float v = im == 0 ? (part == 0 ? cv : -sv) : (part == 0 ? sv : cv); M1[i] = f2bf(v);
            } else if (i < 256 * 256 + 256 * 512) { const int q = i - 256 * 256, r = q >> 9, kk = q & 511, k1s = r >> 6, k2 = r & 63, k1s2 = kk >> 7, part = (kk >> 6) & 1, n2 = kk & 63;
                float sv, cv; sincospif((float)((n2 * k2) & 63) * (1.0f / 32.0f), &sv, &cv);
                M3[q] = f2bf(k1s == k1s2 ? (part == 0 ? cv : -sv) : 0.f);
            } else { const int q = i - 256 * 256 - 256 * 512, k1 = q >> 6, n2 = q & 63;
                float sv, cv; sincospif((float)(n2 * k1) * (1.0f / 4096.0f), &sv, &cv); TW[2 * q] = cv; TW[2 * q + 1] = sv; }
        }
    }
    {
        LAS bf16_t* scr = (LAS bf16_t*)lds + wid * (64 * 72);
        constexpr int T_IN = 16 * 48, T_OUT = 16 * 16, T_GU = 16 * 88, T_DN = 44 * 16, T_FO = 16 * 16, T_EGU = 16 * 112, T_EDN = 56 * 16;
        constexpr int TOTAL = T_IN + T_OUT + T_GU + T_DN + T_FO + NE * T_EGU + NE * T_EDN;
        constexpr int NG = (TOTAL + 7) / 8;
        const int nb = blockIdx.x; const bool bal = (G == 256), spare = bal && nb >= 192;
        for (int rr = 0;; ++rr) {
            int grp; if (bal) { if (spare && rr < 4) grp = (nb - 192) * 4 + rr; else grp = 256 + (rr - (spare ? 4 : 0)) * 256 + nb; } else grp = rr * G + nb;
            if (grp >= NG) break;
            const int it = grp * 8 + wid; if (it >= TOTAL) continue;
            int r = it;
            if (r < T_IN) { const int kb = r / 48, nb = r % 48; wtrans_tile(p.in[8], INW, kb * 64, nb * 64, (bf16_t*)(p.ws + WS_WT_IN), D, nb * 64, scr, lane); continue; } r -= T_IN;
            if (r < T_OUT) { const int kb = r / 16, nb = r % 16; wtrans_tile(p.in[14], D, kb * 64, nb * 64, (bf16_t*)(p.ws + WS_WT_OUT), D, nb * 64, scr, lane); continue; } r -= T_OUT;
#if USE_FP8_FFN
            if (r < T_GU) { const int kb = r / 88, nb = r % 88; wtrans_tile8(p.in[15], 2 * FFN, kb * 64, nb * 64, p.ws + WS_WT_GU, D, gu_row(nb * 64, FFN), (LAS unsigned char*)scr, lane); continue; } r -= T_GU;
#else
            if (r < T_GU) { const int kb = r / 88, nb = r % 88; wtrans_tile(p.in[15], 2 * FFN, kb * 64, nb * 64, (bf16_t*)(p.ws + WS_WT_GU), D, gu_row(nb * 64, FFN), scr, lane); continue; } r -= T_GU;
#endif
#if USE_FP8_FFN || USE_FP8_FFN2
            if (r < T_DN) { const int kb = r / 16, nb = r % 16; wtrans_tile8(p.in[16], D, kb * 64, nb * 64, p.ws + WS_WT_DOWN, FFN, nb * 64, (LAS unsigned char*)scr, lane); continue; } r -= T_DN;
#else
            if (r < T_DN) { const int kb = r / 16, nb = r % 16; wtrans_tile(p.in[16], D, kb * 64, nb * 64, (bf16_t*)(p.ws + WS_WT_DOWN), FFN, nb * 64, scr, lane); continue; } r -= T_DN;
#endif
            if (r < T_FO) { const int kb = r / 16, nb = r % 16; wtrans_tile(p.in[21], D, kb * 64, nb * 64, (bf16_t*)(p.ws + WS_WT_FOUR), D, nb * 64, scr, lane); continue; } r -= T_FO;
            if (r < NE * T_EGU) { const int e = r / T_EGU, q = r % T_EGU, kb = q / 112, nb = q % 112;
#if USE_FP8
                wtrans_tile8(p.in[23] + (size_t)e * D * 2 * EDIM, 2 * EDIM, kb * 64, nb * 64, p.ws + WS_WT_EGU + (size_t)e * 2 * EDIM * D, D, gu_row(nb * 64, EDIM), (LAS unsigned char*)scr, lane); continue; } r -= NE * T_EGU;
#else
                wtrans_tile(p.in[23] + (size_t)e * D * 2 * EDIM, 2 * EDIM, kb * 64, nb * 64, (bf16_t*)(p.ws + WS_WT_EGU) + (size_t)e * 2 * EDIM * D, D, gu_row(nb * 64, EDIM), scr, lane); continue; } r -= NE * T_EGU;
#endif
            { const int e = r / T_EDN, q = r % T_EDN, kb = q / 16, nb = q % 16;
#if USE_FP8
                wtrans_tile8(p.in[24] + (size_t)e * EDIM * D, D, kb * 64, nb * 64, p.ws + WS_WT_EDOWN + (size_t)e * D * EDIM, EDIM, nb * 64, (LAS unsigned char*)scr, lane); }
#else
                wtrans_tile(p.in[24] + (size_t)e * EDIM * D, D, kb * 64, nb * 64, (bf16_t*)(p.ws + WS_WT_EDOWN) + (size_t)e * D * EDIM, EDIM, nb * 64, scr, lane); }
#endif
        }
    }
}

__device__ __forceinline__ void norm_row(const float* __restrict__ xr, const float* __restrict__ gain, const float* __restrict__ sh, const float* __restrict__ sc, bf16_t* __restrict__ orow, int lane, f32x4 (&hv)[4], bool f8 = false) {
    f32x4 v[4]; float s = 0.f;
#pragma unroll
    for (int j = 0; j < 4; ++j) { v[j] = *(const f32x4*)(xr + 4 * lane + 256 * j); s += (v[j][0] * v[j][0] + v[j][1] * v[j][1]) + (v[j][2] * v[j][2] + v[j][3] * v[j][3]); }
    const float rstd = rsqrtf(wave_sum(s) * (1.0f / D) + EPS);
#pragma unroll
    for (int j = 0; j < 4; ++j) { const f32x4 g = *(const f32x4*)(gain + 4 * lane + 256 * j), a = *(const f32x4*)(sh + 4 * lane + 256 * j), b = *(const f32x4*)(sc + 4 * lane + 256 * j);
        f32x4 h;
#pragma unroll
        for (int e = 0; e < 4; ++e) h[e] = (v[j][e] * rstd * g[e]) * (1.0f + b[e]) + a[e];
        hv[j] = h;
        if (f8) *(unsigned*)((unsigned char*)orow + 4 * lane + 256 * j) = pk4_fp8(h[0] * S_A8, h[1] * S_A8, h[2] * S_A8, h[3] * S_A8);
        else *(u32x2*)(orow + 4 * lane + 256 * j) = (u32x2){pk2(h[0], h[1]), pk2(h[2], h[3])}; }
}
template <int NR, bool ROUTER>
__device__ __forceinline__ void norm_rows4(const float* __restrict__ x0, const float* __restrict__ gain, const float* __restrict__ sh, const float* __restrict__ sc,
                                           unsigned char* __restrict__ o0, int opitch, bool f8, int lane, const LAS float* wr, float (&lg)[NR][8]) {
    f32x4 v[NR][4]; float rstd[NR];
#pragma unroll
    for (int r = 0; r < NR; ++r)
#pragma unroll
        for (int j = 0; j < 4; ++j) v[r][j] = *(const f32x4*)(x0 + (size_t)r * D + 4 * lane + 256 * j);
#pragma unroll
    for (int r = 0; r < NR; ++r) { float s = 0.f;
#pragma unroll
        for (int j = 0; j < 4; ++j) s += (v[r][j][0] * v[r][j][0] + v[r][j][1] * v[r][j][1]) + (v[r][j][2] * v[r][j][2] + v[r][j][3] * v[r][j][3]);
        rstd[r] = rsqrtf(wave_sum(s) * (1.0f / D) + EPS); }
    if (ROUTER) {
#pragma unroll
        for (int r = 0; r < NR; ++r)
#pragma unroll
            for (int e = 0; e < 8; ++e) lg[r][e] = 0.f; }
#pragma unroll
    for (int j = 0; j < 4; ++j) { const int c = 4 * lane + 256 * j;
        const f32x4 g = *(const f32x4*)(gain + c), a = *(const f32x4*)(sh + c), b = *(const f32x4*)(sc + c);
        f32x4 h[NR];
#pragma unroll
        for (int r = 0; r < NR; ++r) {
#pragma unroll
            for (int e = 0; e < 4; ++e) h[r][e] = (v[r][j][e] * rstd[r] * g[e]) * (1.0f + b[e]) + a[e];
            if (f8) *(unsigned*)(o0 + (size_t)r * opitch + c) = pk4_fp8(h[r][0] * S_A8, h[r][1] * S_A8, h[r][2] * S_A8, h[r][3] * S_A8);
            else *(u32x2*)(o0 + (size_t)r * opitch + 2 * c) = (u32x2){pk2(h[r][0], h[r][1]), pk2(h[r][2], h[r][3])}; }
        if (ROUTER) {
#pragma unroll
            for (int q = 0; q < 4; ++q) { const f32x4 w0 = *(const LAS f32x4*)(wr + (c + q) * 8), w1 = *(const LAS f32x4*)(wr + (c + q) * 8 + 4);
#pragma unroll
                for (int r = 0; r < NR; ++r) { const float hh = h[r][q];
                    lg[r][0] += hh * w0[0]; lg[r][1] += hh * w0[1]; lg[r][2] += hh * w0[2]; lg[r][3] += hh * w0[3]; lg[r][4] += hh * w1[0]; lg[r][5] += hh * w1[1]; lg[r][6] += hh * w1[2]; lg[r][7] += hh * w1[3]; } } } }
}
__device__ __forceinline__ void phase_norm(const Params& p, const float* X, const float* gain, const float* ada, int chunk_shift, bool with_ctx, bool f8 = false) {
    const int lane = otid() & 63, gw = blockIdx.x * 8 + (otid() >> 6), NW = gridDim.x * 8;
    unsigned char* H = p.ws + WS_H; const int opitch = f8 ? D : 2 * D;
    float lg[8][8];
    for (int r0 = gw * 8; r0 < T; r0 += NW * 8) { const int b = r0 >> 13;
        norm_rows4<8, false>(X + (size_t)r0 * D, gain, ada + b * 6144 + chunk_shift * 1024, ada + b * 6144 + (chunk_shift + 1) * 1024, H + (size_t)r0 * opitch, opitch, f8, lane, nullptr, lg); }
    if (with_ctx) { unsigned char* HX = p.ws + WS_HX;
        for (int r0 = gw * 8; r0 < TX; r0 += NW * 8) norm_rows4<8, false>(p.in[2] + (size_t)r0 * D, gain, ada + 4 * 6144, ada + 4 * 6144 + 1024, HX + (size_t)r0 * 2 * D, 2 * D, false, lane, nullptr, lg); }
}
__device__ __forceinline__ void phase_norm_router(const Params& p, LAS unsigned char* lds) {
    const int tid = otid(), lane = tid & 63, wid = tid >> 6;
    LAS float* wr = (LAS float*)lds;
    LAS int* hist = (LAS int*)(lds + 32768);
    for (int i = tid; i < 8192; i += 512) wr[i] = p.in[22][i];
    const float* X = p.out; const float* gain = p.in[18]; const float* ada = (const float*)(p.ws + WS_ADA1);
    unsigned char* H = p.ws + WS_H; const int opitch = USE_FP8 ? D : 2 * D;
    int* toke = (int*)(p.ws + WS_TOKE); f32x2* tokg = (f32x2*)(p.ws + WS_TOKG); int* histg = (int*)(p.ws + WS_HIST);
    for (int ch = blockIdx.x; ch < 256; ch += gridDim.x) {
        __syncthreads();
        if (tid < 8) hist[tid] = 0;
        __syncthreads();
        for (int rr = wid * 2; rr < 128; rr += 16) { const int row0 = ch * 128 + rr, b = row0 >> 13;
            float lg[2][8];
            norm_rows4<2, true>(X + (size_t)row0 * D, gain, ada + b * 6144 + 3 * 1024, ada + b * 6144 + 4 * 1024, H + (size_t)row0 * opitch, opitch, USE_FP8 != 0, lane, wr, lg);
#pragma unroll
            for (int r = 0; r < 2; ++r) {
#pragma unroll
                for (int e = 0; e < 8; ++e) lg[r][e] = wave_sum(lg[r][e]);
                int e0 = 0; float l0 = lg[r][0];
#pragma unroll
                for (int e = 1; e < 8; ++e) if (lg[r][e] > l0) { l0 = lg[r][e]; e0 = e; }
                int e1 = -1; float l1 = -3.0e38f;
#pragma unroll
                for (int e = 0; e < 8; ++e) if (e != e0 && lg[r][e] > l1) { l1 = lg[r][e]; e1 = e; }
                if (lane == 0) { const float ex = __expf(l1 - l0); const float g0 = 1.0f / (1.0f + ex);
                    toke[row0 + r] = e0 | (e1 << 8); tokg[row0 + r] = (f32x2){g0, ex * g0};
                    lds_add(&hist[e0], 1); lds_add(&hist[e1], 1); } }
        }
        __syncthreads();
        if (tid < 8) histg[ch * 8 + tid] = hist[tid];
    }
}

__device__ __forceinline__ void moe_totals(const Params& p, LAS int* tot  , LAS int* bef  , int ch) {
    const int tid = otid(); const int* histg = (const int*)(p.ws + WS_HIST);
    __syncthreads();
    if (tid < 8) { tot[tid] = 0; bef[tid] = 0; }
    __syncthreads();
    for (int i = tid; i < 2048; i += 512) { const int v = histg[i]; lds_add(&tot[i & 7], v); if ((i >> 3) < ch) lds_add(&bef[i & 7], v); }
    __syncthreads();
}
__device__ __forceinline__ void phase_slots(const Params& p, LAS unsigned char* lds) {
    const int tid = otid(), lane = tid & 63, wid = tid >> 6;
    LAS int* tot = (LAS int*)lds; LAS int* bef = tot + 8; LAS int* pst = bef + 8; LAS int* te = pst + 16; LAS int* sl = te + 128;
    const int* toke = (const int*)(p.ws + WS_TOKE); const f32x2* tokg = (const f32x2*)(p.ws + WS_TOKG);
    int* toks = (int*)(p.ws + WS_TOKS); int* sltok = (int*)(p.ws + WS_SLTOK); float* slg = (float*)(p.ws + WS_SLGATE);
    const unsigned char* H8 = p.ws + WS_H; unsigned char* H8S = p.ws + WS_B + B_H8S;
    for (int ch = blockIdx.x; ch < 256; ch += gridDim.x) {
        moe_totals(p, tot, bef, ch);
        if (tid == 0) { int s = 0; for (int e = 0; e < 8; ++e) { pst[e] = s; s += (tot[e] + 255) & ~255; if (ch == 0) ((int*)(p.ws + WS_BAR))[3500 + e] = s >> 8; } pst[8] = s; }
        if (tid < 128) te[tid] = toke[ch * 128 + tid];
        __syncthreads();
        if (tid < 8) { const int e = tid; int slot = pst[e] + bef[e];
            for (int i = 0; i < 128; ++i) { const int w = te[i], t = ch * 128 + i;
                if ((w & 255) == e) { sltok[slot] = t; slg[slot] = tokg[t][0]; toks[2 * t] = slot; sl[2 * i] = slot; ++slot; }
                if ((w >> 8) == e) { sltok[slot] = t; slg[slot] = tokg[t][1]; toks[2 * t + 1] = slot; sl[2 * i + 1] = slot; ++slot; } }
            if (ch == 255) { const int end = pst[e + 1]; for (; slot < end; ++slot) { sltok[slot] = 0; slg[slot] = 0.f; } } }
        __syncthreads();
#if USE_FP8
        for (int i = wid; i < 128; i += 8) { const u32x4 v = *(const u32x4*)(H8 + (size_t)(ch * 128 + i) * D + lane * 16);
            *(u32x4*)(H8S + (size_t)sl[2 * i] * D + lane * 16) = v; *(u32x4*)(H8S + (size_t)sl[2 * i + 1] * D + lane * 16) = v; }
#endif
    }
}

__device__ __forceinline__ void rope4(float (&x)[8], int head_pair0, int pos, float scale) {
    const float row = (float)(pos >> 6), col = (float)(pos & 63);
#pragma unroll
    for (int e = 0; e < 4; ++e) { const int pp = head_pair0 + e; const float base = pp < 16 ? row : col; const int f = pp & 15;
        const float inv = exp2f(-(float)f * (13.287712379549449f / 16.0f));
        float sn, cs; sincosf(base * inv, &sn, &cs);
        const float x1 = x[2 * e], x2 = x[2 * e + 1]; x[2 * e] = (x1 * cs - x2 * sn) * scale; x[2 * e + 1] = (x1 * sn + x2 * cs) * scale; }
}
__device__ __forceinline__ void headnorm_store(const u32x4 w, bf16_t* ptr, const float* gain, int lane) {
    float x[8]; unpack8(w, x);
    float s = 0.f;
#pragma unroll
    for (int e = 0; e < 8; ++e) s += x[e] * x[e];
    s += __shfl_xor(s, 1); s += __shfl_xor(s, 2); s += __shfl_xor(s, 4);
    const float rstd = rsqrtf(s * (1.0f / 64.0f) + EPS);
    const f32x4 g0 = *(const f32x4*)(gain + (lane & 7) * 8), g1 = *(const f32x4*)(gain + (lane & 7) * 8 + 4);
#pragma unroll
    for (int e = 0; e < 4; ++e) { x[e] = x[e] * rstd * g0[e]; x[4 + e] = x[4 + e] * rstd * g1[e]; }
    *(u32x4*)(ptr + lane * 8) = pack8(x);
}
__device__ __forceinline__ void headnorm_inplace(bf16_t* ptr, const float* gain, int lane) { headnorm_store(*(const u32x4*)(ptr + lane * 8), ptr, gain, lane); }
__device__ __forceinline__ void btrans_tile(const bf16_t* __restrict__ src, int lds_, bf16_t* __restrict__ dst, int ldd, int dstrow0, int dstcol0, int mode, int pos0, LAS bf16_t* scr, int lane) {
#pragma unroll 2
    for (int it = 0; it < 8; ++it) { const int rr = it * 8 + (lane >> 3), ck = lane & 7;
        u32x4 w = *(const u32x4*)(src + (size_t)rr * lds_ + ck * 8);
        if (mode) { float x[8]; unpack8(w, x);
            if (mode == 2) rope4(x, ck * 4, pos0 + rr, 0.125f);
            else {
#pragma unroll
                for (int e = 0; e < 8; ++e) x[e] *= 0.125f; }
            w = pack8(x); }
        const int c0 = ck * 8;
        scr[(c0 + 0) * 72 + rr] = (bf16_t)(w.x & 0xffff); scr[(c0 + 1) * 72 + rr] = (bf16_t)(w.x >> 16);
        scr[(c0 + 2) * 72 + rr] = (bf16_t)(w.y & 0xffff); scr[(c0 + 3) * 72 + rr] = (bf16_t)(w.y >> 16);
        scr[(c0 + 4) * 72 + rr] = (bf16_t)(w.z & 0xffff); scr[(c0 + 5) * 72 + rr] = (bf16_t)(w.z >> 16);
        scr[(c0 + 6) * 72 + rr] = (bf16_t)(w.w & 0xffff); scr[(c0 + 7) * 72 + rr] = (bf16_t)(w.w >> 16); }
    LDS_WAIT();
#pragma unroll
    for (int it = 0; it < 8; ++it) { const int c = it * 8 + (lane >> 3), rc = (lane & 7) * 8;
        const u32x4 o = *(const LAS u32x4*)(scr + c * 72 + rc);
        *(u32x4*)(dst + (size_t)(dstrow0 + c) * ldd + dstcol0 + rc) = o; }
    LDS_WAIT();
}
__device__ __forceinline__ void phase3(const Params& p, LAS unsigned char* lds) {
    const int lane = otid() & 63, wid = otid() >> 6, gw = blockIdx.x * 8 + wid, NW = gridDim.x * 8;
    bf16_t* proj = (bf16_t*)(p.ws + WS_B + B_PROJ); bf16_t* projx = (bf16_t*)(p.ws + WS_B + B_PROJX);
    bf16_t* rkr = (bf16_t*)(p.ws + WS_B + B_RKR);
    const float* qg = p.in[9]; const float* kg = p.in[10];
    for (int row0 = gw * 4; row0 < T; row0 += NW * 4) {
        u32x4 wq[4], wk[4], wr_[4];
#pragma unroll
        for (int r = 0; r < 4; ++r) { const bf16_t* pr = proj + (size_t)(row0 + r) * INW; const int l5 = lane & 31;
            wq[r] = *(const u32x4*)(pr + C_NAQ + lane * 8); wk[r] = *(const u32x4*)(pr + C_NAK + lane * 8); wr_[r] = *(const u32x4*)(pr + (lane < 32 ? C_RQ : C_RK) + l5 * 8); }
#pragma unroll
        for (int r = 0; r < 4; ++r) { bf16_t* pr = proj + (size_t)(row0 + r) * INW; const int pos = (row0 + r) & (SEQ - 1), l5 = lane & 31;
            headnorm_store(wq[r], pr + C_NAQ, qg, lane); headnorm_store(wk[r], pr + C_NAK, kg, lane);
            float x[8]; unpack8(wr_[r], x);
            rope4(x, (l5 & 7) * 4, pos, lane < 32 ? 1.0f : 0.125f);
            bf16_t* dstp = lane < 32 ? pr + C_RQ + l5 * 8 : rkr + (size_t)(row0 + r) * 256 + l5 * 8;
            *(u32x4*)dstp = pack8(x); }
    }
    for (int row = gw; row < TX; row += NW) headnorm_inplace(projx + (size_t)row * KVW + X_NAK, kg, lane);
    LAS bf16_t* scr = (LAS bf16_t*)lds + wid * (64 * 72);
    bf16_t* navt = (bf16_t*)(p.ws + WS_B + B_NAVT); bf16_t* retvt = (bf16_t*)(p.ws + WS_B + B_RETVT); bf16_t* retkt = (bf16_t*)(p.ws + WS_B + B_RETKT);
    bf16_t* navxt = (bf16_t*)(p.ws + WS_B + B_NAVXT); bf16_t* retvxt = (bf16_t*)(p.ws + WS_B + B_RETVXT); bf16_t* retkxt = (bf16_t*)(p.ws + WS_B + B_RETKXT);
    constexpr int NT_L = 512 * 20, NT_X = 16 * 20;
    for (int it = gw; it < NT_L + NT_X; it += NW) {
        if (it < NT_L) { const int tt = it / 20, ct = it % 20, b = tt >> 7, n0 = (tt & 127) * 64; const bf16_t* srow = proj + (size_t)tt * 64 * INW;
            if (ct < 8) btrans_tile(srow + C_NAV + ct * 64, INW, navt, SEQ, b * 512 + ct * 64, n0, 0, 0, scr, lane);
            else if (ct < 16) btrans_tile(srow + C_RV + (ct - 8) * 64, INW, retvt, SEQ, b * 512 + (ct - 8) * 64, n0, 0, 0, scr, lane);
            else btrans_tile(srow + C_RK + (ct - 16) * 64, INW, retkt, SEQ, b * 256 + (ct - 16) * 64, n0, 2, n0, scr, lane);
        } else { const int q = it - NT_L, tt = q / 20, ct = q % 20, b = tt >> 2, l0 = (tt & 3) * 64; const bf16_t* srow = projx + (size_t)tt * 64 * KVW;
            if (ct < 8) btrans_tile(srow + X_NAV + ct * 64, KVW, navxt, CTXL, b * 512 + ct * 64, l0, 0, 0, scr, lane);
            else if (ct < 16) btrans_tile(srow + X_RV + (ct - 8) * 64, KVW, retvxt, CTXL, b * 512 + (ct - 8) * 64, l0, 0, 0, scr, lane);
            else btrans_tile(srow + X_RK + (ct - 16) * 64, KVW, retkxt, CTXL, b * 256 + (ct - 16) * 64, l0, 1, 0, scr, lane);
        }
    }
}

struct NaState { f32x4 o[4]; float l; };
struct NaK { u32x4 k[2][2][2]; };
struct NaV { u32x4 v[2][4]; };
struct NaPtrs { const bf16_t* ks0; const bf16_t* vs0; const bf16_t* kx0; const bf16_t* vx0; };
__device__ __forceinline__ void na_loadK(NaK& f, const NaPtrs& P, int ci, int fr, int fq) {
    const bool strip = ci < 4; const size_t kld = strip ? INW : KVW;
    const bf16_t* kb0 = strip ? P.ks0 + (size_t)ci * 128 * INW : P.kx0 + (size_t)(ci - 4) * 64 * KVW;
    const bf16_t* kb1 = kb0 + (strip ? (size_t)64 * INW : (size_t)32 * KVW);
    const int kkrow = 8 * (fr >> 2) + (fr & 3);
#pragma unroll
    for (int i = 0; i < 2; ++i)
#pragma unroll
        for (int t = 0; t < 2; ++t) { const bf16_t* kp = (i ? kb1 : kb0) + (size_t)(kkrow + 4 * t) * kld + fq * 8; f.k[i][t][0] = *(const u32x4*)kp; f.k[i][t][1] = *(const u32x4*)(kp + 32); }
}
__device__ __forceinline__ void na_loadV(NaV& f, const NaPtrs& P, int ci, int fr, int fq) {
    const bool strip = ci < 4; const size_t vld = strip ? SEQ : CTXL;
    const bf16_t* vb0 = strip ? P.vs0 + ci * 128 : P.vx0 + (ci - 4) * 64;
    const bf16_t* vb1 = vb0 + (strip ? 64 : 32);
#pragma unroll
    for (int i = 0; i < 2; ++i)
#pragma unroll
        for (int dt = 0; dt < 4; ++dt) f.v[i][dt] = *(const u32x4*)((i ? vb1 : vb0) + (size_t)(dt * 16 + fr) * vld + 8 * fq);
}
constexpr int NA_LK_PITCH = 144, NA_LV_PITCH = 528, NA_LV_OFF = 256 * NA_LK_PITCH, NA_RPB_OFF = NA_LV_OFF + 64 * NA_LV_PITCH;
__device__ __forceinline__ void na_loadK_x(NaK& f, const LAS unsigned char* lk, int cx, int fr, int fq) {
    const int kkrow = 8 * (fr >> 2) + (fr & 3);
#pragma unroll
    for (int i = 0; i < 2; ++i)
#pragma unroll
        for (int t = 0; t < 2; ++t) { const LAS unsigned char* kp = lk + (64 * cx + 32 * i + kkrow + 4 * t) * NA_LK_PITCH + fq * 16; f.k[i][t][0] = *(const LAS u32x4*)kp; f.k[i][t][1] = *(const LAS u32x4*)(kp + 64); }
}
__device__ __forceinline__ void na_loadV_x(NaV& f, const LAS unsigned char* lv, int cx, int fr, int fq) {
#pragma unroll
    for (int i = 0; i < 2; ++i)
#pragma unroll
        for (int dt = 0; dt < 4; ++dt) f.v[i][dt] = *(const LAS u32x4*)(lv + (dt * 16 + fr) * NA_LV_PITCH + (64 * cx + 32 * i + 8 * fq) * 2);
}
template <bool STRIP>
__device__ __forceinline__ void na_compute(NaState& st, const NaK& fk, const NaV& fv, const u32x4 (&qf)[2], const LAS float* brow0, const LAS float* brow1, int cb, int c0, int qc, int fq, float sref) {
    f32x4 s[2][2];
#pragma unroll
    for (int i = 0; i < 2; ++i)
#pragma unroll
        for (int t = 0; t < 2; ++t) { f32x4 a = mfma16(fk.k[i][t][0], qf[0], (f32x4){0.f, 0.f, 0.f, 0.f}); s[i][t] = mfma16(fk.k[i][t][1], qf[1], a); }
    float sum = 0.f; u32x4 pf[2];
#pragma unroll
    for (int i = 0; i < 2; ++i) { float e[8];
#pragma unroll
        for (int t = 0; t < 2; ++t)
#pragma unroll
            for (int j = 0; j < 4; ++j) { float v = s[i][t][j] * 0.125f - sref;
                if (STRIP) { const int kc = cb + 8 * fq + 4 * t + j; const bool valid = (unsigned)(kc - c0) < 16u; const int co = min(max(kc - qc + 15, 0), 30);
                    v = valid ? v + (i ? brow1 : brow0)[co] : -3.0e38f; }
                const float pe = __expf(v); e[t * 4 + j] = pe; sum += pe; }
        pf[i] = pack8(e); }
    st.l += sum;
#pragma unroll
    for (int i = 0; i < 2; ++i)
#pragma unroll
        for (int dt = 0; dt < 4; ++dt) st.o[dt] = mfma16(fv.v[i][dt], pf[i], st.o[dt]);
}
__device__ __forceinline__ void na_item(const Params& p, int b, int h, int r, int g, int lane, const LAS unsigned char* lds, float sref) {
    const int fr = lane & 15, fq = lane >> 4;
    const bf16_t* proj = (const bf16_t*)(p.ws + WS_B + B_PROJ); const bf16_t* navt = (const bf16_t*)(p.ws + WS_B + B_NAVT);
    const LAS float* rpb = (const LAS float*)(lds + NA_RPB_OFF) + h * (15 * 31);
    const LAS unsigned char* lk = lds; const LAS unsigned char* lv = lds + NA_LV_OFF;
    const int qc = 16 * g + fr, tokq = b * SEQ + r * 64 + qc;
    const int r0 = min(max(r - 4, 0), 120), cb = min(max(16 * g - 8, 0), 32), c0 = min(max(qc - 8, 0), 48);
    u32x4 qf[2];
#pragma unroll
    for (int ks = 0; ks < 2; ++ks) qf[ks] = *(const u32x4*)(proj + (size_t)tokq * INW + C_NAQ + h * 64 + ks * 32 + fq * 8);
    NaState st;
#pragma unroll
    for (int dt = 0; dt < 4; ++dt) st.o[dt] = (f32x4){0.f, 0.f, 0.f, 0.f};
    st.l = 0.f;
    NaPtrs P;
    P.ks0 = proj + (size_t)(b * SEQ + r0 * 64 + cb) * INW + C_NAK + h * 64;
    P.vs0 = navt + (size_t)(b * 512 + h * 64) * SEQ + r0 * 64 + cb;
    P.kx0 = nullptr; P.vx0 = nullptr;
    NaK ka, kb; NaV vv;
    na_loadK(ka, P, 0, fr, fq);
#pragma unroll 1
    for (int cp = 0; cp < 2; ++cp) { const int ci = 2 * cp;
        const LAS float* br0 = rpb + (r0 + 2 * ci - r + 7) * 31;
        na_loadV(vv, P, ci, fr, fq); na_loadK(kb, P, ci + 1, fr, fq);
        na_compute<true>(st, ka, vv, qf, br0, br0 + 31, cb, c0, qc, fq, sref);
        na_loadV(vv, P, ci + 1, fr, fq); if (cp == 0) na_loadK(ka, P, ci + 2, fr, fq); else na_loadK_x(ka, lk, 0, fr, fq);
        na_compute<true>(st, kb, vv, qf, br0 + 62, br0 + 93, cb, c0, qc, fq, sref); }
#pragma unroll 1
    for (int cx = 0; cx < 4; cx += 2) {
        na_loadV_x(vv, lv, cx, fr, fq); na_loadK_x(kb, lk, cx + 1, fr, fq);
        na_compute<false>(st, ka, vv, qf, rpb, rpb, 0, 0, 0, fq, sref);
        na_loadV_x(vv, lv, cx + 1, fr, fq); na_loadK_x(ka, lk, cx + 2 < 4 ? cx + 2 : 3, fr, fq);
        na_compute<false>(st, kb, vv, qf, rpb, rpb, 0, 0, 0, fq, sref); }
    float l1 = st.l;
    l1 += __shfl_xor(l1, 16); l1 += __shfl_xor(l1, 32);
    const float inv = 1.0f / l1;
    bf16_t* mix = (bf16_t*)(p.ws + WS_B + B_MIXIN) + (size_t)tokq * D + h * 64;
#pragma unroll
    for (int dt = 0; dt < 4; ++dt) { const f32x4 v = st.o[dt] * inv; *(u32x2*)(mix + dt * 16 + 4 * fq) = (u32x2){pk2(v[0], v[1]), pk2(v[2], v[3])}; }
}
__device__ __forceinline__ void na_range(const Params& p, int ulo, int uhi, LAS unsigned char* lds) {
    const int tid = otid(), lane = tid & 63, wid = tid >> 6;
    const bf16_t* projx = (const bf16_t*)(p.ws + WS_B + B_PROJX); const bf16_t* navxt = (const bf16_t*)(p.ws + WS_B + B_NAVXT);
    LAS float* rpb_l = (LAS float*)(lds + NA_RPB_OFF);
    for (int u0 = ulo + blockIdx.x; u0 < uhi; u0 += gridDim.x) { const int u = (gridDim.x == 256 && ulo == 0 && uhi == 256) ? (((u0 & 7) << 5) + (u0 >> 3)) : u0;
        const int bh = u >> 3, b = bh >> 3, h = bh & 7, rbase = (u & 7) * 16;
        __syncthreads();
        for (int i = tid; i < 8 * 15 * 31; i += 512) rpb_l[i] = p.in[11][i];
        for (int i = tid; i < 2048; i += 512) { const int l = i >> 3, ck = i & 7;
            *(LAS u32x4*)(lds + l * NA_LK_PITCH + ck * 16) = *(const u32x4*)(projx + (size_t)(b * CTXL + l) * KVW + X_NAK + h * 64 + ck * 8); }
        for (int i = tid; i < 2048; i += 512) { const int d = i >> 5, ck = i & 31;
            *(LAS u32x4*)(lds + NA_LV_OFF + d * NA_LV_PITCH + ck * 16) = *(const u32x4*)(navxt + (size_t)(b * 512 + h * 64 + d) * CTXL + ck * 8); }
        __syncthreads();
        float gq = fabsf(p.in[9][lane]), gk = fabsf(p.in[10][lane]), bm = 0.f;
        for (int i = lane; i < 15 * 31; i += 64) bm = fmaxf(bm, fabsf(rpb_l[h * (15 * 31) + i]));
#pragma unroll
        for (int o = 1; o < 64; o <<= 1) { gq = fmaxf(gq, __shfl_xor(gq, o)); gk = fmaxf(gk, __shfl_xor(gk, o)); bm = fmaxf(bm, __shfl_xor(bm, o)); }
        const float sref = fminf(8.0f * 1.02f * gq * gk + bm, 40.0f);
        for (int it = wid; it < 64; it += 8) na_item(p, b, h, rbase + (it >> 2), it & 3, lane, lds, sref);
    }
}

__device__ __forceinline__ float log2_decay(float a) { return -log1pf(__expf(-a)) * 1.4426950408889634f; }
__device__ __forceinline__ void retU_item(const Params& p, int item, int lane) {
    const int w = item & 7, cc = (item >> 3) % NCC, bh = (item >> 3) / NCC, b = bh >> 2, h = bh & 3;
    const int fr = lane & 15, fq = lane >> 4;
    const float lgf = log2_decay(p.in[12][h]), lgb = log2_decay(p.in[13][h]);
    const bf16_t* vt; const bf16_t* kt; size_t ld; int n0;
    if (cc < 2) { vt = (const bf16_t*)(p.ws + WS_B + B_RETVXT); kt = (const bf16_t*)(p.ws + WS_B + B_RETKXT); ld = CTXL; n0 = cc * 128; }
    else { vt = (const bf16_t*)(p.ws + WS_B + B_RETVT); kt = (const bf16_t*)(p.ws + WS_B + B_RETKT); ld = SEQ; n0 = (cc - 2) * 128; }
    f32x4 af[4], ab[4];
#pragma unroll
    for (int nt = 0; nt < 4; ++nt) { af[nt] = (f32x4){0.f, 0.f, 0.f, 0.f}; ab[nt] = (f32x4){0.f, 0.f, 0.f, 0.f}; }
#pragma unroll
    for (int ks = 0; ks < 4; ++ks) {
        const u32x4 va = *(const u32x4*)(vt + (size_t)(b * 512 + h * 128 + 16 * w + fr) * ld + n0 + 32 * ks + 8 * fq);
        float wf[8], wb[8];
#pragma unroll
        for (int e = 0; e < 8; ++e) { const int j = 32 * ks + 8 * fq + e; wf[e] = exp2f((float)(127 - j) * lgf); wb[e] = exp2f((float)j * lgb); }
#pragma unroll
        for (int nt = 0; nt < 4; ++nt) { const u32x4 kw = *(const u32x4*)(kt + (size_t)(b * 256 + h * 64 + 16 * nt + fr) * ld + n0 + 32 * ks + 8 * fq);
            float x[8], y[8]; unpack8(kw, x);
#pragma unroll
            for (int e = 0; e < 8; ++e) { y[e] = x[e] * wb[e]; x[e] *= wf[e]; }
            af[nt] = mfma16(va, pack8(x), af[nt]); ab[nt] = mfma16(va, pack8(y), ab[nt]); }
    }
    float* U = (float*)(p.ws + WS_B + B_U);
    float* uf = U + ((size_t)(0 * 16 + bh) * NCC + cc) * 8192; float* ub = U + ((size_t)(1 * 16 + bh) * NCC + cc) * 8192;
#pragma unroll
    for (int nt = 0; nt < 4; ++nt)
#pragma unroll
        for (int j = 0; j < 4; ++j) { const int v = 16 * w + 4 * fq + j, d = 16 * nt + fr; uf[v * 64 + d] = af[nt][j]; ub[v * 64 + d] = ab[nt][j]; }
}
__device__ __forceinline__ void phase_retU(const Params& p) {
    const int lane = otid() & 63, gw = blockIdx.x * 8 + (otid() >> 6), NW = gridDim.x * 8;
    for (int it = gw; it < 16 * NCC * 8; it += NW) retU_item(p, it, lane);
}
__device__ __forceinline__ void phase_scan(const Params& p) {
    const float* U = (const float*)(p.ws + WS_B + B_U); bf16_t* S = (bf16_t*)(p.ws + WS_B + B_S);
    for (int i = blockIdx.x * 512 + otid(); i < 2 * 16 * 4096; i += gridDim.x * 512) {
        const int e = (i & 4095) * 2, bh = (i >> 12) & 15, dir = i >> 16, h = bh & 3;
        const float G = exp2f(128.0f * log2_decay(dir ? p.in[13][h] : p.in[12][h]));
        const float* u = U + (size_t)(dir * 16 + bh) * NCC * 8192 + e; bf16_t* s = S + (size_t)(dir * 16 + bh) * NCHUNK * 8192 + e;
        const f32x2 u0 = *(const f32x2*)u, u1 = *(const f32x2*)(u + 8192);
        if (dir == 0) { f32x2 st = u0 * G + u1;
#pragma unroll 16
            for (int c = 0; c < NCHUNK; ++c) { *(unsigned*)(s + (size_t)c * 8192) = pk2(st.x, st.y); st = st * G + *(const f32x2*)(u + (size_t)(2 + c) * 8192); }
        } else { f32x2 st = u0 + u1 * G;
#pragma unroll 16
            for (int c = NCHUNK - 1; c >= 0; --c) { *(unsigned*)(s + (size_t)c * 8192) = pk2(st.x, st.y); st = st * G + *(const f32x2*)(u + (size_t)(2 + c) * 8192); } }
    }
}
constexpr int RO_KP = 144, RO_VP = 272, RO_SP = 144, RO_V_OFF = 128 * RO_KP, RO_S_OFF = RO_V_OFF + 128 * RO_VP;
__device__ __forceinline__ void retO_item(const Params& p, int bh, int c, int w, int lane, const LAS unsigned char* lds) {
    const int b = bh >> 2, h = bh & 3;
    const int fr = lane & 15, fq = lane >> 4;
    const float lgf = log2_decay(p.in[12][h]), lgb = log2_decay(p.in[13][h]);
    const bf16_t* proj = (const bf16_t*)(p.ws + WS_B + B_PROJ);
    const int tok0 = b * SEQ + c * 128, qi = 16 * w + fr, tokq = tok0 + qi;
    u32x4 qf[2];
#pragma unroll
    for (int ks = 0; ks < 2; ++ks) qf[ks] = *(const u32x4*)(proj + (size_t)tokq * INW + C_RQ + h * 64 + ks * 32 + fq * 8);
    const int kkrow = 8 * (fr >> 2) + (fr & 3);
    u32x4 pf[4];
#pragma unroll
    for (int kb = 0; kb < 4; ++kb) { float e[8];
#pragma unroll
        for (int t = 0; t < 2; ++t) { const LAS unsigned char* kp = lds + (32 * kb + kkrow + 4 * t) * RO_KP + fq * 16;
            const u32x4 k0 = *(const LAS u32x4*)kp, k1 = *(const LAS u32x4*)(kp + 64);
            f32x4 a = mfma16(k0, qf[0], (f32x4){0.f, 0.f, 0.f, 0.f}); a = mfma16(k1, qf[1], a);
#pragma unroll
            for (int j = 0; j < 4; ++j) { const int kj = 32 * kb + 8 * fq + 4 * t + j, df = qi - kj;
                const float dec = df > 0 ? exp2f((float)df * lgf) : (df < 0 ? exp2f((float)(-df) * lgb) : 2.0f);
                e[t * 4 + j] = a[j] * dec; } }
        pf[kb] = pack8(e); }
    f32x4 o[8];
#pragma unroll
    for (int vt = 0; vt < 8; ++vt) o[vt] = (f32x4){0.f, 0.f, 0.f, 0.f};
#pragma unroll
    for (int kb = 0; kb < 4; ++kb)
#pragma unroll
        for (int vt = 0; vt < 8; ++vt) { const u32x4 vf = *(const LAS u32x4*)(lds + RO_V_OFF + (vt * 16 + fr) * RO_VP + (32 * kb + 8 * fq) * 2);
            o[vt] = mfma16(vf, pf[kb], o[vt]); }
    const float xif = exp2f((float)(qi + 1) * lgf), xib = exp2f((float)(128 - qi) * lgb);
#pragma unroll
    for (int dir = 0; dir < 2; ++dir) { const float xi = dir ? xib : xif; const LAS unsigned char* sp = lds + RO_S_OFF + dir * 128 * RO_SP;
#pragma unroll
        for (int ks = 0; ks < 2; ++ks) { float x[8]; unpack8(qf[ks], x);
#pragma unroll
            for (int e = 0; e < 8; ++e) x[e] *= xi;
            const u32x4 qs = pack8(x);
#pragma unroll
            for (int vt = 0; vt < 8; ++vt) { const u32x4 sf = *(const LAS u32x4*)(sp + (vt * 16 + fr) * RO_SP + ks * 64 + fq * 16); o[vt] = mfma16(sf, qs, o[vt]); } } }
    float ss = 0.f;
#pragma unroll
    for (int vt = 0; vt < 8; ++vt)
#pragma unroll
        for (int j = 0; j < 4; ++j) ss += o[vt][j] * o[vt][j];
    ss += __shfl_xor(ss, 16); ss += __shfl_xor(ss, 32);
    const float rstd = rsqrtf(ss * (1.0f / 128.0f) + EPS);
    const bf16_t* rg = proj + (size_t)tokq * INW + C_RG + h * 128; bf16_t* mix = (bf16_t*)(p.ws + WS_B + B_MIXIN) + (size_t)tokq * D + 512 + h * 128;
#pragma unroll
    for (int vt = 0; vt < 8; ++vt) { const u32x2 gw2 = *(const u32x2*)(rg + vt * 16 + 4 * fq);
        const float g0 = silu_f(bflo(gw2.x)), g1 = silu_f(bfhi(gw2.x)), g2 = silu_f(bflo(gw2.y)), g3 = silu_f(bfhi(gw2.y));
        *(u32x2*)(mix + vt * 16 + 4 * fq) = (u32x2){pk2(o[vt][0] * rstd * g0, o[vt][1] * rstd * g1), pk2(o[vt][2] * rstd * g2, o[vt][3] * rstd * g3)}; }
}
__device__ __forceinline__ void phase_retO(const Params& p, LAS unsigned char* lds) {
    const int tid = otid(), lane = tid & 63, wid = tid >> 6;
    const bf16_t* rkr = (const bf16_t*)(p.ws + WS_B + B_RKR); const bf16_t* retvt = (const bf16_t*)(p.ws + WS_B + B_RETVT); const bf16_t* S = (const bf16_t*)(p.ws + WS_B + B_S);
    for (int u = blockIdx.x; u < 16 * 64; u += gridDim.x) { const int c = u & 63, bh = u >> 6, b = bh >> 2, h = bh & 3;
        __syncthreads();
        for (int i = tid; i < 1024; i += 512) { const int r = i >> 3, ck = i & 7;
            *(LAS u32x4*)(lds + r * RO_KP + ck * 16) = *(const u32x4*)(rkr + (size_t)(b * SEQ + c * 128 + r) * 256 + h * 64 + ck * 8); }
        for (int i = tid; i < 2048; i += 512) { const int r = i >> 4, ck = i & 15;
            *(LAS u32x4*)(lds + RO_V_OFF + r * RO_VP + ck * 16) = *(const u32x4*)(retvt + (size_t)(b * 512 + h * 128 + r) * SEQ + c * 128 + ck * 8); }
        for (int i = tid; i < 2048; i += 512) { const int dir = i >> 10, r = (i >> 3) & 127, ck = i & 7;
            *(LAS u32x4*)(lds + RO_S_OFF + (dir * 128 + r) * RO_SP + ck * 16) = *(const u32x4*)(S + ((size_t)(dir * 16 + bh) * NCHUNK + c) * 8192 + r * 64 + ck * 8); }
        __syncthreads();
        retO_item(p, bh, c, wid, lane, lds);
    }
}

__device__ __forceinline__ void phase_combine(const Params& p) {
    const int lane = otid() & 63, gw = blockIdx.x * 8 + (otid() >> 6), NW = gridDim.x * 8;
    const bf16_t* Y = (const bf16_t*)(p.ws + WS_B + B_Y); const int* toks = (const int*)(p.ws + WS_TOKS); const float* ada = (const float*)(p.ws + WS_ADA1);
    for (int r0 = gw * 4; r0 < T; r0 += NW * 4) { const int b = r0 >> 13; const float* gf = ada + b * 6144 + 5 * 1024;
        int s0[4], s1[4];
#pragma unroll
        for (int r = 0; r < 4; ++r) { s0[r] = toks[2 * (r0 + r)]; s1[r] = toks[2 * (r0 + r) + 1]; }
        f32x4 x[4][4]; u32x2 ya[4][4], yb[4][4];
#pragma unroll
        for (int r = 0; r < 4; ++r)
#pragma unroll
            for (int j = 0; j < 4; ++j) { const int c = 4 * lane + 256 * j; x[r][j] = *(const f32x4*)(p.out + (size_t)(r0 + r) * D + c);
                ya[r][j] = *(const u32x2*)(Y + (size_t)s0[r] * D + c); yb[r][j] = *(const u32x2*)(Y + (size_t)s1[r] * D + c); }
#pragma unroll
        for (int j = 0; j < 4; ++j) { const int c = 4 * lane + 256 * j; const f32x4 g = *(const f32x4*)(gf + c);
#pragma unroll
            for (int r = 0; r < 4; ++r) { const u32x2 a = ya[r][j], bb = yb[r][j];
                f32x4 y = (f32x4){bflo(a.x) + bflo(bb.x), bfhi(a.x) + bfhi(bb.x), bflo(a.y) + bflo(bb.y), bfhi(a.y) + bfhi(bb.y)};
                if (DBG_MASK & 16) y = (f32x4){0.f, 0.f, 0.f, 0.f};
                *(f32x4*)(p.out + (size_t)(r0 + r) * D + c) = x[r][j] + g * y; } } }
}

constexpr int NPHASE = 21;
#define XB_TMO      128
#define XB_XCNT(j)  (256  + 64 * (j))
#define XB_XSUB(j)  (1280 + 64 * (j))
#define XB_XGEN(j)  (2304 + 64 * (j))
#define XB_TOP      3328
#define XB_TOPGEN   3392
#define XCD_BAR_WORDS 3456
#define XB_SPIN_CAP (1u << 22)
__device__ __forceinline__ unsigned xb_ld(unsigned* p)              { return __hip_atomic_load(p, __ATOMIC_RELAXED, __HIP_MEMORY_SCOPE_AGENT); }
__device__ __forceinline__ unsigned xb_add(unsigned* p, unsigned v) { return __hip_atomic_fetch_add(p, v, __ATOMIC_RELAXED, __HIP_MEMORY_SCOPE_AGENT); }
__device__ __forceinline__ unsigned xb_xcc_id() { return (unsigned)__builtin_amdgcn_s_getreg((3 << 11) | 20) & 0xFu; }
#define XB_SPIN(cond, bar) do { unsigned _sp = 0; while (cond) { __builtin_amdgcn_s_sleep(1); \
    if ((++_sp & 255u) == 0u) { if (xb_ld(&(bar)[XB_TMO])) break; if (_sp > XB_SPIN_CAP) { atomicAdd(&(bar)[XB_TMO], 1u); break; } } } } while (0)
struct XcdBarrier { unsigned* bar; unsigned x; volatile LAS unsigned* st; };
__device__ __forceinline__ XcdBarrier xcd_barrier_post(unsigned* bar, volatile LAS unsigned* st) {
    XcdBarrier b; b.bar = bar; b.x = xb_xcc_id(); b.st = st;
    if (threadIdx.x == 0) (void)xb_add(&bar[XB_XCNT(b.x)], 1u);
    return b;
}
__device__ __forceinline__ void xcd_barrier_complete(unsigned* bar, unsigned x, unsigned& nloc, unsigned& nx) {
    const unsigned G = gridDim.x * gridDim.y * gridDim.z;
    unsigned sum, cnt, mine, sp = 0u;
    for (;;) {
        sum = 0u; cnt = 0u; mine = 0u;
#pragma unroll
        for (unsigned j = 0; j < 16; ++j) { const unsigned c = xb_ld(&bar[XB_XCNT(j)]); sum += c; cnt += (c > 0u) ? 1u : 0u; mine = (j == x) ? c : mine; }
        if (sum == G) break;
        __builtin_amdgcn_s_sleep(1);
        if ((++sp & 255u) == 0u) { if (xb_ld(&bar[XB_TMO])) break; if (sp > XB_SPIN_CAP) { atomicAdd(&bar[XB_TMO], 1u); break; } }
    }
    nloc = mine > 0u ? mine : 1u; nx = cnt > 0u ? cnt : 1u;
}
__device__ __forceinline__ void xcd_barrier(const XcdBarrier& b) {
    asm volatile("s_waitcnt vmcnt(0) lgkmcnt(0)" ::: "memory");
    __syncthreads();
    if (threadIdx.x == 0) {
        unsigned* bar = b.bar;
        __builtin_amdgcn_s_waitcnt(0);
        unsigned nloc = b.st[0], nx = b.st[1];
        if (nloc == 0u) { xcd_barrier_complete(bar, b.x, nloc, nx); b.st[0] = nloc; b.st[1] = nx; }
        const unsigned old = xb_add(&bar[XB_XSUB(b.x)], 1u);
        const unsigned gen = old / nloc;
        if (old + 1u == (gen + 1u) * nloc) {
            __builtin_amdgcn_fence(__ATOMIC_RELEASE, "agent");
            asm volatile("s_waitcnt vmcnt(0)" ::: "memory");
            const unsigned og = xb_add(&bar[XB_TOP], 1u);
            const unsigned tg = og / nx;
            if (og + 1u == (tg + 1u) * nx) xb_add(&bar[XB_TOPGEN], 1u);
            else XB_SPIN(xb_ld(&bar[XB_TOPGEN]) == tg, bar);
            __builtin_amdgcn_fence(__ATOMIC_ACQUIRE, "agent");
            xb_add(&bar[XB_XGEN(b.x)], 1u);
            asm volatile("s_waitcnt vmcnt(0)" ::: "memory");
        } else {
            XB_SPIN(xb_ld(&bar[XB_XGEN(b.x)]) == gen, bar);
            __builtin_amdgcn_fence(__ATOMIC_ACQUIRE, "agent");
            asm volatile("s_waitcnt vmcnt(0)" ::: "memory");
        }
    }
    __syncthreads();
}
__global__ void __launch_bounds__(512, 2) mega(Params p) {
    extern __shared__ __attribute__((aligned(16))) unsigned char shm[];
    LAS unsigned char* lds = (LAS unsigned char*)shm;
    const int G = gridDim.x, c = blockIdx.x;
    const float* ada0 = (const float*)(p.ws + WS_ADA0); const float* ada1 = (const float*)(p.ws + WS_ADA1);
    unsigned char* B = p.ws + WS_B;
    unsigned* bar = (unsigned*)(p.ws + WS_BAR);
    volatile LAS unsigned* xst = (volatile LAS unsigned*)(lds + LDS_GEMM + 256);
    if (threadIdx.x == 0) { xst[0] = 0u; xst[1] = 0u; }
    __syncthreads();
    XcdBarrier xb = xcd_barrier_post(bar, xst);
    constexpr size_t TS = (size_t)256 * D * 2;
#ifndef PHASE_MASK
#define PHASE_MASK 0x1FFFFF
#endif
#ifndef DUP_MASK
#define DUP_MASK 0
#endif
#define PH(k) for (int rep_ = 0; rep_ < 1 + ((DUP_MASK >> (k)) & 1); ++rep_) { if (((PHASE_MASK >> (k)) & 1) && p.ph_lo <= (k) && (k) < p.ph_hi)
#define SYNC(k) if (((k) + 1 < p.ph_hi || rep_ == 0 && ((DUP_MASK >> (k)) & 1)) && p.ph_lo <= (k)) { xcd_barrier(xb); } }
    if (p.ph_hi < 0) cg::this_grid().sync();
    PH(0) { phase0(p, lds); } SYNC(0)
#ifdef EXTRA_BAR
    for (int xi = 0; xi < EXTRA_BAR; ++xi) xcd_barrier(xb);
#endif
    PH(1) { phase_norm(p, p.in[0], p.in[4], ada0, 0, true); } SYNC(1)
    PH(2) { g8::InProjSched S{(const char*)(p.ws + WS_H), (const char*)(p.ws + WS_HX), (const char*)(p.ws + WS_WT_IN), G, c};
            g8::EpiStoreBf16 E{(bf16_t*)(B + B_PROJ), (bf16_t*)(B + B_PROJX), INW, KVW, 0, 1.0f, true};
            g8::gemm_phase<g8::EpiStoreBf16, g8::InProjSched, false>(lds, D * 2, D * 2, D * 2, S, E, nullptr, 0); } SYNC(2)
    PH(3) { phase3(p, lds); } SYNC(3)
    PH(4) { phase_retU(p); } SYNC(4)
    PH(5) { phase_scan(p); na_range(p, 0, 256, lds); } SYNC(5)
    PH(6) { phase_retO(p, lds); } SYNC(6)
    PH(7) { g8::DenseSched S{(const char*)(B + B_MIXIN), (const char*)(p.ws + WS_WT_OUT), 0, 0, TS, TS, 128, 4, 1, G, c};
            g8::EpiResid E{p.out, p.in[0], ada0 + 2 * 1024, false, 1.0f};
            g8::gemm_phase<g8::EpiResid, g8::DenseSched, false>(lds, D * 2, D * 2, D * 2, S, E, nullptr, 0); } SYNC(7)
    PH(8) { phase_norm(p, p.out, p.in[5], ada0, 3, false, USE_FP8_FFN != 0); } SYNC(8)
    PH(9) {
#if USE_FP8_FFN
            g8::DenseSched S{(const char*)(p.ws + WS_H), (const char*)(p.ws + WS_WT_GU), 0, 0, TS / 2, TS / 2, 128, 22, 1, G, c};
            g8::EpiSwiglu8 E{B + B_ACT, FFN, DESCALE8};
            g8::gemm_phase<g8::EpiSwiglu8, g8::DenseSched, false, true>(lds, D, D, D, S, E, nullptr, 0); } SYNC(9)
#else
            g8::DenseSched S{(const char*)(p.ws + WS_H), (const char*)(p.ws + WS_WT_GU), 0, 0, TS, TS, 128, 22, 1, G, c};
#if USE_FP8_FFN2
            g8::EpiSwiglu8 E{B + B_ACT, FFN, 1.0f};
            g8::gemm_phase<g8::EpiSwiglu8, g8::DenseSched, false>(lds, D * 2, D * 2, D * 2, S, E, nullptr, 0); } SYNC(9)
#else
            g8::EpiSwiglu E{(bf16_t*)(B + B_ACT), FFN};
            g8::gemm_phase<g8::EpiSwiglu, g8::DenseSched, false>(lds, D * 2, D * 2, D * 2, S, E, nullptr, 0); } SYNC(9)
#endif
#endif

    PH(10) {
#if USE_FP8_FFN || USE_FP8_FFN2
             g8::DenseSched S{(const char*)(B + B_ACT), (const char*)(p.ws + WS_WT_DOWN), 0, 0, (size_t)256 * FFN, (size_t)256 * FFN, 128, 4, 1, G, c};
             g8::EpiResid E{p.out, p.out, ada0 + 5 * 1024, (DBG_MASK & 4) != 0, DESCALE8};
             g8::gemm_phase<g8::EpiResid, g8::DenseSched, false, true>(lds, FFN, FFN, FFN, S, E, nullptr, 0); } SYNC(10)
#else
             g8::DenseSched S{(const char*)(B + B_ACT), (const char*)(p.ws + WS_WT_DOWN), 0, 0, (size_t)256 * FFN * 2, (size_t)256 * FFN * 2, 128, 4, 1, G, c};
             g8::EpiResid E{p.out, p.out, ada0 + 5 * 1024, (DBG_MASK & 4) != 0, 1.0f};
             g8::gemm_phase<g8::EpiResid, g8::DenseSched, false>(lds, FFN * 2, FFN * 2, FFN * 2, S, E, nullptr, 0); } SYNC(10)
#endif

    PH(11) { phase_norm(p, p.out, p.in[17], ada1, 0, false); } SYNC(11)
    PH(12) { g8::FourASched S{(const char*)(p.ws + WS_WC2), (const char*)(p.ws + WS_H), G, c};
             g8::EpiFA2 E{(bf16_t*)(B + B_ZT)};
             g8::gemm_phase<g8::EpiFA2, g8::FourASched, false>(lds, 256, 256, 64 * D * 2, S, E, nullptr, (size_t)D * 2); } SYNC(12)
    PH(13) { g8::DenseSched S{(const char*)(p.ws + WS_M1), (const char*)(B + B_ZT), 0, 0, 0, (size_t)256 * 256 * 2, 1, 1024, 1, G, c};
             g8::EpiFB1 E{(bf16_t*)(B + B_T2), (const float*)(p.ws + WS_TW)};
             g8::gemm_phase<g8::EpiFB1, g8::DenseSched, false>(lds, 512, 512, 512, S, E, nullptr, 0); } SYNC(13)
    PH(14) { g8::DenseSched S{(const char*)(p.ws + WS_M3), (const char*)(B + B_T2), 0, 0, 0, (size_t)256 * 512 * 2, 1, 512, 1, G, c};
             g8::EpiFB3 E{(bf16_t*)(B + B_FOUR), 1.0f / 1024.0f};
             g8::gemm_phase<g8::EpiFB3, g8::DenseSched, false>(lds, 1024, 1024, 1024, S, E, nullptr, 0); } SYNC(14)
    PH(15) { g8::DenseSched S{(const char*)(B + B_FOUR), (const char*)(p.ws + WS_WT_FOUR), 0, 0, TS, TS, 128, 4, 1, G, c};
             g8::EpiResid E{p.out, p.out, ada1 + 2 * 1024, (DBG_MASK & 8) != 0, 1.0f};
             g8::gemm_phase<g8::EpiResid, g8::DenseSched, false>(lds, D * 2, D * 2, D * 2, S, E, nullptr, 0); } SYNC(15)
    PH(16) { phase_norm_router(p, lds); } SYNC(16)
    PH(17) { phase_slots(p, lds); } SYNC(17)
    PH(18) { int pe[8];
#pragma unroll
             for (int e = 0; e < 8; ++e) pe[e] = ((const int*)(p.ws + WS_BAR))[3500 + e];
#if USE_FP8
             g8::MoeSched S{(const char*)(B + B_H8S), (const char*)(p.ws + WS_WT_EGU), (size_t)2 * EDIM * D, D, D, pe[7], 28, G, c, pe[0], pe[1], pe[2], pe[3], pe[4], pe[5], pe[6], pe[7], false};
             g8::EpiSwiglu8 E{B + B_ACTE, EDIM, DESCALE8};
             g8::gemm_phase<g8::EpiSwiglu8, g8::MoeSched, false, true>(lds, D, D, D, S, E, nullptr, 0); } SYNC(18)
#else
             g8::MoeSched S{(const char*)(p.ws + WS_H), (const char*)(p.ws + WS_WT_EGU), (size_t)2 * EDIM * D * 2, D * 2, D * 2, pe[7], 28, G, c, pe[0], pe[1], pe[2], pe[3], pe[4], pe[5], pe[6], pe[7], true};
             g8::EpiSwiglu E{(bf16_t*)(B + B_ACTE), EDIM};
             g8::gemm_phase<g8::EpiSwiglu, g8::MoeSched, true>(lds, D * 2, D * 2, D * 2, S, E, (const int*)(p.ws + WS_SLTOK), 0); } SYNC(18)
#endif

    PH(19) { int pe[8];
#pragma unroll
             for (int e = 0; e < 8; ++e) pe[e] = ((const int*)(p.ws + WS_BAR))[3500 + e];
#if USE_FP8
             g8::MoeSched S{(const char*)(B + B_ACTE), (const char*)(p.ws + WS_WT_EDOWN), (size_t)D * EDIM, EDIM, EDIM, pe[7], 4, G, c, pe[0], pe[1], pe[2], pe[3], pe[4], pe[5], pe[6], pe[7], false};
             g8::EpiMoeDown E{(bf16_t*)(B + B_Y), (const float*)(p.ws + WS_SLGATE)};
             g8::gemm_phase<g8::EpiMoeDown, g8::MoeSched, false, true>(lds, EDIM, EDIM, EDIM, S, E, nullptr, 0); } SYNC(19)
#else
             g8::MoeSched S{(const char*)(B + B_ACTE), (const char*)(p.ws + WS_WT_EDOWN), (size_t)D * EDIM * 2, EDIM * 2, EDIM * 2, pe[7], 4, G, c, pe[0], pe[1], pe[2], pe[3], pe[4], pe[5], pe[6], pe[7], false};
             g8::EpiMoeDown E{(bf16_t*)(B + B_Y), (const float*)(p.ws + WS_SLGATE)};
             g8::gemm_phase<g8::EpiMoeDown, g8::MoeSched, false>(lds, EDIM * 2, EDIM * 2, EDIM * 2, S, E, nullptr, 0); } SYNC(19)
#endif

    PH(20) { phase_combine(p); } }
#ifdef PROBE_PH
    if (p.ph_lo == 30) { const bf16_t* src = (const bf16_t*)(p.ws + (size_t)(PROBE_OFF));
        for (size_t i = (size_t)blockIdx.x * 512 + threadIdx.x; i < (size_t)T * D; i += (size_t)gridDim.x * 512) p.out[i] = i < (size_t)(PROBE_N) ? __uint_as_float(((unsigned)src[i]) << 16) : 0.f; }
#endif
#undef PH
#undef SYNC
}

extern "C" void kernel_launch(void* const* d_in, const int* in_sizes, int n_in, void* d_out, int out_size, void* d_ws, size_t ws_size, hipStream_t stream) {
    static int grid = 0;
    if (grid == 0) {
        if (n_in != 25 || out_size != T * D || ws_size < WS_END) { fprintf(stderr, "kernel_launch: unexpected shapes (n_in %d out %d ws %zu need %zu)\n", n_in, out_size, ws_size, (size_t)WS_END); grid = -1; return; }
        int dev = 0, cus = 0, per_cu = 0;
        hipGetDevice(&dev); hipDeviceGetAttribute(&cus, hipDeviceAttributeMultiprocessorCount, dev);
        if (hipFuncSetAttribute((const void*)mega, hipFuncAttributeMaxDynamicSharedMemorySize, LDS_TOTAL) != hipSuccess) { fprintf(stderr, "kernel_launch: hipFuncSetAttribute failed\n"); grid = -1; return; }
        if (hipOccupancyMaxActiveBlocksPerMultiprocessor(&per_cu, (const void*)mega, 512, LDS_TOTAL) != hipSuccess || per_cu < 1) { fprintf(stderr, "kernel_launch: occupancy query failed (%d)\n", per_cu); per_cu = 1; (void)hipGetLastError(); }
        grid = cus * per_cu; if (grid > 256) grid = 256;
    }
    if (grid < 0) return;
    Params p{};
    for (int i = 0; i < 25; ++i) p.in[i] = (const float*)d_in[i];
    p.out = (float*)d_out; p.ws = (unsigned char*)d_ws;
    (void)hipMemsetAsync((unsigned char*)d_ws + WS_BAR, 0, 16384, stream);
#if MK_SPLIT
#ifdef PROBE_PH
    for (int ph = 0; ph < PROBE_PH; ++ph) { p.ph_lo = ph; p.ph_hi = ph + 1; hipLaunchKernelGGL(mega, dim3(grid), dim3(512), LDS_TOTAL, stream, p); }
    p.ph_lo = 30; p.ph_hi = 31; hipLaunchKernelGGL(mega, dim3(grid), dim3(512), LDS_TOTAL, stream, p);
    return;
#endif
    for (int ph = 0; ph < NPHASE; ++ph) { p.ph_lo = ph; p.ph_hi = ph + 1; hipLaunchKernelGGL(mega, dim3(grid), dim3(512), LDS_TOTAL, stream, p); }
#else
    p.ph_lo = 0; p.ph_hi = NPHASE;
    void* args[] = {&p};
    hipError_t e = hipLaunchCooperativeKernel((const void*)mega, dim3(grid), dim3(512), args, LDS_TOTAL, stream);
    if (e != hipSuccess) fprintf(stderr, "cooperative launch failed: %s (grid %d)\n", hipGetErrorString(e), grid);
#endif
}
```
